# Optimizing an MI355X kernel written in HIP

```python
import jax, jax.numpy as jnp
from jax import lax
import numpy as np

D_MODEL = 1024
BATCH = 8
SEQ = 2048
DEPTH = 1

HG_HEADS = 8
HG_KEY = 128
HG_VAL = D_MODEL // HG_HEADS
HG_FDIM = HG_HEADS * HG_KEY
HG_VDIM = HG_HEADS * HG_VAL
HG_CHUNK = 64
ATT_GROUPS = ((128, 1), (512, 4), (2048, 16))
N_GROUPS = 3
ATT_HEADS = 8
ATT_HEAD_DIM = 64
ATT_DIM = ATT_HEADS * ATT_HEAD_DIM
ROPE_THETA = 10000.0
N_BRANCH = 2
NORM_EPS = 1e-6
IN_SIZES = (HG_FDIM, HG_FDIM, HG_VDIM, HG_VDIM, 3 * N_GROUPS * ATT_DIM, ATT_DIM, N_BRANCH * D_MODEL)
IN_COLS = HG_FDIM * 2 + HG_VDIM * 2 + 3 * N_GROUPS * ATT_DIM + ATT_DIM + N_BRANCH * D_MODEL
IN_SPLITS = (HG_FDIM, 2 * HG_FDIM, 2 * HG_FDIM + HG_VDIM, 2 * HG_FDIM + 2 * HG_VDIM,
             2 * HG_FDIM + 2 * HG_VDIM + 3 * N_GROUPS * ATT_DIM,
             2 * HG_FDIM + 2 * HG_VDIM + 3 * N_GROUPS * ATT_DIM + ATT_DIM)

kernel_name = "hybrid_hgrn2_dilated_attn_gated_merge"


def rmsnorm(x, w):
    xf = x.astype(jnp.float32)
    y = xf * lax.rsqrt(jnp.mean(xf * xf, axis=-1, keepdims=True) + NORM_EPS)
    return (y * w.astype(jnp.float32)).astype(x.dtype)


def rope_tables(positions, dim):
    inv_freq = ROPE_THETA ** (-jnp.arange(0, dim, 2, dtype=jnp.float32) / dim)
    ang = positions.astype(jnp.float32)[..., None] * inv_freq
    return jnp.cos(ang), jnp.sin(ang)


def apply_rope(t, cos, sin):
    c = cos[:, :, None, None, :]
    s = sin[:, :, None, None, :]
    t1, t2 = jnp.split(t, 2, axis=-1)
    return jnp.concatenate([t1 * c - t2 * s, t2 * c + t1 * s], axis=-1)


def hgrn2_chunked(q, k, logf, v):
    B, S, H, K = q.shape
    V = v.shape[-1]
    C = HG_CHUNK
    nC = S // C

    def chunks(t):
        return t.reshape(B, nC, C, H, t.shape[-1]).transpose(1, 0, 3, 2, 4)

    causal = jnp.tril(jnp.ones((C, C), dtype=bool))

    def step(state, xs):
        qc, kc, gc, vc = xs
        b = jnp.cumsum(gc, axis=2)
        diff = b[:, :, :, None, :] - b[:, :, None, :, :]
        decay = jnp.exp(jnp.where(causal[:, :, None], diff, -jnp.inf))
        scores = jnp.einsum('bhtk,bhtsk,bhsk->bhts', qc, decay, kc)
        o = (jnp.einsum('bhts,bhsv->bhtv', scores, vc)
             + jnp.einsum('bhtk,bhkv->bhtv', qc * jnp.exp(b), state))
        b_last = b[:, :, -1:, :]
        state = (jnp.exp(b_last)[:, :, 0, :, None] * state
                 + jnp.einsum('bhsk,bhsv->bhkv', kc * jnp.exp(b_last - b), vc))
        return state, o

    s0 = jnp.zeros((B, H, K, V), jnp.float32)
    _, o = lax.scan(step, s0, (chunks(q), chunks(k), chunks(logf), chunks(v)))
    return o.transpose(1, 0, 3, 2, 4).reshape(B, S, H, V)


def dilated_window_attention(q, k, v, window, dilation):
    B, S, H, E = q.shape
    n = window // dilation
    M = S // dilation
    nblk = -(-M // n)
    Mp = nblk * n

    def to_residue(t):
        t = t.reshape(B, M, dilation, H, E).transpose(0, 2, 3, 1, 4)
        return jnp.pad(t, ((0, 0), (0, 0), (0, 0), (0, Mp - M), (0, 0)))

    def key_blocks(t):
        t = jnp.pad(t, ((0, 0), (0, 0), (0, 0), (n, 0), (0, 0))).reshape(B, dilation, H, nblk + 1, n, E)
        return jnp.concatenate([t[:, :, :, :-1], t[:, :, :, 1:]], axis=-2)

    qb = to_residue(q).reshape(B, dilation, H, nblk, n, E)
    kb = key_blocks(to_residue(k))
    vb = key_blocks(to_residue(v))
    s = jnp.einsum('brhcqe,brhcke->brhcqk', qb, kb) * (E ** -0.5)
    i = jnp.arange(n)[:, None]
    j = jnp.arange(2 * n)[None, :]
    dist = i + n - j
    c = jnp.arange(nblk)[:, None, None]
    valid = (dist >= 0) & (dist <= n) & (c * n - n + j >= 0)
    s = jnp.where(valid, s, -jnp.inf)
    m = jnp.max(s, axis=-1)
    p = jnp.exp(s - m[..., None])
    l = jnp.sum(p, axis=-1)
    o = jnp.einsum('brhcqk,brhcke->brhcqe', p, vb)

    def back(t):
        rest = t.shape[5:]
        t = t.reshape(B, dilation, H, Mp, *rest)[:, :, :, :M]
        t = jnp.moveaxis(t, 3, 1)
        return t.reshape(B, S, H, *rest)

    return back(o), back(m), back(l)


def hybrid_layer(x, cos, sin, norm_w, w_in, lb, hgrn_norm_w, w_branch_a, w_branch_b, w_out):
    B, S, _ = x.shape
    h = rmsnorm(x, norm_w)
    z = h @ w_in
    hq, hf, hi, hg, aqkv, ag, gates = jnp.split(z, IN_SPLITS, axis=-1)

    f = lb + (1.0 - lb) * jax.nn.sigmoid(hf.astype(jnp.float32))
    shp = (B, S, HG_HEADS, HG_KEY)
    q_a = jax.nn.silu(hq.astype(jnp.float32)).reshape(shp)
    o_a = hgrn2_chunked(q_a, (1.0 - f).reshape(shp), jnp.log(f).reshape(shp),
                        hi.astype(jnp.float32).reshape(B, S, HG_HEADS, HG_VAL))
    o_a = rmsnorm(o_a, hgrn_norm_w) * jax.nn.silu(hg.astype(jnp.float32)).reshape(B, S, HG_HEADS, HG_VAL)
    y_a = o_a.reshape(B, S, HG_VDIM).astype(x.dtype) @ w_branch_a

    aqkv = aqkv.astype(jnp.float32).reshape(B, S, 3, N_GROUPS, ATT_HEADS, ATT_HEAD_DIM)
    q_b = apply_rope(aqkv[:, :, 0], cos, sin)
    k_b = apply_rope(aqkv[:, :, 1], cos, sin)
    v_b = aqkv[:, :, 2]
    outs, maxes, dens = [], [], []
    for g, (window, dilation) in enumerate(ATT_GROUPS):
        o_g, m_g, l_g = dilated_window_attention(q_b[:, :, g], k_b[:, :, g], v_b[:, :, g], window, dilation)
        outs.append(o_g)
        maxes.append(m_g)
        dens.append(l_g)
    ms = jnp.stack(maxes)
    wts = jnp.exp(ms - jnp.max(ms, axis=0))
    den = jnp.sum(wts * jnp.stack(dens), axis=0)
    num = jnp.sum(wts[..., None] * jnp.stack(outs), axis=0)
    o_b = (num / den[..., None]).reshape(B, S, ATT_DIM) * jax.nn.silu(ag.astype(jnp.float32))
    y_b = o_b.astype(x.dtype) @ w_branch_b

    g_a, g_b = jnp.split(jax.nn.sigmoid(gates), N_BRANCH, axis=-1)
    merged = g_a * y_a + g_b * y_b
    return x + merged @ w_out


def setup_inputs(seed: int = 0) -> dict:
    key = jax.random.key(seed)
    ks = jax.random.split(key, 12)
    x = jax.random.normal(ks[0], (BATCH, SEQ, D_MODEL), jnp.float32)
    offsets = jax.random.randint(ks[1], (BATCH, 1), 0, 4096, dtype=jnp.int32)
    positions = offsets + jnp.arange(SEQ, dtype=jnp.int32)[None, :]
    norm_w = 1.0 + 0.02 * jax.random.normal(ks[2], (DEPTH, D_MODEL), jnp.float32)
    w_in = jax.random.normal(ks[3], (DEPTH, D_MODEL, IN_COLS), jnp.float32) * D_MODEL ** -0.5
    lb_logits = 0.5 * jax.random.normal(ks[4], (DEPTH + 1, HG_FDIM), jnp.float32)
    hgrn_norm_w = 1.0 + 0.02 * jax.random.normal(ks[5], (DEPTH, HG_VAL), jnp.float32)
    w_branch_a = jax.random.normal(ks[6], (DEPTH, HG_VDIM, D_MODEL), jnp.float32) * HG_VDIM ** -0.5
    w_branch_b = jax.random.normal(ks[7], (DEPTH, ATT_DIM, D_MODEL), jnp.float32) * ATT_DIM ** -0.5
    w_out = jax.random.normal(ks[8], (DEPTH, D_MODEL, D_MODEL), jnp.float32) * D_MODEL ** -0.5
    final_norm_w = 1.0 + 0.02 * jax.random.normal(ks[9], (D_MODEL,), jnp.float32)
    return {"x": x, "positions": positions, "norm_w": norm_w, "w_in": w_in, "lb_logits": lb_logits,
            "hgrn_norm_w": hgrn_norm_w, "w_branch_a": w_branch_a, "w_branch_b": w_branch_b,
            "w_out": w_out, "final_norm_w": final_norm_w}


def reference(x, positions, norm_w, w_in, lb_logits, hgrn_norm_w, w_branch_a, w_branch_b, w_out, final_norm_w):
    cos, sin = rope_tables(positions, ATT_HEAD_DIM)
    lower_bounds = jnp.cumsum(jax.nn.softmax(lb_logits.astype(jnp.float32), axis=0), axis=0)
    for layer in range(DEPTH):
        x = hybrid_layer(x, cos, sin, norm_w[layer], w_in[layer], lower_bounds[layer], hgrn_norm_w[layer],
                         w_branch_a[layer], w_branch_b[layer], w_out[layer])
    return rmsnorm(x, final_norm_w)
```

```cpp
#include <hip/hip_runtime.h>
#include <hip/hip_cooperative_groups.h>
#include <hip/hip_bf16.h>
#include <cstdio>
#include <cstdint>
#include <cmath>
namespace cg = cooperative_groups;
namespace pg8 {
#define PG8_LAS __attribute__((address_space(3)))
typedef unsigned short bf16_t;
typedef short bf16x8 __attribute__((ext_vector_type(8)));
typedef float f32x4 __attribute__((ext_vector_type(4)));
typedef unsigned u32x4 __attribute__((ext_vector_type(4)));
constexpr int BM = 256, BK = 64, HALF = 128, HTB = HALF * BK * 2  , STAGE_BYTES = 8 * HTB, NXCD = 8, WGM = 8;

__host__ __device__ __forceinline__ int lds_byte(int r, int c) { const int st = (r >> 4) * 2 + (c >> 5), rr = r & 15, cc = c & 31, ob = rr * 64 + cc * 2; return st * 1024 + (ob ^ (((ob >> 9) & 1) << 5)); }
__host__ __device__ __forceinline__ void stage_rc(int b, int& R, int& C) { const int st = b / 1024, sb = b % 1024, swz = sb ^ (((sb >> 9) & 1) << 5); R = (st >> 1) * 16 + swz / 64; C = (st & 1) * 32 + (swz % 64) / 2; }
__host__ __device__ __forceinline__ int perm32(int rho) { const int n = rho >> 4, i = rho & 15; return 8 * (i >> 2) + 4 * n + (i & 3); }

struct Unit { int pm, pn; };
struct Gemm { const bf16_t* A; const bf16_t* Bt; int M, N, K; };

struct StaticOrder {
    int nM, nN, nwg, G, c;
    __host__ __device__ void init(int M, int N, int G_, int c_) { nM = M / BM; nN = N / BM; nwg = nM * nN; G = G_; c = c_; }
    __host__ __device__ bool next(int i, Unit& u) const {
        const long L = (long)i * G + c; if (L >= nwg) return false;
        int wgid = (int)L; { const int q = nwg / NXCD, r = nwg % NXCD, xcd = wgid % NXCD, off = wgid / NXCD; wgid = (xcd < r ? xcd * (q + 1) : r * (q + 1) + (xcd - r) * q) + off; }
        const int nig = WGM * nN, gid = wgid / nig, fm = gid * WGM, gsz = (nM - fm) < WGM ? (nM - fm) : WGM;
        u.pm = fm + ((wgid % nig) % gsz); u.pn = (wgid % nig) / gsz; return true;
    }
    __device__ __forceinline__ void a_ready(const Unit&) const {}
    __device__ __forceinline__ void done(const Unit&) const {}
};

__device__ __forceinline__ unsigned cvt_pk_bf16(float lo, float hi) { unsigned r; asm volatile("v_cvt_pk_bf16_f32 %0, %1, %2" : "=v"(r) : "v"(lo), "v"(hi)); return r; }
typedef float f32x2 __attribute__((ext_vector_type(2)));
template <class Epi, class Sched, bool ALIGN_EPI = false, bool SP2 = false>
__device__ __forceinline__ void gemm_phase(PG8_LAS unsigned char* lds, const Gemm g, const Sched& S, const Epi& E) {
    const int tid = threadIdx.x, wid = __builtin_amdgcn_readfirstlane(tid >> 6), lane = tid & 63, wr = wid >> 2, wc = wid & 3, fr = lane & 15, fq = lane >> 4;
    const int K = g.K, nt = K / BK;
    unsigned voffA[2], voffB[2];
#pragma unroll
    for (int i = 0; i < 2; ++i) { int R, C; stage_rc(tid * 16 + i * 8192, R, C); const int Rb = Epi::PERM ? ((R & ~31) + perm32(R & 31)) : R;
        voffA[i] = (unsigned)(R * K + C) * 2u; voffB[i] = (unsigned)(Rb * K + C) * 2u; }
    const size_t kstep = (size_t)(BK * 2);
    const size_t hstep = (size_t)HALF * K * 2;
    const size_t tstep = 2 * hstep;
    const unsigned ldsw = (unsigned)wid * 1024u;
    const int aoff = lds_byte(wr * 64 + fr, fq * 8), boff = lds_byte(wc * 32 + fr, fq * 8);
#define PG8_SA(b, h) (((b) * 2 + (h)) * HTB)
#define PG8_SB(b, h) ((4 + (b) * 2 + (h)) * HTB)
#define PG8_STAGE(bufoff, gbase, voff) do { _Pragma("unroll") for (int _i = 0; _i < 2; ++_i) \
        __builtin_amdgcn_global_load_lds((const unsigned*)((const char*)(gbase) + (voff)[_i]), (PG8_LAS unsigned*)(lds + (bufoff) + ldsw + _i * 8192), 16, 0, 0); } while (0)
#define PG8_LDA(dst, b, h) do { _Pragma("unroll") for (int m = 0; m < 4; ++m) _Pragma("unroll") for (int k = 0; k < 2; ++k) dst[m][k] = *(const PG8_LAS bf16x8*)(lds + PG8_SA(b, h) + aoff + m * 2048 + k * 1024); } while (0)
#define PG8_LDB(dst, b, h) do { _Pragma("unroll") for (int n = 0; n < 2; ++n) _Pragma("unroll") for (int k = 0; k < 2; ++k) dst[n][k] = *(const PG8_LAS bf16x8*)(lds + PG8_SB(b, h) + boff + n * 2048 + k * 1024); } while (0)
#define PG8_MMA(ai, bj, At, Bt) do { __builtin_amdgcn_s_setprio(1); _Pragma("unroll") for (int m = 0; m < 4; ++m) _Pragma("unroll") for (int n = 0; n < 2; ++n) _Pragma("unroll") for (int k = 0; k < 2; ++k) \
        acc[ai][bj][m][n] = __builtin_amdgcn_mfma_f32_16x16x32_bf16(Bt[n][k], At[m][k], acc[ai][bj][m][n], 0, 0, 0); __builtin_amdgcn_s_setprio(0); } while (0)
#define PG8_WAIT_V(n) asm volatile("s_waitcnt vmcnt(" #n ")" ::: "memory")
#define PG8_WAIT_L(n) asm volatile("s_waitcnt lgkmcnt(" #n ")" ::: "memory")
#define PG8_BAR __builtin_amdgcn_s_barrier()
#define PG8_SCHED __builtin_amdgcn_sched_barrier(0)
    Unit cur, nxt; int ui = 0;
    if (!S.next(0, cur)) return;
    f32x4 acc[2][2][4][2];
#pragma unroll
    for (int a = 0; a < 2; ++a)
#pragma unroll
        for (int b = 0; b < 2; ++b)
#pragma unroll
            for (int m = 0; m < 4; ++m)
#pragma unroll
                for (int n = 0; n < 2; ++n) acc[a][b][m][n] = (f32x4){0.f, 0.f, 0.f, 0.f};
    bf16x8 At[4][2], B0[2][2], B1[2][2];
    const char* cA = (const char*)g.A + (size_t)cur.pm * tstep; const char* cB = (const char*)g.Bt + (size_t)cur.pn * tstep;
    S.a_ready(cur);
    if constexpr (SP2) {
        PG8_STAGE(PG8_SB(0, 0), cB, voffB); PG8_STAGE(PG8_SB(0, 1), cB + hstep, voffB); PG8_STAGE(PG8_SA(0, 0), cA, voffA); PG8_STAGE(PG8_SA(0, 1), cA + hstep, voffA);
        if (wr == 1) PG8_BAR;
        PG8_WAIT_V(2); PG8_BAR;
        PG8_STAGE(PG8_SB(1, 0), cB + kstep, voffB); PG8_STAGE(PG8_SA(1, 0), cA + kstep, voffA); PG8_STAGE(PG8_SB(1, 1), cB + hstep + kstep, voffB);
        PG8_WAIT_V(6); PG8_BAR;
    } else {
        PG8_STAGE(PG8_SB(0, 0), cB, voffB); PG8_STAGE(PG8_SA(0, 0), cA, voffA); PG8_STAGE(PG8_SB(0, 1), cB + hstep, voffB); PG8_STAGE(PG8_SA(0, 1), cA + hstep, voffA);
        if (wr == 1) PG8_BAR;
        PG8_WAIT_V(4); PG8_BAR;
        PG8_STAGE(PG8_SB(1, 0), cB + kstep, voffB); PG8_STAGE(PG8_SA(1, 0), cA + kstep, voffA); PG8_STAGE(PG8_SB(1, 1), cB + hstep + kstep, voffB);
        PG8_WAIT_V(6); PG8_BAR;
    }
    for (;;) {
        const bool has_next = S.next(ui + 1, nxt);
        const char* nA = has_next ? (const char*)g.A + (size_t)nxt.pm * tstep : cA; const char* nB = has_next ? (const char*)g.Bt + (size_t)nxt.pn * tstep : cB;
        for (int t = 0; t < nt; t += 2) {
            const bool last = (t == nt - 2);
            const char* a1 = cA + (size_t)(t + 1) * kstep;
            const char* a2 = last ? nA : cA + (size_t)(t + 2) * kstep; const char* b2 = last ? nB : cB + (size_t)(t + 2) * kstep;
            const char* a3 = a2 + kstep; const char* b3 = b2 + kstep;
            if (last && has_next) S.a_ready(nxt);
            if constexpr (SP2) {
            PG8_LDB(B0, 0, 0); PG8_LDB(B1, 0, 1); PG8_SCHED; PG8_LDA(At, 0, 0); PG8_STAGE(PG8_SA(1, 1), a1 + hstep, voffA);
            PG8_WAIT_V(8); PG8_WAIT_L(0); PG8_BAR; PG8_MMA(0, 0, At, B0); PG8_MMA(0, 1, At, B1); PG8_BAR; PG8_SCHED;
            PG8_LDA(At, 0, 1); PG8_STAGE(PG8_SB(0, 0), b2, voffB); PG8_STAGE(PG8_SB(0, 1), b2 + hstep, voffB); PG8_STAGE(PG8_SA(0, 0), a2, voffA);
            PG8_WAIT_V(8); PG8_WAIT_L(0); PG8_BAR; PG8_MMA(1, 0, At, B0); PG8_MMA(1, 1, At, B1); PG8_BAR; PG8_SCHED;
            PG8_LDB(B0, 1, 0); PG8_LDB(B1, 1, 1); PG8_SCHED; PG8_LDA(At, 1, 0); PG8_STAGE(PG8_SA(0, 1), a2 + hstep, voffA);
            PG8_WAIT_V(8); PG8_WAIT_L(0); PG8_BAR; PG8_MMA(0, 0, At, B0); PG8_MMA(0, 1, At, B1); PG8_BAR; PG8_SCHED;
            PG8_LDA(At, 1, 1); PG8_STAGE(PG8_SB(1, 0), b3, voffB); PG8_STAGE(PG8_SB(1, 1), b3 + hstep, voffB); PG8_STAGE(PG8_SA(1, 0), a3, voffA);
            PG8_WAIT_V(8); PG8_WAIT_L(0); PG8_BAR; PG8_MMA(1, 0, At, B0); PG8_MMA(1, 1, At, B1); PG8_BAR; PG8_SCHED;
            } else {
            PG8_LDB(B0, 0, 0); PG8_SCHED; PG8_LDA(At, 0, 0); PG8_STAGE(PG8_SA(1, 1), a1 + hstep, voffA);
            PG8_WAIT_L(8); PG8_BAR; PG8_WAIT_L(0); PG8_MMA(0, 0, At, B0); PG8_BAR; PG8_SCHED;
            PG8_LDB(B1, 0, 1); PG8_STAGE(PG8_SB(0, 0), b2, voffB);
            PG8_BAR; PG8_WAIT_L(0); PG8_MMA(0, 1, At, B1); PG8_BAR;
            PG8_LDA(At, 0, 1); PG8_STAGE(PG8_SA(0, 0), a2, voffA);
            PG8_BAR; PG8_WAIT_L(0); PG8_MMA(1, 0, At, B0); PG8_BAR; PG8_SCHED;
            PG8_STAGE(PG8_SB(0, 1), b2 + hstep, voffB);
            PG8_WAIT_V(6); PG8_BAR; PG8_MMA(1, 1, At, B1); PG8_BAR;
            PG8_LDB(B0, 1, 0); PG8_SCHED; PG8_LDA(At, 1, 0); PG8_STAGE(PG8_SA(0, 1), a2 + hstep, voffA);
            PG8_WAIT_L(8); PG8_BAR; PG8_WAIT_L(0); PG8_MMA(0, 0, At, B0); PG8_BAR; PG8_SCHED;
            PG8_LDB(B1, 1, 1); PG8_STAGE(PG8_SB(1, 0), b3, voffB);
            PG8_BAR; PG8_WAIT_L(0); PG8_MMA(0, 1, At, B1); PG8_BAR;
            PG8_LDA(At, 1, 1); PG8_STAGE(PG8_SA(1, 0), a3, voffA);
            PG8_BAR; PG8_WAIT_L(0); PG8_MMA(1, 0, At, B0); PG8_BAR; PG8_SCHED;
            PG8_STAGE(PG8_SB(1, 1), b3 + hstep, voffB);
            PG8_WAIT_V(6); PG8_BAR; PG8_MMA(1, 1, At, B1); PG8_BAR;
            }
        }
        if constexpr (ALIGN_EPI) { if (wr == 0) PG8_BAR; }
        if constexpr (!Epi::AFTER_DRAIN) { E(acc, cur, wr, wc, fr, fq); S.done(cur); }
        if (!has_next) break;
#pragma unroll
        for (int a = 0; a < 2; ++a)
#pragma unroll
            for (int b = 0; b < 2; ++b)
#pragma unroll
                for (int m = 0; m < 4; ++m)
#pragma unroll
                    for (int n = 0; n < 2; ++n) acc[a][b][m][n] = (f32x4){0.f, 0.f, 0.f, 0.f};
        cur = nxt; cA = nA; cB = nB; ++ui;
        if constexpr (ALIGN_EPI) { if (wr == 1) PG8_BAR; }
    }
    PG8_WAIT_V(0);
    if constexpr (!ALIGN_EPI) { if (wr == 0) PG8_BAR; }
    PG8_BAR;
    if constexpr (Epi::AFTER_DRAIN) { E.fused(acc, cur, wr, wc, fr, fq, lds, wid, lane); S.done(cur); }
#undef PG8_SA
#undef PG8_SB
#undef PG8_STAGE
#undef PG8_LDA
#undef PG8_LDB
#undef PG8_MMA
#undef PG8_WAIT_V
#undef PG8_WAIT_L
#undef PG8_BAR
#undef PG8_SCHED
}
}

#define LAS __attribute__((address_space(3)))
typedef unsigned short u16;
typedef short bf16x8 __attribute__((ext_vector_type(8)));
typedef short s16x4 __attribute__((ext_vector_type(4)));
typedef float f32x4 __attribute__((ext_vector_type(4)));
typedef float f32x2 __attribute__((ext_vector_type(2)));
typedef unsigned u32x4 __attribute__((ext_vector_type(4)));
typedef unsigned u32x2 __attribute__((ext_vector_type(2)));

constexpr int TT = 16384, DM = 1024, SEQ = 2048, NIN = 11264;
constexpr int ZBP = 4608;
constexpr size_t MiB = 1u << 20;
constexpr size_t WS_WT = 0;
constexpr size_t WS_WA = 22 * MiB, WS_WB = 24 * MiB, WS_WO = 25 * MiB;
constexpr size_t WS_COS = 27 * MiB, WS_SIN = 29 * MiB;
constexpr size_t WS_H = 32 * MiB;
constexpr size_t WS_Z = 64 * MiB;
constexpr size_t Z_QA = WS_Z, Z_G = WS_Z + 32 * MiB, Z_VA = WS_Z + 64 * MiB, Z_HG = WS_Z + 96 * MiB, Z_GATES = WS_Z + 128 * MiB;
constexpr size_t Z_TMP = WS_Z, Z_MERGED = WS_Z + 64 * MiB;
constexpr size_t WS_END = 256 * MiB;
constexpr size_t DO_OG = 0, DO_AG = 48 * MiB;
constexpr int LDS_BYTES = 147456;
constexpr float NORM_EPS = 1e-6f;

__device__ __forceinline__ unsigned pk_bf16(float lo, float hi) { typedef __bf16 b2 __attribute__((ext_vector_type(2))); f32x2 v = {lo, hi}; b2 b = __builtin_convertvector(v, b2); return __builtin_bit_cast(unsigned, b); }
__device__ __forceinline__ unsigned pk_f16(float lo, float hi) { typedef _Float16 h2 __attribute__((ext_vector_type(2))); h2 h = {(_Float16)lo, (_Float16)hi}; return __builtin_bit_cast(unsigned, h); }
__device__ __forceinline__ float bflo(unsigned u) { return __uint_as_float(u << 16); }
__device__ __forceinline__ float bfhi(unsigned u) { return __uint_as_float(u & 0xffff0000u); }
__device__ __forceinline__ float f16lo(unsigned u) { return (float)__builtin_bit_cast(_Float16, (unsigned short)(u & 0xffffu)); }
__device__ __forceinline__ float f16hi(unsigned u) { return (float)__builtin_bit_cast(_Float16, (unsigned short)(u >> 16)); }
__device__ __forceinline__ float sigm(float x) { return __builtin_amdgcn_rcpf(1.0f + __expf(-x)); }
__device__ __forceinline__ s16x4 ds_tr(const LAS u16* p) { typedef short v4 __attribute__((ext_vector_type(4))); return __builtin_bit_cast(s16x4, __builtin_amdgcn_ds_read_tr16_b64_v4i16((LAS v4*)p)); }
__device__ __forceinline__ bf16x8 cat8(s16x4 lo, s16x4 hi) { return (bf16x8){lo[0], lo[1], lo[2], lo[3], hi[0], hi[1], hi[2], hi[3]}; }
__device__ __forceinline__ f32x4 mfma16(bf16x8 a, bf16x8 b, f32x4 c) { return __builtin_amdgcn_mfma_f32_16x16x32_bf16(a, b, c, 0, 0, 0); }
__device__ __forceinline__ float wave_sum(float v) {
#pragma unroll
    for (int o = 1; o < 64; o <<= 1) v += __shfl_xor(v, o);
    return v;
}

using pg8::Unit;
template <int ACT  > __device__ __forceinline__ float act1(float v) { if (ACT == 1) return v * sigm(v); if (ACT == 2) return sigm(v); return v; }
template <int ACT> __device__ __forceinline__ void epi_store16(const f32x4 (&acc)[2][2][4][2], u16* base, int pitch, int row0, int col0) {
#pragma unroll
    for (int ai = 0; ai < 2; ++ai)
#pragma unroll
        for (int m = 0; m < 4; ++m) { u16* rowp = base + (size_t)(row0 + ai * 128 + m * 16) * pitch + col0;
#pragma unroll
            for (int bj = 0; bj < 2; ++bj) { const f32x4 v0 = acc[ai][bj][m][0], v1 = acc[ai][bj][m][1]; u32x4 w;
                w.x = pk_bf16(act1<ACT>(v0[0]), act1<ACT>(v0[1])); w.y = pk_bf16(act1<ACT>(v0[2]), act1<ACT>(v0[3]));
                w.z = pk_bf16(act1<ACT>(v1[0]), act1<ACT>(v1[1])); w.w = pk_bf16(act1<ACT>(v1[2]), act1<ACT>(v1[3]));
                *(u32x4*)(rowp + bj * 128) = w; } }
}
struct EpiZ {
    static constexpr bool PERM = true, AFTER_DRAIN = false;
    int mode;
    unsigned char* ws; unsigned char* dout; const float* lbl;
    __device__ __forceinline__ void operator()(const f32x4 (&acc)[2][2][4][2], const Unit& u, int wr, int wc, int fr, int fq) const {
        const int pn = u.pn, row0 = u.pm * 256 + wr * 64 + fr, lc = wc * 32 + 8 * fq;
        if (mode == 0) {
            u16* ZB = (u16*)(ws + WS_Z);
            if (pn < 12) {
                const float sc = (pn < 6) ? 0.125f * 1.4426950408889634f : 1.0f;
                const float* cosT = (const float*)(ws + WS_COS); const float* sinT = (const float*)(ws + WS_SIN);
                const int jb = 16 * (wc & 1) + 4 * fq;
#pragma unroll
                for (int ai = 0; ai < 2; ++ai)
#pragma unroll
                    for (int m = 0; m < 4; ++m) { const int row = row0 + ai * 128 + m * 16;
                        const f32x4 c = *(const f32x4*)(cosT + (size_t)row * 32 + jb), s = *(const f32x4*)(sinT + (size_t)row * 32 + jb);
                        u16* rowp = ZB + (size_t)row * ZBP + pn * 256 + lc;
#pragma unroll
                        for (int bj = 0; bj < 2; ++bj) { const f32x4 v0 = acc[ai][bj][m][0], v1 = acc[ai][bj][m][1]; u32x4 w;
                            w.x = pk_bf16((v0[0] * c[0] - v0[1] * s[0]) * sc, (v0[1] * c[0] + v0[0] * s[0]) * sc);
                            w.y = pk_bf16((v0[2] * c[1] - v0[3] * s[1]) * sc, (v0[3] * c[1] + v0[2] * s[1]) * sc);
                            w.z = pk_bf16((v1[0] * c[2] - v1[1] * s[2]) * sc, (v1[1] * c[2] + v1[0] * s[2]) * sc);
                            w.w = pk_bf16((v1[2] * c[3] - v1[3] * s[3]) * sc, (v1[3] * c[3] + v1[2] * s[3]) * sc);
                            *(u32x4*)(rowp + bj * 128) = w; } }
            } else if (pn < 18) epi_store16<0>(acc, ZB, ZBP, row0, pn * 256 + lc);
            else epi_store16<1>(acc, (u16*)(dout + DO_AG), 512, row0, (pn - 18) * 256 + lc);
        } else {
            if (pn < 4) epi_store16<1>(acc, (u16*)(ws + Z_QA), 1024, row0, pn * 256 + lc);
            else if (pn < 8) {
                const int cb = (pn - 4) * 256 + lc; float lb[2][8];
#pragma unroll
                for (int bj = 0; bj < 2; ++bj)
#pragma unroll
                    for (int e = 0; e < 8; ++e) { const int idx = cb + bj * 128 + e; lb[bj][e] = 1.0f / (1.0f + __expf(lbl[1024 + idx] - lbl[idx])); }
                u16* G = (u16*)(ws + Z_G);
#pragma unroll
                for (int ai = 0; ai < 2; ++ai)
#pragma unroll
                    for (int m = 0; m < 4; ++m) { u16* rowp = G + (size_t)(row0 + ai * 128 + m * 16) * 1024 + cb;
#pragma unroll
                        for (int bj = 0; bj < 2; ++bj) { const f32x4 v0 = acc[ai][bj][m][0], v1 = acc[ai][bj][m][1]; float g[8];
#pragma unroll
                            for (int e = 0; e < 8; ++e) { const float v = e < 4 ? v0[e & 3] : v1[e & 3]; g[e] = __logf(lb[bj][e] + (1.0f - lb[bj][e]) * sigm(v)); }
                            u32x4 w; w.x = pk_f16(g[0], g[1]); w.y = pk_f16(g[2], g[3]); w.z = pk_f16(g[4], g[5]); w.w = pk_f16(g[6], g[7]);
                            *(u32x4*)(rowp + bj * 128) = w; } }
            } else if (pn < 12) epi_store16<0>(acc, (u16*)(ws + Z_VA), 1024, row0, (pn - 8) * 256 + lc);
            else if (pn < 16) epi_store16<1>(acc, (u16*)(ws + Z_HG), 1024, row0, (pn - 12) * 256 + lc);
            else epi_store16<2>(acc, (u16*)(ws + Z_GATES), 2048, row0, (pn - 16) * 256 + lc);
        }
    }
};
struct EpiGateA {
    static constexpr bool PERM = true, AFTER_DRAIN = false;
    const u16* gates; float* tmp;
    __device__ __forceinline__ void operator()(const f32x4 (&acc)[2][2][4][2], const Unit& u, int wr, int wc, int fr, int fq) const {
        const int row0 = u.pm * 256 + wr * 64 + fr, col0 = u.pn * 256 + wc * 32 + 8 * fq;
#pragma unroll
        for (int ai = 0; ai < 2; ++ai)
#pragma unroll
            for (int m = 0; m < 4; ++m) { const size_t row = row0 + ai * 128 + m * 16;
#pragma unroll
                for (int bj = 0; bj < 2; ++bj) { const int col = col0 + bj * 128; const u32x4 g = *(const u32x4*)(gates + row * 2048 + col);
                    const f32x4 v0 = acc[ai][bj][m][0], v1 = acc[ai][bj][m][1];
                    *(f32x4*)(tmp + row * 1024 + col) = (f32x4){v0[0] * bflo(g.x), v0[1] * bfhi(g.x), v0[2] * bflo(g.y), v0[3] * bfhi(g.y)};
                    *(f32x4*)(tmp + row * 1024 + col + 4) = (f32x4){v1[0] * bflo(g.z), v1[1] * bfhi(g.z), v1[2] * bflo(g.w), v1[3] * bfhi(g.w)}; } }
    }
};
struct EpiGateB {
    static constexpr bool PERM = true, AFTER_DRAIN = false;
    const u16* gates; const float* tmp; u16* merged;
    __device__ __forceinline__ void operator()(const f32x4 (&acc)[2][2][4][2], const Unit& u, int wr, int wc, int fr, int fq) const {
        const int row0 = u.pm * 256 + wr * 64 + fr, col0 = u.pn * 256 + wc * 32 + 8 * fq;
#pragma unroll
        for (int ai = 0; ai < 2; ++ai)
#pragma unroll
            for (int m = 0; m < 4; ++m) { const size_t row = row0 + ai * 128 + m * 16;
#pragma unroll
                for (int bj = 0; bj < 2; ++bj) { const int col = col0 + bj * 128; const u32x4 g = *(const u32x4*)(gates + row * 2048 + 1024 + col);
                    const f32x4 t0 = *(const f32x4*)(tmp + row * 1024 + col), t1 = *(const f32x4*)(tmp + row * 1024 + col + 4);
                    const f32x4 v0 = acc[ai][bj][m][0], v1 = acc[ai][bj][m][1]; u32x4 w;
                    w.x = pk_bf16(t0[0] + v0[0] * bflo(g.x), t0[1] + v0[1] * bfhi(g.x)); w.y = pk_bf16(t0[2] + v0[2] * bflo(g.y), t0[3] + v0[3] * bfhi(g.y));
                    w.z = pk_bf16(t1[0] + v1[0] * bflo(g.z), t1[1] + v1[1] * bfhi(g.z)); w.w = pk_bf16(t1[2] + v1[2] * bflo(g.w), t1[3] + v1[3] * bfhi(g.w));
                    *(u32x4*)(merged + row * 1024 + col) = w; } }
    }
};
struct EpiOut {
    static constexpr bool PERM = true, AFTER_DRAIN = false;
    const float* x; float* out;
    __device__ __forceinline__ void operator()(const f32x4 (&acc)[2][2][4][2], const Unit& u, int wr, int wc, int fr, int fq) const {
        const int row0 = u.pm * 256 + wr * 64 + fr, col0 = u.pn * 256 + wc * 32 + 8 * fq;
#pragma unroll
        for (int ai = 0; ai < 2; ++ai)
#pragma unroll
            for (int m = 0; m < 4; ++m) { const size_t row = row0 + ai * 128 + m * 16;
#pragma unroll
                for (int bj = 0; bj < 2; ++bj) { const size_t o = row * 1024 + col0 + bj * 128;
                    *(f32x4*)(out + o) = *(const f32x4*)(x + o) + acc[ai][bj][m][0]; *(f32x4*)(out + o + 4) = *(const f32x4*)(x + o + 4) + acc[ai][bj][m][1]; } }
    }
};

__device__ __forceinline__ int wt_row_of_col(int n) {
    if (n < 4096) return n;
    if (n >= 9216) return 4096 + (n - 9216);
    int a = n - 4096;
    if (a < 3072) { const int e = a & 63; a = (a - e) + (e < 32 ? 2 * e : 2 * (e - 32) + 1); }
    return 6144 + a;
}
template <bool MAP> __device__ __forceinline__ void p0_transpose_item(const float* W, int K, int N, u16* WT, LAS float* scr, int item, int lane) {
    const int nblk = N / 32, kb = item / nblk, nb = item % nblk, k0 = 64 * kb, n0 = 32 * nb;
#pragma unroll 8
    for (int i = 0; i < 32; ++i) { const int kk = 2 * i + (lane >> 5); scr[kk * 33 + (lane & 31)] = W[(size_t)(k0 + kk) * N + n0 + (lane & 31)]; }
    asm volatile("s_waitcnt lgkmcnt(0)" ::: "memory");
    const int c = lane & 7;
#pragma unroll
    for (int j = 0; j < 4; ++j) { const int n = (lane >> 3) + 8 * j; const LAS float* s = scr + (8 * c) * 33 + n;
        u32x4 o; o.x = pk_bf16(s[0 * 33], s[1 * 33]); o.y = pk_bf16(s[2 * 33], s[3 * 33]); o.z = pk_bf16(s[4 * 33], s[5 * 33]); o.w = pk_bf16(s[6 * 33], s[7 * 33]);
        const int r = MAP ? wt_row_of_col(n0 + n) : (n0 + n);
        *(u32x4*)(WT + (size_t)r * K + k0 + 8 * c) = o; }
    asm volatile("s_waitcnt lgkmcnt(0)" ::: "memory");
}
struct Ptrs { const float* x; const int* pos; const float* norm_w; const float* w_in; const float* lbl; const float* hnw; const float* wa; const float* wb; const float* wo; const float* fnw; float* out; unsigned char* ws; };

__device__ __forceinline__ void p0_prologue(const Ptrs& P, LAS unsigned char* lds, int vcu, int G) {
    const int tid = threadIdx.x, lane = tid & 63, wave = __builtin_amdgcn_readfirstlane(tid >> 6);
    LAS float* scr = (LAS float*)(lds + wave * 16384);
    const int gw = vcu * 8 + wave, NGW = G * 8;
    constexpr int I_IN = 16 * (NIN / 32), I_A = 16 * 32, I_B = 8 * 32, I_O = 16 * 32, NITEMS = I_IN + I_A + I_B + I_O;
    for (int it = gw; it < NITEMS; it += NGW) {
        int r = it;
        if (r < I_IN) { p0_transpose_item<true>(P.w_in, 1024, NIN, (u16*)(P.ws + WS_WT), scr, r, lane); continue; } r -= I_IN;
        if (r < I_A) { p0_transpose_item<false>(P.wa, 1024, 1024, (u16*)(P.ws + WS_WA), scr, r, lane); continue; } r -= I_A;
        if (r < I_B) { p0_transpose_item<false>(P.wb, 512, 1024, (u16*)(P.ws + WS_WB), scr, r, lane); continue; } r -= I_B;
        p0_transpose_item<false>(P.wo, 1024, 1024, (u16*)(P.ws + WS_WO), scr, r, lane);
    }
    u16* H = (u16*)(P.ws + WS_H);
    for (int m = gw; m < TT; m += NGW) {
        const f32x4* xr = (const f32x4*)(P.x + (size_t)m * DM) + lane; f32x4 v[4]; float s = 0.f;
#pragma unroll
        for (int j = 0; j < 4; ++j) { v[j] = xr[64 * j]; s += (v[j].x * v[j].x + v[j].y * v[j].y) + (v[j].z * v[j].z + v[j].w * v[j].w); }
        const float rstd = rsqrtf(wave_sum(s) * (1.0f / DM) + NORM_EPS);
        u32x2* o8 = (u32x2*)(H + (size_t)m * DM) + lane;
#pragma unroll
        for (int j = 0; j < 4; ++j) { const f32x4 w4 = ((const f32x4*)P.norm_w)[lane + 64 * j];
            o8[64 * j] = (u32x2){pk_bf16(v[j].x * rstd * w4.x, v[j].y * rstd * w4.y), pk_bf16(v[j].z * rstd * w4.z, v[j].w * rstd * w4.w)}; }
    }
    float* cosT = (float*)(P.ws + WS_COS); float* sinT = (float*)(P.ws + WS_SIN);
    for (int e = (vcu * 512 + tid); e < TT * 32; e += G * 512) {
        const int row = e >> 5, j = e & 31;
        const float inv = exp2f(-(float)j * (13.287712379549449f / 32.0f));
        const float ang = (float)P.pos[row] * inv;
        const double rev = (double)ang * 0.15915494309189535; const float fr = (float)(rev - __builtin_rint(rev));
        cosT[e] = __builtin_amdgcn_cosf(fr); sinT[e] = __builtin_amdgcn_sinf(fr);
    }
}

__device__ __forceinline__ void attn_phase(LAS unsigned char* lds, const u16* ZB, u16* OG, float* LSE, int bid, int G) {
    const int tid = threadIdx.x, lane = tid & 63, w = __builtin_amdgcn_readfirstlane(tid >> 6), l15 = lane & 15, q4 = lane >> 4;
    constexpr int KP = 72;
    LAS u16* KI = (LAS u16*)lds; LAS u16* VI = (LAS u16*)(lds + 256 * KP * 2);
    for (int un = bid; un < 3072; un += G) {
        const int b = un / 384, rem = un % 384, g = rem >> 7, h = (rem >> 4) & 7, rc = rem & 15;
        const int d = (g == 0) ? 1 : (g == 1 ? 4 : 16), r = rc % d, c = rc / d;
        const size_t tb = (size_t)b * SEQ;
#pragma unroll
        for (int i = 0; i < 4; ++i) { const int id = tid + 512 * i, j = id >> 3, ch = id & 7, mp = 128 * c - 128 + j;
            u32x4 kv = (u32x4){0u, 0u, 0u, 0u}, vv = (u32x4){0u, 0u, 0u, 0u};
            if (mp >= 0) { const u16* p = ZB + (tb + (size_t)mp * d + r) * ZBP + g * 512 + h * 64 + 8 * ch; kv = *(const u32x4*)(p + 1536); vv = *(const u32x4*)(p + 3072); }
            *(LAS u32x4*)(KI + j * KP + 8 * ch) = kv; *(LAS u32x4*)(VI + j * KP + 8 * ch) = vv; }
        const size_t tq = tb + (size_t)(128 * c + 16 * w + l15) * d + r;
        bf16x8 qf[2];
#pragma unroll
        for (int ds = 0; ds < 2; ++ds) qf[ds] = *(const bf16x8*)(ZB + tq * ZBP + g * 512 + h * 64 + 32 * ds + 8 * q4);
        __syncthreads();
        const int a0 = w >> 1, iq = 16 * w + l15;
        f32x4 st[5][2]; float mx = -INFINITY;
#pragma unroll
        for (int p = 0; p < 5; ++p) { const int a = a0 + p; const bool on = (a <= 7) && !(c == 0 && a < 4);
#pragma unroll
            for (int t = 0; t < 2; ++t) { f32x4 s = (f32x4){0.f, 0.f, 0.f, 0.f};
                if (on) { const int jt = 2 * a + t;
#pragma unroll
                    for (int ds = 0; ds < 2; ++ds) { const bf16x8 kf = *(const LAS bf16x8*)(KI + (16 * jt + l15) * KP + 32 * ds + 8 * q4); s = mfma16(kf, qf[ds], s); }
#pragma unroll
                    for (int i = 0; i < 4; ++i) { const int dist = iq + 128 - (16 * jt + 4 * q4 + i); s[i] = (dist >= 0 && dist <= 128) ? s[i] : -INFINITY; mx = fmaxf(mx, s[i]); }
                } else s = (f32x4){-INFINITY, -INFINITY, -INFINITY, -INFINITY};
                st[p][t] = s; } }
        mx = fmaxf(mx, __shfl_xor(mx, 16)); mx = fmaxf(mx, __shfl_xor(mx, 32));
        float l = 0.f; bf16x8 pf[5];
#pragma unroll
        for (int p = 0; p < 5; ++p) { float e[8];
#pragma unroll
            for (int t = 0; t < 2; ++t)
#pragma unroll
                for (int i = 0; i < 4; ++i) { e[4 * t + i] = __builtin_amdgcn_exp2f(st[p][t][i] - mx); l += e[4 * t + i]; }
            u32x4 pw; pw.x = pk_bf16(e[0], e[1]); pw.y = pk_bf16(e[2], e[3]); pw.z = pk_bf16(e[4], e[5]); pw.w = pk_bf16(e[6], e[7]); pf[p] = __builtin_bit_cast(bf16x8, pw); }
        l += __shfl_xor(l, 16); l += __shfl_xor(l, 32);
        f32x4 o[4];
#pragma unroll
        for (int dt = 0; dt < 4; ++dt) o[dt] = (f32x4){0.f, 0.f, 0.f, 0.f};
#pragma unroll
        for (int p = 0; p < 5; ++p) { const int a = a0 + p; const bool on = (a <= 7) && !(c == 0 && a < 4);
            if (on) {
#pragma unroll
                for (int dt = 0; dt < 4; ++dt) { const LAS u16* vp = VI + (32 * a + 4 * q4 + (l15 >> 2)) * KP + 16 * dt + 4 * (l15 & 3);
                    const s16x4 lo = ds_tr(vp), hi = ds_tr(vp + 16 * KP); o[dt] = mfma16(cat8(lo, hi), pf[p], o[dt]); } } }
        const float il = 1.0f / l;
        u16* og = OG + (size_t)g * TT * 512 + tq * 512 + h * 64 + 4 * q4;
#pragma unroll
        for (int dt = 0; dt < 4; ++dt) *(u32x2*)(og + 16 * dt) = (u32x2){pk_bf16(o[dt][0] * il, o[dt][1] * il), pk_bf16(o[dt][2] * il, o[dt][3] * il)};
        if (q4 == 0) LSE[(size_t)g * TT * 8 + tq * 8 + h] = mx + __log2f(l);
        __syncthreads();
    }
}
__device__ __forceinline__ void merge_phase(u16* OG, const float* LSE, const u16* AG, int bid, int nb) {
    for (int idx = bid * 512 + threadIdx.x; idx < TT * 64; idx += nb * 512) {
        const int tok = idx >> 6, h = (idx >> 3) & 7, ch = idx & 7; const size_t off = (size_t)tok * 512 + h * 64 + 8 * ch;
        const float l0 = LSE[(size_t)tok * 8 + h], l1 = LSE[(size_t)TT * 8 + (size_t)tok * 8 + h], l2 = LSE[(size_t)2 * TT * 8 + (size_t)tok * 8 + h];
        const float m = fmaxf(l0, fmaxf(l1, l2)); float w0 = __builtin_amdgcn_exp2f(l0 - m), w1 = __builtin_amdgcn_exp2f(l1 - m), w2 = __builtin_amdgcn_exp2f(l2 - m);
        const float inv = 1.0f / (w0 + w1 + w2); w0 *= inv; w1 *= inv; w2 *= inv;
        const u32x4 a = *(const u32x4*)(OG + off), bq = *(const u32x4*)(OG + (size_t)TT * 512 + off), cq = *(const u32x4*)(OG + (size_t)2 * TT * 512 + off), gq = *(const u32x4*)(AG + off);
        u32x4 o;
#define MRG(F) o.F = pk_bf16((w0 * bflo(a.F) + w1 * bflo(bq.F) + w2 * bflo(cq.F)) * bflo(gq.F), (w0 * bfhi(a.F) + w1 * bfhi(bq.F) + w2 * bfhi(cq.F)) * bfhi(gq.F))
        MRG(x); MRG(y); MRG(z); MRG(w);
#undef MRG
        *(u32x4*)(OG + off) = o;
    }
}

__device__ __forceinline__ void hgrn_unit(LAS unsigned char* lds, int b, int h, const u16* QA, const u16* GG, const u16* VA, const u16* HG, const float* nw, u16* OA) {
    const int tid = threadIdx.x, lane = tid & 63, w = __builtin_amdgcn_readfirstlane(tid >> 6), l15 = lane & 15, q4 = lane >> 4;
    constexpr int P = 136;
    LAS u16* QM = (LAS u16*)(lds); LAS u16* Q0 = (LAS u16*)(lds + 17408); LAS u16* KM = (LAS u16*)(lds + 34816); LAS u16* VI = (LAS u16*)(lds + 52224); LAS u16* SB = (LAS u16*)(lds + 69632);
    LAS float* TOT = (LAS float*)(lds + 104448); LAS float* DF = (LAS float*)(lds + 108544); LAS float* SSQ = (LAS float*)(lds + 109568);
    for (int i = tid; i < 128 * P / 2; i += 512) ((LAS unsigned*)SB)[i] = 0u;
    f32x4 S[8];
#pragma unroll
    for (int i = 0; i < 8; ++i) S[i] = (f32x4){0.f, 0.f, 0.f, 0.f};
    const int kp = lane, seg = w, tt = w >> 1, vh = w & 1;
    const size_t tok0 = (size_t)b * SEQ;
    unsigned gq[8], qq[8]; u32x4 vv[2];
#define HG_LOAD(c) do { const size_t t0_ = tok0 + 64 * (c); \
        _Pragma("unroll") for (int i = 0; i < 8; ++i) { const size_t o_ = (t0_ + 8 * seg + i) * 1024 + h * 128 + 2 * kp; gq[i] = *(const unsigned*)(GG + o_); qq[i] = *(const unsigned*)(QA + o_); } \
        _Pragma("unroll") for (int u_ = 0; u_ < 2; ++u_) { const int id_ = tid + 512 * u_; vv[u_] = *(const u32x4*)(VA + (t0_ + (id_ >> 4)) * 1024 + h * 128 + 8 * (id_ & 15)); } } while (0)
    HG_LOAD(0);
    for (int c = 0; c < 32; ++c) {
        float cs0[8], cs1[8]; { float r0 = 0.f, r1 = 0.f;
#pragma unroll
            for (int i = 0; i < 8; ++i) { r0 += f16lo(gq[i]); r1 += f16hi(gq[i]); cs0[i] = r0; cs1[i] = r1; }
            *(LAS f32x2*)(TOT + seg * 128 + 2 * kp) = (f32x2){r0, r1}; }
        __syncthreads();
        float off0 = 0.f, off1 = 0.f, br0 = 0.f, br1 = 0.f, bl0 = 0.f, bl1 = 0.f;
#pragma unroll
        for (int s2 = 0; s2 < 8; ++s2) { const f32x2 t = *(const LAS f32x2*)(TOT + s2 * 128 + 2 * kp);
            if (s2 < seg) { off0 += t.x; off1 += t.y; } if (s2 < 4) { br0 += t.x; br1 += t.y; } bl0 += t.x; bl1 += t.y; }
#pragma unroll
        for (int i = 0; i < 8; ++i) { const int s = 8 * seg + i; const float b0 = off0 + cs0[i], b1 = off1 + cs1[i];
            const float k0 = 1.0f - __expf(f16lo(gq[i])), k1 = 1.0f - __expf(f16hi(gq[i])); const float q0v = bflo(qq[i]), q1v = bfhi(qq[i]);
            *(LAS unsigned*)(QM + s * P + 2 * kp) = pk_bf16(q0v * __expf(fminf(b0 - br0, 80.f)), q1v * __expf(fminf(b1 - br1, 80.f)));
            *(LAS unsigned*)(Q0 + s * P + 2 * kp) = pk_bf16(q0v * __expf(b0), q1v * __expf(b1));
            *(LAS unsigned*)(KM + s * P + 2 * kp) = pk_bf16(k0 * __expf(fminf(br0 - b0, 80.f)), k1 * __expf(fminf(br1 - b1, 80.f))); }
        if (seg == 0) { *(LAS f32x2*)(DF + 2 * kp) = (f32x2){__expf(bl0), __expf(bl1)}; *(LAS f32x2*)(DF + 128 + 2 * kp) = (f32x2){__expf(bl0 - br0), __expf(bl1 - br1)}; }
#pragma unroll
        for (int u = 0; u < 2; ++u) { const int id = tid + 512 * u; *(LAS u32x4*)(VI + (id >> 4) * P + 8 * (id & 15)) = vv[u]; }
        const size_t tokq = tok0 + 64 * c + 16 * tt + l15;
        u32x2 hgv[4];
#pragma unroll
        for (int j = 0; j < 4; ++j) hgv[j] = *(const u32x2*)(HG + tokq * 1024 + h * 128 + 16 * (4 * vh + j) + 4 * q4);
        if (c + 1 < 32) HG_LOAD(c + 1);
        __syncthreads();
        bf16x8 qm[4], q0[4];
#pragma unroll
        for (int ks = 0; ks < 4; ++ks) { qm[ks] = *(const LAS bf16x8*)(QM + (16 * tt + l15) * P + 32 * ks + 8 * q4); q0[ks] = *(const LAS bf16x8*)(Q0 + (16 * tt + l15) * P + 32 * ks + 8 * q4); }
        f32x4 Dm[4];
#pragma unroll
        for (int st = 0; st < 4; ++st) { Dm[st] = (f32x4){0.f, 0.f, 0.f, 0.f};
            if (st <= tt) {
#pragma unroll
                for (int ks = 0; ks < 4; ++ks) { const bf16x8 kf = *(const LAS bf16x8*)(KM + (16 * st + l15) * P + 32 * ks + 8 * q4); Dm[st] = mfma16(kf, qm[ks], Dm[st]); }
                if (st == tt) {
#pragma unroll
                    for (int i = 0; i < 4; ++i) if (4 * q4 + i > l15) Dm[st][i] = 0.f; } } }
        bf16x8 pf[2];
#pragma unroll
        for (int a = 0; a < 2; ++a) { u32x4 pw; pw.x = pk_bf16(Dm[2 * a][0], Dm[2 * a][1]); pw.y = pk_bf16(Dm[2 * a][2], Dm[2 * a][3]); pw.z = pk_bf16(Dm[2 * a + 1][0], Dm[2 * a + 1][1]); pw.w = pk_bf16(Dm[2 * a + 1][2], Dm[2 * a + 1][3]); pf[a] = __builtin_bit_cast(bf16x8, pw); }
        f32x4 O[4];
#pragma unroll
        for (int j = 0; j < 4; ++j) { const int vt = 4 * vh + j; f32x4 o = (f32x4){0.f, 0.f, 0.f, 0.f};
#pragma unroll
            for (int a = 0; a < 2; ++a) if (2 * a <= tt) { const LAS u16* vp = VI + (32 * a + 4 * q4 + (l15 >> 2)) * P + 16 * vt + 4 * (l15 & 3);
                const s16x4 lo = ds_tr(vp), hi = ds_tr(vp + 16 * P); o = mfma16(cat8(lo, hi), pf[a], o); }
#pragma unroll
            for (int ks = 0; ks < 4; ++ks) { const bf16x8 sf = *(const LAS bf16x8*)(SB + (16 * vt + l15) * P + 32 * ks + 8 * q4); o = mfma16(sf, q0[ks], o); }
            O[j] = o; }
        { bf16x8 ka[2];
#pragma unroll
            for (int a = 0; a < 2; ++a) { const LAS u16* kpp = KM + (32 * a + 8 * q4 + (l15 >> 2)) * P + 16 * w + 4 * (l15 & 3); const s16x4 lo = ds_tr(kpp), hi = ds_tr(kpp + 4 * P); ka[a] = cat8(lo, hi); }
            const f32x4 d1 = *(const LAS f32x4*)(DF + 16 * w + 4 * q4), d2 = *(const LAS f32x4*)(DF + 128 + 16 * w + 4 * q4);
#pragma unroll
            for (int vt = 0; vt < 8; ++vt) { f32x4 U = (f32x4){0.f, 0.f, 0.f, 0.f};
#pragma unroll
                for (int a = 0; a < 2; ++a) { const LAS u16* vp = VI + (32 * a + 8 * q4 + (l15 >> 2)) * P + 16 * vt + 4 * (l15 & 3); const s16x4 lo = ds_tr(vp), hi = ds_tr(vp + 4 * P); U = mfma16(ka[a], cat8(lo, hi), U); }
                S[vt] = d1 * S[vt] + d2 * U; } }
        { float sq = 0.f;
#pragma unroll
            for (int j = 0; j < 4; ++j) sq += (O[j][0] * O[j][0] + O[j][1] * O[j][1]) + (O[j][2] * O[j][2] + O[j][3] * O[j][3]);
            sq += __shfl_xor(sq, 16); sq += __shfl_xor(sq, 32);
            if (q4 == 0) SSQ[(tt * 2 + vh) * 16 + l15] = sq; }
        __syncthreads();
#pragma unroll
        for (int vt = 0; vt < 8; ++vt) *(LAS u32x2*)(SB + (16 * vt + l15) * P + 16 * w + 4 * q4) = (u32x2){pk_bf16(S[vt][0], S[vt][1]), pk_bf16(S[vt][2], S[vt][3])};
        const float scale = rsqrtf((SSQ[(tt * 2) * 16 + l15] + SSQ[(tt * 2 + 1) * 16 + l15]) * (1.0f / 128.0f) + NORM_EPS);
#pragma unroll
        for (int j = 0; j < 4; ++j) { const int v0 = 16 * (4 * vh + j) + 4 * q4; const f32x4 n4 = *(const f32x4*)(nw + v0);
            *(u32x2*)(OA + tokq * 1024 + h * 128 + v0) = (u32x2){pk_bf16(O[j][0] * scale * n4[0] * bflo(hgv[j].x), O[j][1] * scale * n4[1] * bfhi(hgv[j].x)),
                                                                 pk_bf16(O[j][2] * scale * n4[2] * bflo(hgv[j].y), O[j][3] * scale * n4[3] * bfhi(hgv[j].y))}; }
    }
#undef HG_LOAD
    __syncthreads();
}

struct Args { const float* in[10]; float* out; unsigned char* ws; int ph_lo, ph_hi; };
__global__ void __launch_bounds__(512, 2) fwd_megakernel(Args a) {
    extern __shared__ __attribute__((aligned(16))) unsigned char lds_raw[];
    LAS unsigned char* lds = (LAS unsigned char*)lds_raw;
    cg::grid_group grid = cg::this_grid();
    const int G = gridDim.x, bx = blockIdx.x, vcu = (G % 8 == 0) ? (bx % 8) * (G / 8) + bx / 8 : bx;
    const int tid = threadIdx.x, lane = tid & 63, wave = __builtin_amdgcn_readfirstlane(tid >> 6);
    Ptrs P; P.x = a.in[0]; P.pos = (const int*)a.in[1]; P.norm_w = a.in[2]; P.w_in = a.in[3]; P.lbl = a.in[4]; P.hnw = a.in[5]; P.wa = a.in[6]; P.wb = a.in[7]; P.wo = a.in[8]; P.fnw = a.in[9];
    P.out = a.out; P.ws = a.ws;
    unsigned char* ws = a.ws; unsigned char* dout = (unsigned char*)a.out;
    const int lo = a.ph_lo, hi = a.ph_hi;
#define IN(k) (lo <= (k) && (k) < hi)
#define SEAM(k) do { if (IN(k) && IN((k) + 1)) grid.sync(); } while (0)
    if (IN(0)) p0_prologue(P, lds, vcu, G);
    SEAM(0);
    if (IN(1)) { pg8::Gemm g{(const u16*)(ws + WS_H), (const u16*)(ws + WS_WT) + (size_t)6144 * 1024, TT, 5120, 1024}; pg8::StaticOrder S; S.init(TT, 5120, G, bx);
        EpiZ E{0, ws, dout, P.lbl}; pg8::gemm_phase<EpiZ, pg8::StaticOrder, true, true>(lds, g, S, E); }
    SEAM(1);
    if (IN(2)) attn_phase(lds, (const u16*)(ws + WS_Z), (u16*)(dout + DO_OG), (float*)(ws + WS_COS), bx, G);
    SEAM(2);
    if (IN(3)) { pg8::Gemm g{(const u16*)(ws + WS_H), (const u16*)(ws + WS_WT), TT, 6144, 1024}; pg8::StaticOrder S; S.init(TT, 6144, G, bx);
        EpiZ E{1, ws, dout, P.lbl}; pg8::gemm_phase<EpiZ, pg8::StaticOrder, true, true>(lds, g, S, E); }
    SEAM(3);
    if (IN(4)) {
        const int nh = (G >= 128) ? 64 : G;
        if (bx < nh) { for (int un = bx; un < 64; un += nh) hgrn_unit(lds, un >> 3, un & 7, (const u16*)(ws + Z_QA), (const u16*)(ws + Z_G), (const u16*)(ws + Z_VA), (const u16*)(ws + Z_HG), P.hnw, (u16*)(ws + WS_H)); }
        if (G >= 128) { if (bx >= nh) merge_phase((u16*)(dout + DO_OG), (const float*)(ws + WS_COS), (const u16*)(dout + DO_AG), bx - nh, G - nh); }
        else merge_phase((u16*)(dout + DO_OG), (const float*)(ws + WS_COS), (const u16*)(dout + DO_AG), bx, G);
    }
    SEAM(4);
    if (IN(5)) {
        { pg8::Gemm g{(const u16*)(ws + WS_H), (const u16*)(ws + WS_WA), TT, 1024, 1024}; pg8::StaticOrder S; S.init(TT, 1024, G, bx);
          EpiGateA E{(const u16*)(ws + Z_GATES), (float*)(ws + Z_TMP)}; pg8::gemm_phase<EpiGateA, pg8::StaticOrder, true, true>(lds, g, S, E); }
        { pg8::Gemm g{(const u16*)(dout + DO_OG), (const u16*)(ws + WS_WB), TT, 1024, 512}; pg8::StaticOrder S; S.init(TT, 1024, G, bx);
          EpiGateB E{(const u16*)(ws + Z_GATES), (const float*)(ws + Z_TMP), (u16*)(ws + Z_MERGED)}; pg8::gemm_phase<EpiGateB, pg8::StaticOrder, true, true>(lds, g, S, E); }
    }
    SEAM(5);
    if (IN(6)) { pg8::Gemm g{(const u16*)(ws + Z_MERGED), (const u16*)(ws + WS_WO), TT, 1024, 1024}; pg8::StaticOrder S; S.init(TT, 1024, G, bx);
        EpiOut E{P.x, P.out}; pg8::gemm_phase<EpiOut, pg8::StaticOrder, true, true>(lds, g, S, E); }
    SEAM(6);
    if (IN(7)) {
        const int gw = vcu * 8 + wave, NGW = G * 8;
        for (int m = gw; m < TT; m += NGW) { f32x4* xr = (f32x4*)(P.out + (size_t)m * DM) + lane; f32x4 v[4]; float s = 0.f;
#pragma unroll
            for (int j = 0; j < 4; ++j) { v[j] = xr[64 * j]; s += (v[j].x * v[j].x + v[j].y * v[j].y) + (v[j].z * v[j].z + v[j].w * v[j].w); }
            const float rstd = rsqrtf(wave_sum(s) * (1.0f / DM) + NORM_EPS);
#pragma unroll
            for (int j = 0; j < 4; ++j) xr[64 * j] = v[j] * rstd * ((const f32x4*)P.fnw)[lane + 64 * j]; }
    }
#undef IN
#undef SEAM
}

extern "C" void kernel_launch(void* const* d_in, const int* in_sizes, int n_in, void* d_out, int out_size, void* d_ws, size_t ws_size, hipStream_t stream) {
    static int grid = 0;
    if (grid == 0) {
        if (n_in != 10 || in_sizes[0] != TT * DM || out_size != TT * DM || ws_size < WS_END) { fprintf(stderr, "kernel_launch: unexpected shapes (n_in %d, in0 %d, out %d, ws %zu)\n", n_in, n_in > 0 ? in_sizes[0] : -1, out_size, ws_size); grid = -1; return; }
        int dev = 0, cus = 0, per_cu = 0;
        hipGetDevice(&dev); hipDeviceGetAttribute(&cus, hipDeviceAttributeMultiprocessorCount, dev);
        if (hipFuncSetAttribute((const void*)fwd_megakernel, hipFuncAttributeMaxDynamicSharedMemorySize, LDS_BYTES) != hipSuccess) { fprintf(stderr, "kernel_launch: hipFuncSetAttribute failed\n"); grid = -1; return; }
        if (hipOccupancyMaxActiveBlocksPerMultiprocessor(&per_cu, (const void*)fwd_megakernel, 512, LDS_BYTES) != hipSuccess || per_cu < 1) { fprintf(stderr, "kernel_launch: occupancy query says %d\n", per_cu); per_cu = 1; }
        (void)hipGetLastError();
        grid = cus * (per_cu > 1 ? 1 : per_cu);
    }
    if (grid < 0) return;
    Args a{};
    for (int i = 0; i < 10; ++i) a.in[i] = (const float*)d_in[i];
    a.out = (float*)d_out; a.ws = (unsigned char*)d_ws; a.ph_lo = 0; a.ph_hi = 8;
    void* args[] = {&a};
    hipError_t e = hipLaunchCooperativeKernel((const void*)fwd_megakernel, dim3(grid), dim3(512), args, LDS_BYTES, stream);
    if (e != hipSuccess) fprintf(stderr, "kernel_launch: cooperative launch failed: %s (grid %d)\n", hipGetErrorString(e), grid);
}
```

```cpp
#include <hip/hip_runtime.h>
#include <hip/hip_cooperative_groups.h>
#include <hip/hip_bf16.h>
#include <cstdio>
#include <cstdint>
#include <cmath>
namespace cg = cooperative_groups;
namespace pg8 {
#define PG8_LAS __attribute__((address_space(3)))
typedef unsigned short bf16_t;
typedef short bf16x8 __attribute__((ext_vector_type(8)));
typedef float f32x4 __attribute__((ext_vector_type(4)));
typedef unsigned u32x4 __attribute__((ext_vector_type(4)));
constexpr int BM = 256, BK = 64, HALF = 128, HTB = HALF * BK * 2  , STAGE_BYTES = 8 * HTB, NXCD = 8, WGM = 8;

__host__ __device__ __forceinline__ int lds_byte(int r, int c) { const int st = (r >> 4) * 2 + (c >> 5), rr = r & 15, cc = c & 31, ob = rr * 64 + cc * 2; return st * 1024 + (ob ^ (((ob >> 9) & 1) << 5)); }
__host__ __device__ __forceinline__ void stage_rc(int b, int& R, int& C) { const int st = b / 1024, sb = b % 1024, swz = sb ^ (((sb >> 9) & 1) << 5); R = (st >> 1) * 16 + swz / 64; C = (st & 1) * 32 + (swz % 64) / 2; }
__host__ __device__ __forceinline__ int perm32(int rho) { const int n = rho >> 4, i = rho & 15; return 8 * (i >> 2) + 4 * n + (i & 3); }

struct Unit { int pm, pn; };
struct Gemm { const bf16_t* A; const bf16_t* Bt; int M, N, K; };

struct StaticOrder {
    int nM, nN, nwg, G, c;
    __host__ __device__ void init(int M, int N, int G_, int c_) { nM = M / BM; nN = N / BM; nwg = nM * nN; G = G_; c = c_; }
    __host__ __device__ bool next(int i, Unit& u) const {
        const long L = (long)i * G + c; if (L >= nwg) return false;
        int wgid = (int)L; { const int q = nwg / NXCD, r = nwg % NXCD, xcd = wgid % NXCD, off = wgid / NXCD; wgid = (xcd < r ? xcd * (q + 1) : r * (q + 1) + (xcd - r) * q) + off; }
        const int nig = WGM * nN, gid = wgid / nig, fm = gid * WGM, gsz = (nM - fm) < WGM ? (nM - fm) : WGM;
        u.pm = fm + ((wgid % nig) % gsz); u.pn = (wgid % nig) / gsz; return true;
    }
    __device__ __forceinline__ void a_ready(const Unit&) const {}
    __device__ __forceinline__ void done(const Unit&) const {}
};

__device__ __forceinline__ unsigned cvt_pk_bf16(float lo, float hi) { unsigned r; asm volatile("v_cvt_pk_bf16_f32 %0, %1, %2" : "=v"(r) : "v"(lo), "v"(hi)); return r; }
typedef float f32x2 __attribute__((ext_vector_type(2)));
template <class Epi, class Sched, bool ALIGN_EPI = false, bool SP2 = false>
__device__ __forceinline__ void gemm_phase(PG8_LAS unsigned char* lds, const Gemm g, const Sched& S, const Epi& E) {
    const int tid = threadIdx.x, wid = __builtin_amdgcn_readfirstlane(tid >> 6), lane = tid & 63, wr = wid >> 2, wc = wid & 3, fr = lane & 15, fq = lane >> 4;
    const int K = g.K, nt = K / BK;
    unsigned voffA[2], voffB[2];
#pragma unroll
    for (int i = 0; i < 2; ++i) { int R, C; stage_rc(tid * 16 + i * 8192, R, C); const int Rb = Epi::PERM ? ((R & ~31) + perm32(R & 31)) : R;
        voffA[i] = (unsigned)(R * K + C) * 2u; voffB[i] = (unsigned)(Rb * K + C) * 2u; }
    const size_t kstep = (size_t)(BK * 2);
    const size_t hstep = (size_t)HALF * K * 2;
    const size_t tstep = 2 * hstep;
    const unsigned ldsw = (unsigned)wid * 1024u;
    const int aoff = lds_byte(wr * 64 + fr, fq * 8), boff = lds_byte(wc * 32 + fr, fq * 8);
#define PG8_SA(b, h) (((b) * 2 + (h)) * HTB)
#define PG8_SB(b, h) ((4 + (b) * 2 + (h)) * HTB)
#define PG8_STAGE(bufoff, gbase, voff) do { _Pragma("unroll") for (int _i = 0; _i < 2; ++_i) \
        __builtin_amdgcn_global_load_lds((const unsigned*)((const char*)(gbase) + (voff)[_i]), (PG8_LAS unsigned*)(lds + (bufoff) + ldsw + _i * 8192), 16, 0, 0); } while (0)
#define PG8_LDA(dst, b, h) do { _Pragma("unroll") for (int m = 0; m < 4; ++m) _Pragma("unroll") for (int k = 0; k < 2; ++k) dst[m][k] = *(const PG8_LAS bf16x8*)(lds + PG8_SA(b, h) + aoff + m * 2048 + k * 1024); } while (0)
#define PG8_LDB(dst, b, h) do { _Pragma("unroll") for (int n = 0; n < 2; ++n) _Pragma("unroll") for (int k = 0; k < 2; ++k) dst[n][k] = *(const PG8_LAS bf16x8*)(lds + PG8_SB(b, h) + boff + n * 2048 + k * 1024); } while (0)
#define PG8_MMA(ai, bj, At, Bt) do { __builtin_amdgcn_s_setprio(1); _Pragma("unroll") for (int m = 0; m < 4; ++m) _Pragma("unroll") for (int n = 0; n < 2; ++n) _Pragma("unroll") for (int k = 0; k < 2; ++k) \
        acc[ai][bj][m][n] = __builtin_amdgcn_mfma_f32_16x16x32_bf16(Bt[n][k], At[m][k], acc[ai][bj][m][n], 0, 0, 0); __builtin_amdgcn_s_setprio(0); } while (0)
#define PG8_WAIT_V(n) asm volatile("s_waitcnt vmcnt(" #n ")" ::: "memory")
#define PG8_WAIT_L(n) asm volatile("s_waitcnt lgkmcnt(" #n ")" ::: "memory")
#define PG8_BAR __builtin_amdgcn_s_barrier()
#define PG8_SCHED __builtin_amdgcn_sched_barrier(0)
    Unit cur, nxt; int ui = 0;
    if (!S.next(0, cur)) return;
    f32x4 acc[2][2][4][2];
#pragma unroll
    for (int a = 0; a < 2; ++a)
#pragma unroll
        for (int b = 0; b < 2; ++b)
#pragma unroll
            for (int m = 0; m < 4; ++m)
#pragma unroll
                for (int n = 0; n < 2; ++n) acc[a][b][m][n] = (f32x4){0.f, 0.f, 0.f, 0.f};
    bf16x8 At[4][2], B0[2][2], B1[2][2];
    const char* cA = (const char*)g.A + (size_t)cur.pm * tstep; const char* cB = (const char*)g.Bt + (size_t)cur.pn * tstep;
    S.a_ready(cur);
    if constexpr (SP2) {
        PG8_STAGE(PG8_SB(0, 0), cB, voffB); PG8_STAGE(PG8_SB(0, 1), cB + hstep, voffB); PG8_STAGE(PG8_SA(0, 0), cA, voffA); PG8_STAGE(PG8_SA(0, 1), cA + hstep, voffA);
        if (wr == 1) PG8_BAR;
        PG8_WAIT_V(2); PG8_BAR;
        PG8_STAGE(PG8_SB(1, 0), cB + kstep, voffB); PG8_STAGE(PG8_SA(1, 0), cA + kstep, voffA); PG8_STAGE(PG8_SB(1, 1), cB + hstep + kstep, voffB);
        PG8_WAIT_V(6); PG8_BAR;
    } else {
        PG8_STAGE(PG8_SB(0, 0), cB, voffB); PG8_STAGE(PG8_SA(0, 0), cA, voffA); PG8_STAGE(PG8_SB(0, 1), cB + hstep, voffB); PG8_STAGE(PG8_SA(0, 1), cA + hstep, voffA);
        if (wr == 1) PG8_BAR;
        PG8_WAIT_V(4); PG8_BAR;
        PG8_STAGE(PG8_SB(1, 0), cB + kstep, voffB); PG8_STAGE(PG8_SA(1, 0), cA + kstep, voffA); PG8_STAGE(PG8_SB(1, 1), cB + hstep + kstep, voffB);
        PG8_WAIT_V(6); PG8_BAR;
    }
    for (;;) {
        const bool has_next = S.next(ui + 1, nxt);
        const char* nA = has_next ? (const char*)g.A + (size_t)nxt.pm * tstep : cA; const char* nB = has_next ? (const char*)g.Bt + (size_t)nxt.pn * tstep : cB;
        for (int t = 0; t < nt; t += 2) {
            const bool last = (t == nt - 2);
            const char* a1 = cA + (size_t)(t + 1) * kstep;
            const char* a2 = last ? nA : cA + (size_t)(t + 2) * kstep; const char* b2 = last ? nB : cB + (size_t)(t + 2) * kstep;
            const char* a3 = a2 + kstep; const char* b3 = b2 + kstep;
            if (last && has_next) S.a_ready(nxt);
            if constexpr (SP2) {
            PG8_LDB(B0, 0, 0); PG8_LDB(B1, 0, 1); PG8_SCHED; PG8_LDA(At, 0, 0); PG8_STAGE(PG8_SA(1, 1), a1 + hstep, voffA);
            PG8_WAIT_V(8); PG8_WAIT_L(0); PG8_BAR; PG8_MMA(0, 0, At, B0); PG8_MMA(0, 1, At, B1); PG8_BAR; PG8_SCHED;
            PG8_LDA(At, 0, 1); PG8_STAGE(PG8_SB(0, 0), b2, voffB); PG8_STAGE(PG8_SB(0, 1), b2 + hstep, voffB); PG8_STAGE(PG8_SA(0, 0), a2, voffA);
            PG8_WAIT_V(8); PG8_WAIT_L(0); PG8_BAR; PG8_MMA(1, 0, At, B0); PG8_MMA(1, 1, At, B1); PG8_BAR; PG8_SCHED;
            PG8_LDB(B0, 1, 0); PG8_LDB(B1, 1, 1); PG8_SCHED; PG8_LDA(At, 1, 0); PG8_STAGE(PG8_SA(0, 1), a2 + hstep, voffA);
            PG8_WAIT_V(8); PG8_WAIT_L(0); PG8_BAR; PG8_MMA(0, 0, At, B0); PG8_MMA(0, 1, At, B1); PG8_BAR; PG8_SCHED;
            PG8_LDA(At, 1, 1); PG8_STAGE(PG8_SB(1, 0), b3, voffB); PG8_STAGE(PG8_SB(1, 1), b3 + hstep, voffB); PG8_STAGE(PG8_SA(1, 0), a3, voffA);
            PG8_WAIT_V(8); PG8_WAIT_L(0); PG8_BAR; PG8_MMA(1, 0, At, B0); PG8_MMA(1, 1, At, B1); PG8_BAR; PG8_SCHED;
            } else {
            PG8_LDB(B0, 0, 0); PG8_SCHED; PG8_LDA(At, 0, 0); PG8_STAGE(PG8_SA(1, 1), a1 + hstep, voffA);
            PG8_WAIT_L(8); PG8_BAR; PG8_WAIT_L(0); PG8_MMA(0, 0, At, B0); PG8_BAR; PG8_SCHED;
            PG8_LDB(B1, 0, 1); PG8_STAGE(PG8_SB(0, 0), b2, voffB);
            PG8_BAR; PG8_WAIT_L(0); PG8_MMA(0, 1, At, B1); PG8_BAR;
            PG8_LDA(At, 0, 1); PG8_STAGE(PG8_SA(0, 0), a2, voffA);
            PG8_BAR; PG8_WAIT_L(0); PG8_MMA(1, 0, At, B0); PG8_BAR; PG8_SCHED;
            PG8_STAGE(PG8_SB(0, 1), b2 + hstep, voffB);
            PG8_WAIT_V(6); PG8_BAR; PG8_MMA(1, 1, At, B1); PG8_BAR;
            PG8_LDB(B0, 1, 0); PG8_SCHED; PG8_LDA(At, 1, 0); PG8_STAGE(PG8_SA(0, 1), a2 + hstep, voffA);
            PG8_WAIT_L(8); PG8_BAR; PG8_WAIT_L(0); PG8_MMA(0, 0, At, B0); PG8_BAR; PG8_SCHED;
            PG8_LDB(B1, 1, 1); PG8_STAGE(PG8_SB(1, 0), b3, voffB);
            PG8_BAR; PG8_WAIT_L(0); PG8_MMA(0, 1, At, B1); PG8_BAR;
            PG8_LDA(At, 1, 1); PG8_STAGE(PG8_SA(1, 0), a3, voffA);
            PG8_BAR; PG8_WAIT_L(0); PG8_MMA(1, 0, At, B0); PG8_BAR; PG8_SCHED;
            PG8_STAGE(PG8_SB(1, 1), b3 + hstep, voffB);
            PG8_WAIT_V(6); PG8_BAR; PG8_MMA(1, 1, At, B1); PG8_BAR;
            }
        }
        if constexpr (ALIGN_EPI) { if (wr == 0) PG8_BAR; }
        if constexpr (!Epi::AFTER_DRAIN) { E(acc, cur, wr, wc, fr, fq); S.done(cur); }
        if (!has_next) break;
#pragma unroll
        for (int a = 0; a < 2; ++a)
#pragma unroll
            for (int b = 0; b < 2; ++b)
#pragma unroll
                for (int m = 0; m < 4; ++m)
#pragma unroll
                    for (int n = 0; n < 2; ++n) acc[a][b][m][n] = (f32x4){0.f, 0.f, 0.f, 0.f};
        cur = nxt; cA = nA; cB = nB; ++ui;
        if constexpr (ALIGN_EPI) { if (wr == 1) PG8_BAR; }
    }
    PG8_WAIT_V(0);
    if constexpr (!ALIGN_EPI) { if (wr == 0) PG8_BAR; }
    PG8_BAR;
    if constexpr (Epi::AFTER_DRAIN) { E.fused(acc, cur, wr, wc, fr, fq, lds, wid, lane); S.done(cur); }
#undef PG8_SA
#undef PG8_SB
#undef PG8_STAGE
#undef PG8_LDA
#undef PG8_LDB
#undef PG8_MMA
#undef PG8_WAIT_V
#undef PG8_WAIT_L
#undef PG8_BAR
#undef PG8_SCHED
}
}

#define LAS __attribute__((address_space(3)))
typedef unsigned short u16;
typedef short bf16x8 __attribute__((ext_vector_type(8)));
typedef short s16x4 __attribute__((ext_vector_type(4)));
typedef float f32x4 __attribute__((ext_vector_type(4)));
typedef float f32x2 __attribute__((ext_vector_type(2)));
typedef unsigned u32x4 __attribute__((ext_vector_type(4)));
typedef unsigned u32x2 __attribute__((ext_vector_type(2)));

constexpr int TT = 16384, DM = 1024, SEQ = 2048, NIN = 11264;
constexpr int ZBP = 4608;
constexpr size_t MiB = 1u << 20;
constexpr size_t WS_WT = 0;
constexpr size_t WS_WA = 22 * MiB, WS_WB = 24 * MiB, WS_WO = 25 * MiB;
constexpr size_t WS_COS = 27 * MiB, WS_SIN = 29 * MiB;
constexpr size_t WS_BAR = 31 * MiB;
constexpr size_t WS_H = 32 * MiB;
constexpr size_t WS_Z = 64 * MiB;
constexpr size_t Z_QA = WS_Z, Z_G = WS_Z + 32 * MiB, Z_VA = WS_Z + 64 * MiB, Z_HG = WS_Z + 96 * MiB, Z_GATES = WS_Z + 128 * MiB;
constexpr size_t Z_MERGED = WS_Z + 64 * MiB;
constexpr size_t WS_END = 256 * MiB;
constexpr size_t DO_OG = 0, DO_AG = 48 * MiB, DO_TMPB = 16 * MiB;
constexpr int LDS_BYTES = 163840;
constexpr float NORM_EPS = 1e-6f;

__device__ __forceinline__ unsigned pk_bf16(float lo, float hi) { typedef __bf16 b2 __attribute__((ext_vector_type(2))); f32x2 v = {lo, hi}; b2 b = __builtin_convertvector(v, b2); return __builtin_bit_cast(unsigned, b); }
__device__ __forceinline__ unsigned pk_f16(float lo, float hi) { typedef _Float16 h2 __attribute__((ext_vector_type(2))); h2 h = {(_Float16)lo, (_Float16)hi}; return __builtin_bit_cast(unsigned, h); }
__device__ __forceinline__ float bflo(unsigned u) { return __uint_as_float(u << 16); }
__device__ __forceinline__ float bfhi(unsigned u) { return __uint_as_float(u & 0xffff0000u); }
__device__ __forceinline__ float f16lo(unsigned u) { return (float)__builtin_bit_cast(_Float16, (unsigned short)(u & 0xffffu)); }
__device__ __forceinline__ float f16hi(unsigned u) { return (float)__builtin_bit_cast(_Float16, (unsigned short)(u >> 16)); }
__device__ __forceinline__ float sigm(float x) { return __builtin_amdgcn_rcpf(1.0f + __expf(-x)); }
__device__ __forceinline__ s16x4 ds_tr(const LAS u16* p) { typedef short v4 __attribute__((ext_vector_type(4))); return __builtin_bit_cast(s16x4, __builtin_amdgcn_ds_read_tr16_b64_v4i16((LAS v4*)p)); }
__device__ __forceinline__ bf16x8 cat8(s16x4 lo, s16x4 hi) { return (bf16x8){lo[0], lo[1], lo[2], lo[3], hi[0], hi[1], hi[2], hi[3]}; }
__device__ __forceinline__ f32x4 mfma16(bf16x8 a, bf16x8 b, f32x4 c) { return __builtin_amdgcn_mfma_f32_16x16x32_bf16(a, b, c, 0, 0, 0); }
__device__ __forceinline__ void store16_wt(void* p, u32x4 v) { asm volatile("global_store_dwordx4 %0, %1, off sc1\n\ts_nop 1" :: "v"(p), "v"(v) : "memory"); }
template <bool WT> __device__ __forceinline__ void store16(void* p, u32x4 v) { if (WT) store16_wt(p, v); else *(u32x4*)p = v; }
__device__ __forceinline__ float wave_sum(float v) {
#pragma unroll
    for (int o = 1; o < 64; o <<= 1) v += __shfl_xor(v, o);
    return v;
}

using pg8::Unit;
template <int ACT  > __device__ __forceinline__ float act1(float v) { if (ACT == 1) return v * sigm(v); if (ACT == 2) return sigm(v); return v; }
template <int ACT, bool WT = false> __device__ __forceinline__ void epi_store16(const f32x4 (&acc)[2][2][4][2], u16* base, int pitch, int row0, int col0) {
#pragma unroll
    for (int ai = 0; ai < 2; ++ai)
#pragma unroll
        for (int m = 0; m < 4; ++m) { u16* rowp = base + (size_t)(row0 + ai * 128 + m * 16) * pitch + col0;
#pragma unroll
            for (int bj = 0; bj < 2; ++bj) { const f32x4 v0 = acc[ai][bj][m][0], v1 = acc[ai][bj][m][1]; u32x4 w;
                w.x = pk_bf16(act1<ACT>(v0[0]), act1<ACT>(v0[1])); w.y = pk_bf16(act1<ACT>(v0[2]), act1<ACT>(v0[3]));
                w.z = pk_bf16(act1<ACT>(v1[0]), act1<ACT>(v1[1])); w.w = pk_bf16(act1<ACT>(v1[2]), act1<ACT>(v1[3]));
                store16<WT>(rowp + bj * 128, w); } }
}
template <bool WT> struct EpiZT {
    static constexpr bool PERM = true, AFTER_DRAIN = false;
    int mode;
    unsigned char* ws; unsigned char* dout; const float* lbl;
    __device__ __forceinline__ void operator()(const f32x4 (&acc)[2][2][4][2], const Unit& u, int wr, int wc, int fr, int fq) const {
        const int pn = u.pn, row0 = u.pm * 256 + wr * 64 + fr, lc = wc * 32 + 8 * fq;
        if (mode == 2) { epi_store16<2>(acc, (u16*)(ws + Z_GATES), 2048, row0, pn * 256 + lc); return; }
        if (mode == 0) {
            u16* ZB = (u16*)(ws + WS_Z);
            if (pn < 12) {
                const float sc = (pn < 6) ? 0.125f * 1.4426950408889634f : 1.0f;
                const float* cosT = (const float*)(ws + WS_COS); const float* sinT = (const float*)(ws + WS_SIN);
                const int jb = 16 * (wc & 1) + 4 * fq;
#pragma unroll
                for (int ai = 0; ai < 2; ++ai) { f32x4 cc[4], ss[4];
#pragma unroll
                    for (int m = 0; m < 4; ++m) { const int row = row0 + ai * 128 + m * 16; cc[m] = *(const f32x4*)(cosT + (size_t)row * 32 + jb); ss[m] = *(const f32x4*)(sinT + (size_t)row * 32 + jb); }
#pragma unroll
                    for (int m = 0; m < 4; ++m) { const int row = row0 + ai * 128 + m * 16; const f32x4 c = cc[m], s = ss[m];
                        u16* rowp = ZB + ((size_t)(pn * 4 + (wc >> 1)) * TT + row) * 64 + (lc & 63);
#pragma unroll
                        for (int bj = 0; bj < 2; ++bj) { const f32x4 v0 = acc[ai][bj][m][0], v1 = acc[ai][bj][m][1]; u32x4 w;
                            w.x = pk_bf16((v0[0] * c[0] - v0[1] * s[0]) * sc, (v0[1] * c[0] + v0[0] * s[0]) * sc);
                            w.y = pk_bf16((v0[2] * c[1] - v0[3] * s[1]) * sc, (v0[3] * c[1] + v0[2] * s[1]) * sc);
                            w.z = pk_bf16((v1[0] * c[2] - v1[1] * s[2]) * sc, (v1[1] * c[2] + v1[0] * s[2]) * sc);
                            w.w = pk_bf16((v1[2] * c[3] - v1[3] * s[3]) * sc, (v1[3] * c[3] + v1[2] * s[3]) * sc);
                            *(u32x4*)(rowp + (size_t)bj * 2 * TT * 64) = w; } } }
            } else if (pn < 18) {
#pragma unroll
                for (int ai = 0; ai < 2; ++ai)
#pragma unroll
                    for (int m = 0; m < 4; ++m) { u16* rowp = ZB + ((size_t)(pn * 4 + (wc >> 1)) * TT + (row0 + ai * 128 + m * 16)) * 64 + (lc & 63);
#pragma unroll
                        for (int bj = 0; bj < 2; ++bj) { const f32x4 v0 = acc[ai][bj][m][0], v1 = acc[ai][bj][m][1]; u32x4 w;
                            w.x = pk_bf16(v0[0], v0[1]); w.y = pk_bf16(v0[2], v0[3]); w.z = pk_bf16(v1[0], v1[1]); w.w = pk_bf16(v1[2], v1[3]);
                            *(u32x4*)(rowp + (size_t)bj * 2 * TT * 64) = w; } }
            }
            else epi_store16<1>(acc, (u16*)(dout + DO_AG), 512, row0, (pn - 18) * 256 + lc);
        } else {
            if (pn < 4) epi_store16<1, WT>(acc, (u16*)(ws + Z_QA), 1024, row0, pn * 256 + lc);
            else if (pn < 8) {
                const int cb = (pn - 4) * 256 + lc; float lb[2][8];
#pragma unroll
                for (int bj = 0; bj < 2; ++bj)
#pragma unroll
                    for (int e = 0; e < 8; ++e) { const int idx = cb + bj * 128 + e; lb[bj][e] = 1.0f / (1.0f + __expf(lbl[1024 + idx] - lbl[idx])); }
                u16* G = (u16*)(ws + Z_G);
#pragma unroll
                for (int ai = 0; ai < 2; ++ai)
#pragma unroll
                    for (int m = 0; m < 4; ++m) { u16* rowp = G + (size_t)(row0 + ai * 128 + m * 16) * 1024 + cb;
#pragma unroll
                        for (int bj = 0; bj < 2; ++bj) { const f32x4 v0 = acc[ai][bj][m][0], v1 = acc[ai][bj][m][1]; float g[8];
#pragma unroll
                            for (int e = 0; e < 8; ++e) { const float v = e < 4 ? v0[e & 3] : v1[e & 3]; g[e] = lb[bj][e] + (1.0f - lb[bj][e]) * sigm(v); }
                            u32x4 w; w.x = pk_f16(g[0], g[1]); w.y = pk_f16(g[2], g[3]); w.z = pk_f16(g[4], g[5]); w.w = pk_f16(g[6], g[7]);
                            store16<WT>(rowp + bj * 128, w); } }
            } else if (pn < 12) epi_store16<0, WT>(acc, (u16*)(ws + Z_VA), 1024, row0, (pn - 8) * 256 + lc);
            else if (pn < 16) epi_store16<1, WT>(acc, (u16*)(ws + Z_HG), 1024, row0, (pn - 12) * 256 + lc);
            else epi_store16<2>(acc, (u16*)(ws + Z_GATES), 2048, row0, (pn - 16) * 256 + lc);
        }
    }
};
typedef EpiZT<false> EpiZ;
struct EpiGateB {
    static constexpr bool PERM = true, AFTER_DRAIN = false;
    const u16* gates; u16* tmpb;
    __device__ __forceinline__ void operator()(const f32x4 (&acc)[2][2][4][2], const Unit& u, int wr, int wc, int fr, int fq) const {
        const int row0 = u.pm * 256 + wr * 64 + fr, col0 = u.pn * 256 + wc * 32 + 8 * fq;
#pragma unroll
        for (int ai = 0; ai < 2; ++ai) { u32x4 gg[4][2];
#pragma unroll
            for (int m = 0; m < 4; ++m)
#pragma unroll
                for (int bj = 0; bj < 2; ++bj) gg[m][bj] = *(const u32x4*)(gates + (size_t)(row0 + ai * 128 + m * 16) * 2048 + 1024 + col0 + bj * 128);
#pragma unroll
            for (int m = 0; m < 4; ++m) { const size_t row = row0 + ai * 128 + m * 16;
#pragma unroll
                for (int bj = 0; bj < 2; ++bj) { const int col = col0 + bj * 128; const u32x4 g = gg[m][bj];
                    const f32x4 v0 = acc[ai][bj][m][0], v1 = acc[ai][bj][m][1]; u32x4 w;
                    w.x = pk_bf16(v0[0] * bflo(g.x), v0[1] * bfhi(g.x)); w.y = pk_bf16(v0[2] * bflo(g.y), v0[3] * bfhi(g.y));
                    w.z = pk_bf16(v1[0] * bflo(g.z), v1[1] * bfhi(g.z)); w.w = pk_bf16(v1[2] * bflo(g.w), v1[3] * bfhi(g.w));
                    *(u32x4*)(tmpb + row * 1024 + col) = w; } } }
    }
};
struct EpiGateA {
    static constexpr bool PERM = true, AFTER_DRAIN = false;
    const u16* gates; const u16* tmpb; u16* merged;
    __device__ __forceinline__ void operator()(const f32x4 (&acc)[2][2][4][2], const Unit& u, int wr, int wc, int fr, int fq) const {
        const int row0 = u.pm * 256 + wr * 64 + fr, col0 = u.pn * 256 + wc * 32 + 8 * fq;
#pragma unroll
        for (int ai = 0; ai < 2; ++ai) { u32x4 gg[4][2], tb[4][2];
#pragma unroll
            for (int m = 0; m < 4; ++m)
#pragma unroll
                for (int bj = 0; bj < 2; ++bj) { const size_t row = row0 + ai * 128 + m * 16; gg[m][bj] = *(const u32x4*)(gates + row * 2048 + col0 + bj * 128); tb[m][bj] = *(const u32x4*)(tmpb + row * 1024 + col0 + bj * 128); }
#pragma unroll
            for (int m = 0; m < 4; ++m) { const size_t row = row0 + ai * 128 + m * 16;
#pragma unroll
                for (int bj = 0; bj < 2; ++bj) { const int col = col0 + bj * 128; const u32x4 g = gg[m][bj], t = tb[m][bj];
                    const f32x4 v0 = acc[ai][bj][m][0], v1 = acc[ai][bj][m][1]; u32x4 w;
                    w.x = pk_bf16(bflo(t.x) + v0[0] * bflo(g.x), bfhi(t.x) + v0[1] * bfhi(g.x)); w.y = pk_bf16(bflo(t.y) + v0[2] * bflo(g.y), bfhi(t.y) + v0[3] * bfhi(g.y));
                    w.z = pk_bf16(bflo(t.z) + v1[0] * bflo(g.z), bfhi(t.z) + v1[1] * bfhi(g.z)); w.w = pk_bf16(bflo(t.w) + v1[2] * bflo(g.w), bfhi(t.w) + v1[3] * bfhi(g.w));
                    *(u32x4*)(merged + row * 1024 + col) = w; } } }
    }
};
struct ListOrder { int pm0; unsigned list;
    __device__ __forceinline__ bool next(int i, Unit& u) const { const unsigned c = (i < 4) ? ((list >> (8 * i)) & 0xffu) : 0xffu; if (c == 0xffu) return false; u.pm = pm0 + (int)(c & 7u); u.pn = (int)(c >> 3); return true; }
    __device__ __forceinline__ void a_ready(const Unit&) const {} __device__ __forceinline__ void done(const Unit&) const {} };
struct DefOrder { pg8::StaticOrder base;
    __device__ __forceinline__ bool next(int i, Unit& u) const { if (!base.next(i, u)) return false; u.pm = (u.pm / 6) * 8 + (u.pm % 6); return true; }
    __device__ __forceinline__ void a_ready(const Unit&) const {} __device__ __forceinline__ void done(const Unit&) const {} };
__device__ __forceinline__ unsigned lo_code(int idx, int base) { return (unsigned)(((base + (idx >> 3)) << 3) | (idx & 7)); }
struct EpiOutNorm {
    static constexpr bool PERM = true, AFTER_DRAIN = true;
    const float* x; float* out; const float* fnw; float* xbuf; unsigned* cnt;
    __device__ __forceinline__ void operator()(const f32x4 (&)[2][2][4][2], const Unit&, int, int, int, int) const {}
    __device__ __forceinline__ void fused(f32x4 (&acc)[2][2][4][2], const Unit& u, int wr, int wc, int fr, int fq, PG8_LAS unsigned char* lds, int wid, int lane) const {
        const int row0 = u.pm * 256 + wr * 64 + fr, col0 = u.pn * 256 + wc * 32 + 8 * fq;
        LAS float* PS = (LAS float*)lds;
        LAS float* RS = (LAS float*)(lds + 4096);
#pragma unroll
        for (int ai = 0; ai < 2; ++ai)
#pragma unroll
            for (int mh = 0; mh < 2; ++mh) { f32x4 xv[2][2][2];
#pragma unroll
                for (int mm = 0; mm < 2; ++mm)
#pragma unroll
                    for (int bj = 0; bj < 2; ++bj) { const size_t o = (size_t)(row0 + ai * 128 + (2 * mh + mm) * 16) * 1024 + col0 + bj * 128; xv[mm][bj][0] = *(const f32x4*)(x + o); xv[mm][bj][1] = *(const f32x4*)(x + o + 4); }
#pragma unroll
                for (int mm = 0; mm < 2; ++mm) { const int m = 2 * mh + mm; float sq = 0.f;
#pragma unroll
                    for (int bj = 0; bj < 2; ++bj)
#pragma unroll
                        for (int n = 0; n < 2; ++n) { const f32x4 v = acc[ai][bj][m][n] + xv[mm][bj][n]; acc[ai][bj][m][n] = v; sq += (v[0] * v[0] + v[1] * v[1]) + (v[2] * v[2] + v[3] * v[3]); }
                    sq += __shfl_xor(sq, 16); sq += __shfl_xor(sq, 32);
                    if (fq == 0) PS[(ai * 128 + wr * 64 + m * 16 + fr) * 4 + wc] = sq; } }
        asm volatile("s_waitcnt lgkmcnt(0)" ::: "memory"); __builtin_amdgcn_s_barrier(); asm volatile("" ::: "memory");
        const int tid = wid * 64 + lane;
        if (tid < 256) { const f32x4 p = *(const LAS f32x4*)(PS + tid * 4);
            __hip_atomic_store(xbuf + (size_t)(u.pm * 256 + tid) * 4 + u.pn, (p[0] + p[1]) + (p[2] + p[3]), __ATOMIC_RELAXED, __HIP_MEMORY_SCOPE_AGENT); }
        asm volatile("s_waitcnt vmcnt(0)" ::: "memory"); __builtin_amdgcn_s_barrier(); asm volatile("" ::: "memory");
        if (tid == 0) {
            __hip_atomic_fetch_add(cnt + 64 * u.pm, 1u, __ATOMIC_RELAXED, __HIP_MEMORY_SCOPE_AGENT);
            unsigned sp = 0u; while (__hip_atomic_load(cnt + 64 * u.pm, __ATOMIC_RELAXED, __HIP_MEMORY_SCOPE_AGENT) < 4u) { __builtin_amdgcn_s_sleep(2); if (++sp > (1u << 22)) break; }
            __builtin_amdgcn_fence(__ATOMIC_ACQUIRE, "agent"); asm volatile("s_waitcnt vmcnt(0)" ::: "memory"); }
        __builtin_amdgcn_s_barrier(); asm volatile("" ::: "memory");
        if (tid < 256) { const float* sl = xbuf + (size_t)(u.pm * 256 + tid) * 4; float t = 0.f;
#pragma unroll
            for (int k = 0; k < 4; ++k) t += __hip_atomic_load(sl + k, __ATOMIC_RELAXED, __HIP_MEMORY_SCOPE_AGENT);
            RS[tid] = rsqrtf(t * (1.0f / 1024.0f) + NORM_EPS); }
        asm volatile("s_waitcnt vmcnt(0) lgkmcnt(0)" ::: "memory"); __builtin_amdgcn_s_barrier(); asm volatile("" ::: "memory");
        f32x4 wv[2][2];
#pragma unroll
        for (int bj = 0; bj < 2; ++bj) { wv[bj][0] = *(const f32x4*)(fnw + col0 + bj * 128); wv[bj][1] = *(const f32x4*)(fnw + col0 + bj * 128 + 4); }
#pragma unroll
        for (int ai = 0; ai < 2; ++ai)
#pragma unroll
            for (int m = 0; m < 4; ++m) { const int rl = ai * 128 + wr * 64 + m * 16 + fr; const float rs = RS[rl]; const size_t o = (size_t)(u.pm * 256 + rl) * 1024 + col0;
#pragma unroll
                for (int bj = 0; bj < 2; ++bj) { const f32x4 r0 = acc[ai][bj][m][0] * rs * wv[bj][0], r1 = acc[ai][bj][m][1] * rs * wv[bj][1];
                    store16_wt(out + o + bj * 128, __builtin_bit_cast(u32x4, r0)); store16_wt(out + o + bj * 128 + 4, __builtin_bit_cast(u32x4, r1)); } }
    }
};

__device__ __forceinline__ int wt_row_of_col(int n) {
    if (n < 4096) return n;
    if (n >= 9216) return 4096 + (n - 9216);
    int a = n - 4096;
    if (a < 3072) { const int e = a & 63; a = (a - e) + (e < 32 ? 2 * e : 2 * (e - 32) + 1); }
    return 6144 + a;
}
template <bool MAP> __device__ __forceinline__ void p0_transpose_item(const float* W, int K, int N, u16* WT, LAS float* scr, int item, int lane) {
    const int nblk = N / 32, kb = item / nblk, nb = item % nblk, k0 = 64 * kb, n0 = 32 * nb;
    float tv[32];
#pragma unroll
    for (int i = 0; i < 32; ++i) tv[i] = W[(size_t)(k0 + 2 * i + (lane >> 5)) * N + n0 + (lane & 31)];
#pragma unroll
    for (int i = 0; i < 32; ++i) scr[(2 * i + (lane >> 5)) * 33 + (lane & 31)] = tv[i];
    asm volatile("s_waitcnt lgkmcnt(0)" ::: "memory");
    const int c = lane & 7;
#pragma unroll
    for (int j = 0; j < 4; ++j) { const int n = (lane >> 3) + 8 * j; const LAS float* s = scr + (8 * c) * 33 + n;
        u32x4 o; o.x = pk_bf16(s[0 * 33], s[1 * 33]); o.y = pk_bf16(s[2 * 33], s[3 * 33]); o.z = pk_bf16(s[4 * 33], s[5 * 33]); o.w = pk_bf16(s[6 * 33], s[7 * 33]);
        const int r = MAP ? wt_row_of_col(n0 + n) : (n0 + n);
        *(u32x4*)(WT + (size_t)r * K + k0 + 8 * c) = o; }
    asm volatile("s_waitcnt lgkmcnt(0)" ::: "memory");
}
struct Ptrs { const float* x; const int* pos; const float* norm_w; const float* w_in; const float* lbl; const float* hnw; const float* wa; const float* wb; const float* wo; const float* fnw; float* out; unsigned char* ws; };

__device__ __forceinline__ void p0_prologue(const Ptrs& P, LAS unsigned char* lds, int vcu, int G) {
    const int tid = threadIdx.x, lane = tid & 63, wave = __builtin_amdgcn_readfirstlane(tid >> 6);
    LAS float* scr = (LAS float*)(lds + wave * 16384);
    const int gw = vcu * 8 + wave, NGW = G * 8;
    constexpr int I_IN = 16 * (NIN / 32), I_A = 16 * 32, I_B = 8 * 32, I_O = 16 * 32, NITEMS = I_IN + I_A + I_B + I_O;
    for (int it = gw; it < NITEMS; it += NGW) {
        int r = it;
        if (r < I_IN) { p0_transpose_item<true>(P.w_in, 1024, NIN, (u16*)(P.ws + WS_WT), scr, r, lane); continue; } r -= I_IN;
        if (r < I_A) { p0_transpose_item<false>(P.wa, 1024, 1024, (u16*)(P.ws + WS_WA), scr, r, lane); continue; } r -= I_A;
        if (r < I_B) { p0_transpose_item<false>(P.wb, 512, 1024, (u16*)(P.ws + WS_WB), scr, r, lane); continue; } r -= I_B;
        p0_transpose_item<false>(P.wo, 1024, 1024, (u16*)(P.ws + WS_WO), scr, r, lane);
    }
    u16* H = (u16*)(P.ws + WS_H);
    for (int m = gw; m < TT; m += 2 * NGW) {
        const int m2 = (m + NGW < TT) ? m + NGW : m;
        const f32x4* xr = (const f32x4*)(P.x + (size_t)m * DM) + lane; const f32x4* xr2 = (const f32x4*)(P.x + (size_t)m2 * DM) + lane; f32x4 v[4], v2[4]; float s = 0.f, s2 = 0.f;
#pragma unroll
        for (int j = 0; j < 4; ++j) { v[j] = xr[64 * j]; v2[j] = xr2[64 * j]; }
#pragma unroll
        for (int j = 0; j < 4; ++j) { s += (v[j].x * v[j].x + v[j].y * v[j].y) + (v[j].z * v[j].z + v[j].w * v[j].w); s2 += (v2[j].x * v2[j].x + v2[j].y * v2[j].y) + (v2[j].z * v2[j].z + v2[j].w * v2[j].w); }
        const float rstd = rsqrtf(wave_sum(s) * (1.0f / DM) + NORM_EPS), rstd2 = rsqrtf(wave_sum(s2) * (1.0f / DM) + NORM_EPS);
        u32x2* o8 = (u32x2*)(H + (size_t)m * DM) + lane; u32x2* o82 = (u32x2*)(H + (size_t)m2 * DM) + lane;
#pragma unroll
        for (int j = 0; j < 4; ++j) { const f32x4 w4 = ((const f32x4*)P.norm_w)[lane + 64 * j];
            o8[64 * j] = (u32x2){pk_bf16(v[j].x * rstd * w4.x, v[j].y * rstd * w4.y), pk_bf16(v[j].z * rstd * w4.z, v[j].w * rstd * w4.w)};
            o82[64 * j] = (u32x2){pk_bf16(v2[j].x * rstd2 * w4.x, v2[j].y * rstd2 * w4.y), pk_bf16(v2[j].z * rstd2 * w4.z, v2[j].w * rstd2 * w4.w)}; }
    }
    float* cosT = (float*)(P.ws + WS_COS); float* sinT = (float*)(P.ws + WS_SIN);
    for (int e = (vcu * 512 + tid); e < TT * 32; e += G * 512) {
        const int row = e >> 5, j = e & 31;
        const float inv = exp2f(-(float)j * (13.287712379549449f / 32.0f));
        const float ang = (float)P.pos[row] * inv;
        const double rev = (double)ang * 0.15915494309189535; const float fr = (float)(rev - __builtin_rint(rev));
        cosT[e] = __builtin_amdgcn_cosf(fr); sinT[e] = __builtin_amdgcn_sinf(fr);
    }
}

#define LBAR() asm volatile("s_waitcnt lgkmcnt(0)\n\ts_barrier" ::: "memory")
__device__ __forceinline__ void attn_phase(LAS unsigned char* lds, const u16* ZB, u16* OG, float* LSE, int bid, int G) {
    const int tid = threadIdx.x, lane = tid & 63, w = __builtin_amdgcn_readfirstlane(tid >> 6), l15 = lane & 15, q4 = lane >> 4, sb = w >> 2, wq = w & 3;
    constexpr int KP = 72;
    LAS u16* KI = (LAS u16*)lds; LAS u16* VI = (LAS u16*)(lds + 384 * KP * 2);
    u32x4 kr[6], vr[6]; bf16x8 qn[2][2];
#define AT_DEC(un_) const int b_ = (un_) / 192, rem_ = (un_) % 192, g_ = rem_ >> 6, h_ = (rem_ >> 3) & 7, su_ = rem_ & 7; \
        const int d_ = (g_ == 0) ? 1 : (g_ == 1 ? 4 : 16); const size_t tb_ = (size_t)b_ * SEQ; \
        const int r0_ = (g_ == 0) ? 0 : (g_ == 1 ? (su_ >> 1) : 2 * su_), c0_ = (g_ == 0) ? 2 * su_ : (g_ == 1 ? 2 * (su_ & 1) : 0); \
        const int rq_ = (g_ == 2) ? r0_ + sb : r0_, cq_ = (g_ == 2) ? 0 : c0_ + sb;
#define AT_LOAD(un_) do { AT_DEC(un_) \
        _Pragma("unroll") for (int i = 0; i < 6; ++i) { const int id = tid + 512 * i, j = id >> 3, ch = id & 7; \
            const int mp = (g_ == 2) ? (j & 127) : 128 * (c0_ - 1) + j, rr = (g_ == 2) ? r0_ + (j >> 7) : r0_; \
            kr[i] = (u32x4){0u, 0u, 0u, 0u}; vr[i] = (u32x4){0u, 0u, 0u, 0u}; \
            if (mp >= 0 && (g_ != 2 || j < 256)) { const size_t tk_ = tb_ + (size_t)mp * d_ + rr; kr[i] = *(const u32x4*)(ZB + ((size_t)(24 + g_ * 8 + h_) * TT + tk_) * 64 + 8 * ch); vr[i] = *(const u32x4*)(ZB + ((size_t)(48 + g_ * 8 + h_) * TT + tk_) * 64 + 8 * ch); } } \
        _Pragma("unroll") for (int qt = 0; qt < 2; ++qt) { const size_t tq_ = tb_ + (size_t)(128 * cq_ + 32 * wq + 16 * qt + l15) * d_ + rq_; \
            _Pragma("unroll") for (int ds = 0; ds < 2; ++ds) qn[qt][ds] = *(const bf16x8*)(ZB + ((size_t)(g_ * 8 + h_) * TT + tq_) * 64 + 32 * ds + 8 * q4); } } while (0)
    const bool xl = (G == 256); const int ustep = xl ? 32 : G, ubase = xl ? (bid & 7) * 192 : 0, ulim = xl ? ubase + 192 : 1536;
    { const int u0 = ubase + (xl ? (bid >> 3) : bid); AT_LOAD((u0 < ulim ? u0 : ulim - 1)); }
    for (int un = ubase + (xl ? (bid >> 3) : bid); un < ulim; un += ustep) {
        AT_DEC(un)
        const int g = g_, h = h_; const bool prev_ok = (g_ != 2) && (cq_ > 0); const int wbase = (g_ == 2) ? 128 * sb - 128 : 128 * sb;
        size_t tq[2];
#pragma unroll
        for (int qt = 0; qt < 2; ++qt) tq[qt] = tb_ + (size_t)(128 * cq_ + 32 * wq + 16 * qt + l15) * d_ + rq_;
#pragma unroll
        for (int i = 0; i < 6; ++i) { const int id = tid + 512 * i, j = id >> 3, ch = id & 7; *(LAS u32x4*)(KI + j * KP + 8 * ch) = kr[i]; *(LAS u32x4*)(VI + j * KP + 8 * ch) = vr[i]; }
        bf16x8 qf[2][2];
#pragma unroll
        for (int qt = 0; qt < 2; ++qt) { qf[qt][0] = qn[qt][0]; qf[qt][1] = qn[qt][1]; }
        LBAR();
        { const int nx = (un + ustep < ulim) ? un + ustep : un; AT_LOAD(nx); }
        f32x4 st[5][2][2]; float mx[2] = {-INFINITY, -INFINITY};
#pragma unroll
        for (int p = 0; p < 5; ++p) { const int a = wq + p; const bool on = prev_ok || a >= 4;
#pragma unroll
            for (int t = 0; t < 2; ++t) {
                if (on) { const int j0 = 32 * a + 16 * t, k = 2 * p + t; f32x4 s0 = (f32x4){0.f, 0.f, 0.f, 0.f}, s1 = (f32x4){0.f, 0.f, 0.f, 0.f};
#pragma unroll
                    for (int ds = 0; ds < 2; ++ds) { const bf16x8 kf = *(const LAS bf16x8*)(KI + (wbase + j0 + l15) * KP + 32 * ds + 8 * q4); if (k <= 8) s0 = mfma16(kf, qf[0][ds], s0); if (k >= 1) s1 = mfma16(kf, qf[1][ds], s1); }
#pragma unroll
                    for (int i = 0; i < 4; ++i) { const int kk = 4 * q4 + i;
                        if (k == 0) s0[i] = (kk >= l15) ? s0[i] : -INFINITY; if (k == 8) s0[i] = (kk <= l15) ? s0[i] : -INFINITY; if (k == 9) s0[i] = -INFINITY;
                        if (k == 1) s1[i] = (kk >= l15) ? s1[i] : -INFINITY; if (k == 9) s1[i] = (kk <= l15) ? s1[i] : -INFINITY; if (k == 0) s1[i] = -INFINITY;
                        mx[0] = fmaxf(mx[0], s0[i]); mx[1] = fmaxf(mx[1], s1[i]); }
                    st[p][t][0] = s0; st[p][t][1] = s1;
                } else { st[p][t][0] = (f32x4){-INFINITY, -INFINITY, -INFINITY, -INFINITY}; st[p][t][1] = st[p][t][0]; } } }
        float l[2] = {0.f, 0.f}; bf16x8 pf[5][2];
#pragma unroll
        for (int qt = 0; qt < 2; ++qt) { mx[qt] = fmaxf(mx[qt], __shfl_xor(mx[qt], 16)); mx[qt] = fmaxf(mx[qt], __shfl_xor(mx[qt], 32)); }
#pragma unroll
        for (int p = 0; p < 5; ++p)
#pragma unroll
            for (int qt = 0; qt < 2; ++qt) { float e[8];
#pragma unroll
                for (int t = 0; t < 2; ++t)
#pragma unroll
                    for (int i = 0; i < 4; ++i) { e[4 * t + i] = __builtin_amdgcn_exp2f(st[p][t][qt][i] - mx[qt]); l[qt] += e[4 * t + i]; }
                u32x4 pw; pw.x = pk_bf16(e[0], e[1]); pw.y = pk_bf16(e[2], e[3]); pw.z = pk_bf16(e[4], e[5]); pw.w = pk_bf16(e[6], e[7]); pf[p][qt] = __builtin_bit_cast(bf16x8, pw); }
#pragma unroll
        for (int qt = 0; qt < 2; ++qt) { l[qt] += __shfl_xor(l[qt], 16); l[qt] += __shfl_xor(l[qt], 32); }
        f32x4 o[4][2];
#pragma unroll
        for (int dt = 0; dt < 4; ++dt) { o[dt][0] = (f32x4){0.f, 0.f, 0.f, 0.f}; o[dt][1] = (f32x4){0.f, 0.f, 0.f, 0.f}; }
#pragma unroll
        for (int p = 0; p < 5; ++p) { const int a = wq + p; const bool on = prev_ok || a >= 4;
            if (on) {
#pragma unroll
                for (int dt = 0; dt < 4; ++dt) { const LAS u16* vp = VI + (wbase + 32 * a + 4 * q4 + (l15 >> 2)) * KP + 16 * dt + 4 * (l15 & 3);
                    const s16x4 lo = ds_tr(vp), hi = ds_tr(vp + 16 * KP); const bf16x8 vf = cat8(lo, hi); o[dt][0] = mfma16(vf, pf[p][0], o[dt][0]); o[dt][1] = mfma16(vf, pf[p][1], o[dt][1]); } } }
        LAS u16* stg = (LAS u16*)(lds + 2 * 384 * KP * 2 + w * 4608);
#pragma unroll
        for (int qt = 0; qt < 2; ++qt) { const float il = 1.0f / l[qt];
#pragma unroll
            for (int dt = 0; dt < 4; ++dt) *(LAS u32x2*)(stg + (16 * qt + l15) * 72 + 16 * dt + 4 * q4) = (u32x2){pk_bf16(o[dt][qt][0] * il, o[dt][qt][1] * il), pk_bf16(o[dt][qt][2] * il, o[dt][qt][3] * il)};
            if (q4 == 0) LSE[(size_t)g * TT * 8 + tq[qt] * 8 + h] = mx[qt] + __log2f(l[qt]); }
        asm volatile("s_waitcnt lgkmcnt(0)" ::: "memory");
#pragma unroll
        for (int i = 0; i < 4; ++i) { const int row = i * 8 + (lane >> 3), ch = lane & 7; const u32x4 v = *(const LAS u32x4*)(stg + row * 72 + 8 * ch);
            const size_t tr = tb_ + (size_t)(128 * cq_ + 32 * wq + row) * d_ + rq_;
            *(u32x4*)(OG + (size_t)g * TT * 512 + tr * 512 + h * 64 + 8 * ch) = v; }
        LBAR();
    }
#undef AT_DEC
#undef AT_LOAD
}
__device__ __forceinline__ void merge_phase(u16* OG, const float* LSE, const u16* AG, int bid, int nb) {
    for (int idx = bid * 512 + threadIdx.x; idx < TT * 64; idx += nb * 512) {
        const int tok = idx >> 6, h = (idx >> 3) & 7, ch = idx & 7; const size_t off = (size_t)tok * 512 + h * 64 + 8 * ch;
        const float l0 = LSE[(size_t)tok * 8 + h], l1 = LSE[(size_t)TT * 8 + (size_t)tok * 8 + h], l2 = LSE[(size_t)2 * TT * 8 + (size_t)tok * 8 + h];
        const float m = fmaxf(l0, fmaxf(l1, l2)); float w0 = __builtin_amdgcn_exp2f(l0 - m), w1 = __builtin_amdgcn_exp2f(l1 - m), w2 = __builtin_amdgcn_exp2f(l2 - m);
        const float inv = 1.0f / (w0 + w1 + w2); w0 *= inv; w1 *= inv; w2 *= inv;
        const u32x4 a = *(const u32x4*)(OG + off), bq = *(const u32x4*)(OG + (size_t)TT * 512 + off), cq = *(const u32x4*)(OG + (size_t)2 * TT * 512 + off), gq = *(const u32x4*)(AG + off);
        u32x4 o;
#define MRG(F) o.F = pk_bf16((w0 * bflo(a.F) + w1 * bflo(bq.F) + w2 * bflo(cq.F)) * bflo(gq.F), (w0 * bfhi(a.F) + w1 * bfhi(bq.F) + w2 * bfhi(cq.F)) * bfhi(gq.F))
        MRG(x); MRG(y); MRG(z); MRG(w);
#undef MRG
        store16_wt(OG + off, o);
    }
}

template <int MODE = 0> __device__ __forceinline__ void hgrn_unit(LAS unsigned char* lds, int b, int h, const u16* QA, const u16* GG, const u16* VA, const u16* HG, const float* nw, u16* OA, unsigned* dcnt) {
    const int tid = threadIdx.x, lane = tid & 63, w = __builtin_amdgcn_readfirstlane(tid >> 6), l15 = lane & 15, q4 = lane >> 4;
    constexpr int P = 136, IMGB = 52224;
    LAS u16* SB = (LAS u16*)(lds + 104448); LAS float* TOT = (LAS float*)(lds + 139264); LAS float* DFB = (LAS float*)(lds + 143360); LAS float* SSQ = (LAS float*)(lds + 146432);
    f32x4 S[8];
#pragma unroll
    for (int i = 0; i < 8; ++i) S[i] = (f32x4){0.f, 0.f, 0.f, 0.f};
    const int kp = lane, seg = w, tt = (w < 4) ? (w >> 1) : 3 - ((w - 4) >> 1), vh = w & 1;
    const size_t tok0 = (size_t)b * SEQ;
    unsigned gq0[8], qq0[8], gq1[8], qq1[8]; u32x4 vv0[2], vv1[2]; u32x2 hg0[4], hg1[4];
    f32x4 O[4]; float sqp = 0.f;
#pragma unroll
    for (int j = 0; j < 4; ++j) O[j] = (f32x4){0.f, 0.f, 0.f, 0.f};
#define HG_LOAD(c, gq, qq, vv) do { const size_t t0_ = tok0 + 64 * (c); \
        _Pragma("unroll") for (int i = 0; i < 8; ++i) { const size_t o_ = (t0_ + 8 * seg + i) * 1024 + h * 128 + 2 * kp; gq[i] = *(const unsigned*)(GG + o_); qq[i] = *(const unsigned*)(QA + o_); } \
        _Pragma("unroll") for (int u_ = 0; u_ < 2; ++u_) { const int id_ = tid + 512 * u_; vv[u_] = *(const u32x4*)(VA + (t0_ + (id_ >> 4)) * 1024 + h * 128 + 8 * (id_ & 15)); } } while (0)
#define HG_LOADG(c, hgv) do { const size_t tq_ = tok0 + 64 * (c) + 16 * tt + l15; \
        _Pragma("unroll") for (int j = 0; j < 4; ++j) hgv[j] = *(const u32x2*)(HG + tq_ * 1024 + h * 128 + 16 * (4 * vh + j) + 4 * q4); } while (0)
#define HG_PREP1(gq) do { float r0_ = 1.f, r1_ = 1.f; \
        _Pragma("unroll") for (int i = 0; i < 8; ++i) { r0_ *= f16lo(gq[i]); r1_ *= f16hi(gq[i]); } \
        *(LAS f32x2*)(TOT + seg * 128 + 2 * kp) = (f32x2){__log2f(r0_), __log2f(r1_)}; } while (0)
#define HG_PREP2(buf, gq, qq, vv) do { LAS u16* QM_ = (LAS u16*)(lds + (buf) * IMGB); LAS u16* KM_ = (LAS u16*)(lds + (buf) * IMGB + 17408); LAS u16* VI_ = (LAS u16*)(lds + (buf) * IMGB + 34816); LAS float* DF_ = DFB + (buf) * 384; \
        float off0 = 0.f, off1 = 0.f, br0 = 0.f, br1 = 0.f, bl0 = 0.f, bl1 = 0.f; \
        _Pragma("unroll") for (int s2 = 0; s2 < 8; ++s2) { const f32x2 t_ = *(const LAS f32x2*)(TOT + s2 * 128 + 2 * kp); \
            if (s2 < seg) { off0 += t_.x; off1 += t_.y; } if (s2 < 4) { br0 += t_.x; br1 += t_.y; } bl0 += t_.x; bl1 += t_.y; } \
        off0 -= br0; off1 -= br1; \
        float E0 = __builtin_amdgcn_exp2f(fminf(off0, 115.f)), E1 = __builtin_amdgcn_exp2f(fminf(off1, 115.f)), I0 = __builtin_amdgcn_exp2f(fminf(-off0, 115.f)), I1 = __builtin_amdgcn_exp2f(fminf(-off1, 115.f)); \
        _Pragma("unroll") for (int i = 0; i < 8; ++i) { const int s_ = 8 * seg + i; const float f0_ = f16lo(gq[i]), f1_ = f16hi(gq[i]); \
            E0 *= f0_; E1 *= f1_; I0 *= __builtin_amdgcn_rcpf(f0_); I1 *= __builtin_amdgcn_rcpf(f1_); \
            *(LAS unsigned*)(QM_ + s_ * P + 2 * kp) = pk_bf16(bflo(qq[i]) * E0, bfhi(qq[i]) * E1); \
            *(LAS unsigned*)(KM_ + s_ * P + 2 * kp) = pk_bf16((1.0f - f0_) * I0, (1.0f - f1_) * I1); } \
        if (seg == 0) { *(LAS f32x2*)(DF_ + 2 * kp) = (f32x2){__builtin_amdgcn_exp2f(bl0), __builtin_amdgcn_exp2f(bl1)}; *(LAS f32x2*)(DF_ + 128 + 2 * kp) = (f32x2){__builtin_amdgcn_exp2f(bl0 - br0), __builtin_amdgcn_exp2f(bl1 - br1)}; *(LAS f32x2*)(DF_ + 256 + 2 * kp) = (f32x2){__builtin_amdgcn_exp2f(br0), __builtin_amdgcn_exp2f(br1)}; } \
        _Pragma("unroll") for (int u_ = 0; u_ < 2; ++u_) { const int id_ = tid + 512 * u_; *(LAS u32x4*)(VI_ + (id_ >> 4) * P + 8 * (id_ & 15)) = vv[u_]; } } while (0)
#define HG_STAGE(hgv) do { \
        _Pragma("unroll") for (int j = 0; j < 4; ++j) { const f32x4 n4 = nwv[j]; const int row_ = 16 * tt + l15, c16_ = 2 * (4 * vh + j) + (q4 >> 1); \
            *(LAS u32x2*)(STG + row_ * 256 + ((c16_ ^ l15) << 4) + 8 * (q4 & 1)) = (u32x2){pk_bf16(O[j][0] * n4[0] * bflo(hgv[j].x), O[j][1] * n4[1] * bfhi(hgv[j].x)), \
                                                                                         pk_bf16(O[j][2] * n4[2] * bflo(hgv[j].y), O[j][3] * n4[3] * bfhi(hgv[j].y))}; } } while (0)
#define HG_COPY(c) do { \
        _Pragma("unroll") for (int u_ = 0; u_ < 2; ++u_) { const int id_ = tid + 512 * u_, row_ = id_ >> 4, ch_ = id_ & 15; \
            const float sc_ = rsqrtf((SSQ[((row_ >> 4) * 2) * 16 + (row_ & 15)] + SSQ[((row_ >> 4) * 2 + 1) * 16 + (row_ & 15)]) * (1.0f / 128.0f) + NORM_EPS); \
            const u32x4 v_ = *(const LAS u32x4*)(STG + row_ * 256 + ((ch_ ^ (row_ & 15)) << 4)); u32x4 o_; \
            o_.x = pk_bf16(bflo(v_.x) * sc_, bfhi(v_.x) * sc_); o_.y = pk_bf16(bflo(v_.y) * sc_, bfhi(v_.y) * sc_); o_.z = pk_bf16(bflo(v_.z) * sc_, bfhi(v_.z) * sc_); o_.w = pk_bf16(bflo(v_.w) * sc_, bfhi(v_.w) * sc_); \
            if (MODE & 8) { dacc_ ^= o_.x ^ o_.w; } else *(u32x4*)(OA + (tok0 + 64 * (c) + row_) * 1024 + h * 128 + 8 * ch_) = o_; } } while (0)
    unsigned dacc_ = 0u;
    LAS unsigned char* STG = lds + 146944;
    f32x4 nwv[4];
#pragma unroll
    for (int j = 0; j < 4; ++j) nwv[j] = *(const f32x4*)(nw + 16 * (4 * vh + j) + 4 * q4);
    HG_LOAD(0, gq0, qq0, vv0); HG_LOADG(0, hg0); HG_LOADG(0, hg1); if (tid < 128) SSQ[tid] = 1.0f; HG_PREP1(gq0); LBAR(); HG_PREP2(0, gq0, qq0, vv0);
    for (int i = tid; i < 128 * P / 2; i += 512) ((LAS unsigned*)SB)[i] = 0u;
    HG_LOAD(1, gq1, qq1, vv1); HG_LOAD(2, gq0, qq0, vv0); LBAR(); HG_PREP1(gq1); LBAR();
#ifdef PROBE_ACC
    unsigned tacc_ = 0u, tlast_ = (unsigned)__builtin_amdgcn_s_memrealtime();
#define HG_T(k) do { if (blockIdx.x == 0 && tid == 448) { const unsigned n_ = (unsigned)__builtin_amdgcn_s_memrealtime(); if ((k) == PROBE_ACC) tacc_ += n_ - tlast_; tlast_ = n_; } } while (0)
#else
#define HG_T(k) do {} while (0)
#endif
#define HG_STEP(c, G2, Q2, V2, G1, HGU, HGL) do { HG_T(2); \
        const int cur = (c) & 1, nxt = cur ^ 1; \
        const LAS u16* QM = (const LAS u16*)(lds + cur * IMGB); const LAS u16* KM = (const LAS u16*)(lds + cur * IMGB + 17408); const LAS u16* VI = (const LAS u16*)(lds + cur * IMGB + 34816); const LAS float* DF = DFB + cur * 384; \
        if (!(MODE & 4)) HG_COPY(((c) > 0 ? (c) - 1 : 0)); \
        if (!(MODE & 2)) HG_PREP2(nxt, G2, Q2, V2); HG_LOADG(((c) + 1 < 32 ? (c) + 1 : 31), HGL); \
        HG_LOAD(((c) + 3 < 32 ? (c) + 3 : 31), G2, Q2, V2); HG_T(0); \
        if (!(MODE & 1)) { \
        bf16x8 qm[4]; \
        _Pragma("unroll") for (int ks = 0; ks < 4; ++ks) qm[ks] = *(const LAS bf16x8*)(QM + (16 * tt + l15) * P + 32 * ks + 8 * q4); \
        f32x4 Dm[4]; \
        _Pragma("unroll") for (int st = 0; st < 4; ++st) { Dm[st] = (f32x4){0.f, 0.f, 0.f, 0.f}; \
            _Pragma("unroll") for (int ks = 0; ks < 4; ++ks) { const bf16x8 kf = *(const LAS bf16x8*)(KM + (16 * st + l15) * P + 32 * ks + 8 * q4); Dm[st] = mfma16(kf, qm[ks], Dm[st]); } \
            _Pragma("unroll") for (int i = 0; i < 4; ++i) { const bool keep_ = (st < tt) || (st == tt && 4 * q4 + i <= l15); Dm[st][i] = keep_ ? Dm[st][i] : 0.f; } } \
        bf16x8 pf[2]; \
        _Pragma("unroll") for (int a = 0; a < 2; ++a) { u32x4 pw; pw.x = pk_bf16(Dm[2 * a][0], Dm[2 * a][1]); pw.y = pk_bf16(Dm[2 * a][2], Dm[2 * a][3]); pw.z = pk_bf16(Dm[2 * a + 1][0], Dm[2 * a + 1][1]); pw.w = pk_bf16(Dm[2 * a + 1][2], Dm[2 * a + 1][3]); pf[a] = __builtin_bit_cast(bf16x8, pw); } \
        _Pragma("unroll") for (int j = 0; j < 4; ++j) { const int vt = 4 * vh + j; f32x4 o = (f32x4){0.f, 0.f, 0.f, 0.f}; \
            _Pragma("unroll") for (int a = 0; a < 2; ++a) { const LAS u16* vp = VI + (32 * a + 4 * q4 + (l15 >> 2)) * P + 16 * vt + 4 * (l15 & 3); \
                const s16x4 lo = ds_tr(vp), hi = ds_tr(vp + 16 * P); o = mfma16(cat8(lo, hi), pf[a], o); } \
            _Pragma("unroll") for (int ks = 0; ks < 4; ++ks) { const bf16x8 sf = *(const LAS bf16x8*)(SB + (16 * vt + l15) * P + 32 * ks + 8 * q4); o = mfma16(sf, qm[ks], o); } \
            O[j] = o; } \
        { bf16x8 ka[2]; \
            _Pragma("unroll") for (int a = 0; a < 2; ++a) { const LAS u16* kpp = KM + (32 * a + 8 * q4 + (l15 >> 2)) * P + 16 * w + 4 * (l15 & 3); const s16x4 lo = ds_tr(kpp), hi = ds_tr(kpp + 4 * P); ka[a] = cat8(lo, hi); } \
            const f32x4 d1 = *(const LAS f32x4*)(DF + 16 * w + 4 * q4), d2 = *(const LAS f32x4*)(DF + 128 + 16 * w + 4 * q4); \
            _Pragma("unroll") for (int vt = 0; vt < 8; ++vt) { f32x4 U = (f32x4){0.f, 0.f, 0.f, 0.f}; \
                _Pragma("unroll") for (int a = 0; a < 2; ++a) { const LAS u16* vp = VI + (32 * a + 8 * q4 + (l15 >> 2)) * P + 16 * vt + 4 * (l15 & 3); const s16x4 lo = ds_tr(vp), hi = ds_tr(vp + 4 * P); U = mfma16(ka[a], cat8(lo, hi), U); } \
                S[vt] = d1 * S[vt] + d2 * U; } } \
        { float sq = 0.f; \
            _Pragma("unroll") for (int j = 0; j < 4; ++j) sq += (O[j][0] * O[j][0] + O[j][1] * O[j][1]) + (O[j][2] * O[j][2] + O[j][3] * O[j][3]); \
            sq += __shfl_xor(sq, 16); sq += __shfl_xor(sq, 32); sqp = sq; } } \
        HG_T(1); \
        LBAR(); HG_T(2); \
        { const f32x4 eb = *(const LAS f32x4*)(DFB + nxt * 384 + 256 + 16 * w + 4 * q4); \
            _Pragma("unroll") for (int vt = 0; vt < 8; ++vt) *(LAS u32x2*)(SB + (16 * vt + l15) * P + 16 * w + 4 * q4) = (u32x2){pk_bf16(S[vt][0] * eb[0], S[vt][1] * eb[1]), pk_bf16(S[vt][2] * eb[2], S[vt][3] * eb[3])}; } \
        if (q4 == 0) SSQ[(tt * 2 + vh) * 16 + l15] = sqp; \
        if (!(MODE & 4)) HG_STAGE(HGU); \
        if (!(MODE & 2)) HG_PREP1(G1); HG_T(3); \
        LBAR(); } while (0)
    for (int c = 0; c < 32; c += 2) {
        if (c == 20 && dcnt) {
            if (tid == 0) { unsigned sp = 0u;
                while (__hip_atomic_load(dcnt + 64 * (8 * b + 6), __ATOMIC_RELAXED, __HIP_MEMORY_SCOPE_AGENT) < 16u || __hip_atomic_load(dcnt + 64 * (8 * b + 7), __ATOMIC_RELAXED, __HIP_MEMORY_SCOPE_AGENT) < 16u) { __builtin_amdgcn_s_sleep(2); if (++sp > (1u << 22)) break; }
                __builtin_amdgcn_fence(__ATOMIC_ACQUIRE, "agent"); asm volatile("s_waitcnt vmcnt(0)" ::: "memory"); }
            LBAR(); }
        HG_STEP(c, gq1, qq1, vv1, gq0, hg0, hg1);
        HG_STEP(c + 1, gq0, qq0, vv0, gq1, hg1, hg0);
    }
    HG_COPY(31);
    if (MODE & 8) { if (dacc_ == 0x12345678u) OA[tid] = (u16)dacc_; }
#ifdef PROBE_ACC
    if (blockIdx.x == 0 && tid == 448) ((LAS unsigned long long*)(lds + 163344))[10] = (unsigned long long)tacc_;
#endif
#undef HG_STEP
#undef HG_LOAD
#undef HG_LOADG
#undef HG_PREP1
#undef HG_PREP2
#undef HG_STAGE
#undef HG_COPY
    LBAR();
}

#define XB_TMO      128
#define XB_XCNT(j)  (256  + 64 * (j))
#define XB_XSUB(j)  (1280 + 64 * (j))
#define XB_XGEN(j)  (2304 + 64 * (j))
#define XB_TOP      3328
#define XB_TOPGEN   3392
#define XCD_BAR_WORDS 3456
#define XB_SPIN_CAP (1u << 18)

__device__ __forceinline__ unsigned xb_ld(unsigned* p)              { return __hip_atomic_load(p, __ATOMIC_RELAXED, __HIP_MEMORY_SCOPE_AGENT); }
__device__ __forceinline__ unsigned xb_add(unsigned* p, unsigned v) { return __hip_atomic_fetch_add(p, v, __ATOMIC_RELAXED, __HIP_MEMORY_SCOPE_AGENT); }
__device__ __forceinline__ unsigned xb_xcc_id() { return (unsigned)__builtin_amdgcn_s_getreg((3 << 11) | 20) & 0xFu; }
#define XB_SPIN(cond, bar) do { unsigned _sp = 0; while (cond) { __builtin_amdgcn_s_sleep(1); \
    if ((++_sp & 255u) == 0u) { if (xb_ld(&(bar)[XB_TMO])) break; if (_sp > XB_SPIN_CAP) { atomicAdd(&(bar)[XB_TMO], 1u); break; } } } } while (0)

struct XcdBarrier {
    unsigned* bar; unsigned x;
    volatile LAS unsigned* st;
};

__device__ __forceinline__ XcdBarrier xcd_barrier_post(unsigned* bar, volatile LAS unsigned* st) {
    XcdBarrier b; b.bar = bar; b.x = xb_xcc_id(); b.st = st;
    if (threadIdx.x == 0) (void)xb_add(&bar[XB_XCNT(b.x)], 1u);
    return b;
}
__device__ __forceinline__ void xcd_barrier_complete(unsigned* bar, unsigned x, unsigned& nloc, unsigned& nx) {
    const unsigned G = gridDim.x * gridDim.y * gridDim.z;
    unsigned sum, cnt, mine, sp = 0u;
    for (;;) {
        sum = 0u; cnt = 0u; mine = 0u;
#pragma unroll
        for (unsigned j = 0; j < 16; ++j) { const unsigned c = xb_ld(&bar[XB_XCNT(j)]); sum += c; cnt += (c > 0u) ? 1u : 0u; mine = (j == x) ? c : mine; }
        if (sum == G) break;
        __builtin_amdgcn_s_sleep(1);
        if ((++sp & 255u) == 0u) { if (xb_ld(&bar[XB_TMO])) break; if (sp > XB_SPIN_CAP) { atomicAdd(&bar[XB_TMO], 1u); break; } }
    }
    nloc = mine > 0u ? mine : 1u; nx = cnt > 0u ? cnt : 1u;
}

__device__ __forceinline__ void xcd_barrier(const XcdBarrier& b) {
    asm volatile("s_waitcnt vmcnt(0)" ::: "memory");
    __syncthreads();
    if (threadIdx.x == 0) {
        unsigned* bar = b.bar;
        __builtin_amdgcn_s_waitcnt(0);
        unsigned nloc = b.st[0], nx = b.st[1];
        if (nloc == 0u) { xcd_barrier_complete(bar, b.x, nloc, nx); b.st[0] = nloc; b.st[1] = nx; }
        const unsigned old = xb_add(&bar[XB_XSUB(b.x)], 1u);
        const unsigned gen = old / nloc;
        if (old + 1u == (gen + 1u) * nloc) {
            __builtin_amdgcn_fence(__ATOMIC_RELEASE, "agent");
            asm volatile("s_waitcnt vmcnt(0)" ::: "memory");
            const unsigned og = xb_add(&bar[XB_TOP], 1u);
            const unsigned tg = og / nx;
            if (og + 1u == (tg + 1u) * nx) xb_add(&bar[XB_TOPGEN], 1u);
            else XB_SPIN(xb_ld(&bar[XB_TOPGEN]) == tg, bar);
            __builtin_amdgcn_fence(__ATOMIC_ACQUIRE, "agent");
            xb_add(&bar[XB_XGEN(b.x)], 1u);
            asm volatile("s_waitcnt vmcnt(0)" ::: "memory");
        } else {
            XB_SPIN(xb_ld(&bar[XB_XGEN(b.x)]) == gen, bar);
            __builtin_amdgcn_fence(__ATOMIC_ACQUIRE, "agent");
            asm volatile("s_waitcnt vmcnt(0)" ::: "memory");
        }
    }
    __syncthreads();
}

struct Args { const float* in[10]; float* out; unsigned char* ws; int ph_lo, ph_hi; };
__global__ void __launch_bounds__(512, 2) fwd_megakernel(Args a) {
    extern __shared__ __attribute__((aligned(16))) unsigned char lds_raw[];
    LAS unsigned char* lds = (LAS unsigned char*)lds_raw;
    cg::grid_group grid = cg::this_grid();
    const int G = gridDim.x, bx = blockIdx.x, vcu = (G % 8 == 0) ? (bx % 8) * (G / 8) + bx / 8 : bx;
    const int tid = threadIdx.x, lane = tid & 63, wave = __builtin_amdgcn_readfirstlane(tid >> 6);
    Ptrs P; P.x = a.in[0]; P.pos = (const int*)a.in[1]; P.norm_w = a.in[2]; P.w_in = a.in[3]; P.lbl = a.in[4]; P.hnw = a.in[5]; P.wa = a.in[6]; P.wb = a.in[7]; P.wo = a.in[8]; P.fnw = a.in[9];
    P.out = a.out; P.ws = a.ws;
    unsigned char* ws = a.ws; unsigned char* dout = (unsigned char*)a.out;
    const int lo = a.ph_lo, hi = a.ph_hi;
#ifndef REP_MASK
#define REP_MASK 0
#endif
#define IN(k) (lo <= (k) && (k) < hi)
#define REPS(k) for (int rep_ = 0; rep_ < 1 + ((REP_MASK >> (k)) & 1); ++rep_)
#ifdef PROBE_K
#ifndef PROBE_A
#define PROBE_A PROBE_K
#define PROBE_B (PROBE_K + 1)
#endif
#define STAMP(k) do { if (bx == 0 && tid == 0) ((LAS unsigned long long*)(lds + 163344))[k] = __builtin_amdgcn_s_memrealtime(); } while (0)
#else
#define STAMP(k) do {} while (0)
#endif
#define SEAM(k) do { if (IN(k) && IN((k) + 1)) xcd_barrier(bar); STAMP((k) + 1); } while (0)
    if (tid < 4) ((LAS unsigned*)(lds + 163328))[tid] = 0u;
    __syncthreads();
    const XcdBarrier bar = xcd_barrier_post((unsigned*)(ws + WS_BAR), (volatile LAS unsigned*)(lds + 163328));
    if (a.ph_hi > 1000) grid.sync();
    STAMP(0);
    if (IN(0)) REPS(0) p0_prologue(P, lds, vcu, G);
    SEAM(0);
#ifdef EXTRA_SYNCS
    for (int i_ = 0; i_ < EXTRA_SYNCS; ++i_) xcd_barrier(bar);
#endif
    if (IN(1)) REPS(1) { pg8::Gemm g{(const u16*)(ws + WS_H), (const u16*)(ws + WS_WT) + (size_t)6144 * 1024, TT, 5120, 1024}; pg8::StaticOrder S; S.init(TT, 5120, G, bx);
        EpiZ E{0, ws, dout, P.lbl}; pg8::gemm_phase<EpiZ, pg8::StaticOrder, true, true>(lds, g, S, E); }
    SEAM(1);
    if (IN(2)) REPS(2) attn_phase(lds, (const u16*)(ws + WS_Z), (u16*)(dout + DO_OG), (float*)(ws + WS_COS), bx, G);
    SEAM(2);
    if (IN(3)) {
        pg8::Gemm g{(const u16*)(ws + WS_H), (const u16*)(ws + WS_WT), TT, 4096, 1024}; DefOrder S; S.base.init(48 * 256, 4096, G, bx);
        EpiZ E{1, ws, dout, P.lbl}; pg8::gemm_phase<EpiZ, DefOrder, true, true>(lds, g, S, E); }
    SEAM(3);
    if (IN(4)) {
        {
            if (bx < 64) { hgrn_unit(lds, bx >> 3, bx & 7, (const u16*)(ws + Z_QA), (const u16*)(ws + Z_G), (const u16*)(ws + Z_VA), (const u16*)(ws + Z_HG), P.hnw, (u16*)(ws + Z_QA), (unsigned*)(ws + WS_BAR + 36864)); STAMP(9);
            }
            else { const int x = bx & 7, r = (bx >> 3) - 8;
                const pg8::Gemm gG{(const u16*)(ws + WS_H), (const u16*)(ws + WS_WT) + (size_t)4096 * 1024, TT, 2048, 1024}; const pg8::Gemm gB{(const u16*)(dout + DO_OG), (const u16*)(ws + WS_WB), TT, 1024, 512};
                const EpiZ EG{2, ws, dout, P.lbl}; const EpiGateB EB{(const u16*)(ws + Z_GATES), (u16*)(dout + DO_TMPB)};
                unsigned lg, lb2;
                if (r < 8) { lg = lo_code(r, 4) | (lo_code(r + 24, 4) << 8) | 0xffff0000u; lb2 = lo_code(r, 0) | (lo_code(r + 24, 0) << 8) | 0xffff0000u; }
                else { lg = lo_code(r, 4) | (lo_code(2 * (r - 8), 0) << 8) | (lo_code(2 * (r - 8) + 1, 0) << 16) | 0xff000000u; lb2 = lo_code(r, 0) | 0xffffff00u; }
                unsigned* mcnt = (unsigned*)(ws + WS_BAR + 16384 + 64 * 64 * 4);
                unsigned* dcnt = (unsigned*)(ws + WS_BAR + 36864);
                { unsigned ld; if (r < 8) ld = (unsigned)(((2 * r) << 3) | 6) | ((unsigned)(((2 * r + 1) << 3) | 6) << 8) | 0xffff0000u; else ld = (unsigned)(((r - 8) << 3) | 7) | 0xffffff00u;
                  const pg8::Gemm gD{(const u16*)(ws + WS_H), (const u16*)(ws + WS_WT), TT, 4096, 1024}; const EpiZT<true> ED{1, ws, dout, P.lbl};
                  ListOrder S{8 * x, ld}; pg8::gemm_phase<EpiZT<true>, ListOrder, true, true>(lds, gD, S, ED);
                  asm volatile("s_waitcnt vmcnt(0)" ::: "memory"); __syncthreads();
                  if (tid == 0) __hip_atomic_fetch_add(dcnt + 64 * (8 * x + (r < 8 ? 6 : 7)), (r < 8 ? 2u : 1u), __ATOMIC_RELAXED, __HIP_MEMORY_SCOPE_AGENT); }
                merge_phase((u16*)(dout + DO_OG), (const float*)(ws + WS_COS), (const u16*)(dout + DO_AG), bx - 64, 192);
                asm volatile("s_waitcnt vmcnt(0)" ::: "memory"); __syncthreads();
                if (tid == 0) __hip_atomic_fetch_add(mcnt, 1u, __ATOMIC_RELAXED, __HIP_MEMORY_SCOPE_AGENT);
                { ListOrder S{8 * x, lg}; pg8::gemm_phase<EpiZ, ListOrder, true, true>(lds, gG, S, EG); }
                if (tid == 0) { unsigned sp = 0u; while (__hip_atomic_load(mcnt, __ATOMIC_RELAXED, __HIP_MEMORY_SCOPE_AGENT) < 192u) { __builtin_amdgcn_s_sleep(2); if (++sp > (1u << 22)) break; }
                    __builtin_amdgcn_fence(__ATOMIC_ACQUIRE, "agent"); asm volatile("s_waitcnt vmcnt(0)" ::: "memory"); }
                __syncthreads();
                { ListOrder S{8 * x, lb2}; pg8::gemm_phase<EpiGateB, ListOrder, true, true>(lds, gB, S, EB); } }
        }
    }
    SEAM(4);
    if (IN(5)) { pg8::Gemm g{(const u16*)(ws + Z_QA), (const u16*)(ws + WS_WA), TT, 1024, 1024}; pg8::StaticOrder S; S.init(TT, 1024, G, bx);
        EpiGateA E{(const u16*)(ws + Z_GATES), (const u16*)(dout + DO_TMPB), (u16*)(ws + Z_MERGED)}; pg8::gemm_phase<EpiGateA, pg8::StaticOrder, true, true>(lds, g, S, E); }
    SEAM(5);
    if (IN(6)) { pg8::Gemm g{(const u16*)(ws + Z_MERGED), (const u16*)(ws + WS_WO), TT, 1024, 1024}; pg8::StaticOrder S; S.init(TT, 1024, G, bx);
        EpiOutNorm E{P.x, P.out, P.fnw, (float*)(ws + WS_BAR + 65536), (unsigned*)(ws + WS_BAR + 16384)}; pg8::gemm_phase<EpiOutNorm, pg8::StaticOrder, false, true>(lds, g, S, E); }
#ifdef HG_PROBE_MODE
    if (bx < 64) hgrn_unit<HG_PROBE_MODE>(lds, bx >> 3, bx & 7, (const u16*)(ws + Z_QA), (const u16*)(ws + Z_G), (const u16*)(ws + Z_VA), (const u16*)(ws + Z_HG), P.hnw, (u16*)(ws + Z_HG), nullptr);
#endif
#ifdef PROBE_K
    STAMP(7);
    if (bx == 0 && tid == 0) { const LAS unsigned long long* ts = (const LAS unsigned long long*)(lds + 163344);
#ifdef PROBE_ACC
        const unsigned long long dt = ts[10], t0
#else
        const unsigned long long dt = ts[PROBE_B] - ts[PROBE_A], t0
#endif
 = __builtin_amdgcn_s_memrealtime();
        while (__builtin_amdgcn_s_memrealtime() - t0 < dt) __builtin_amdgcn_s_sleep(8); }
#endif
#undef IN
#undef SEAM
}

extern "C" void kernel_launch(void* const* d_in, const int* in_sizes, int n_in, void* d_out, int out_size, void* d_ws, size_t ws_size, hipStream_t stream) {
    static int grid = 0;
    if (grid == 0) {
        if (n_in != 10 || in_sizes[0] != TT * DM || out_size != TT * DM || ws_size < WS_END) { fprintf(stderr, "kernel_launch: unexpected shapes (n_in %d, in0 %d, out %d, ws %zu)\n", n_in, n_in > 0 ? in_sizes[0] : -1, out_size, ws_size); grid = -1; return; }
        int dev = 0, cus = 0, per_cu = 0;
        hipGetDevice(&dev); hipDeviceGetAttribute(&cus, hipDeviceAttributeMultiprocessorCount, dev);
        if (hipFuncSetAttribute((const void*)fwd_megakernel, hipFuncAttributeMaxDynamicSharedMemorySize, LDS_BYTES) != hipSuccess) { fprintf(stderr, "kernel_launch: hipFuncSetAttribute failed\n"); grid = -1; return; }
        if (hipOccupancyMaxActiveBlocksPerMultiprocessor(&per_cu, (const void*)fwd_megakernel, 512, LDS_BYTES) != hipSuccess || per_cu < 1) { fprintf(stderr, "kernel_launch: occupancy query says %d\n", per_cu); per_cu = 1; }
        (void)hipGetLastError();
        grid = cus * (per_cu > 1 ? 1 : per_cu);
        if (grid != 256) { fprintf(stderr, "kernel_launch: built for a 256-CU device (one workgroup per CU); got %d\n", grid); grid = -1; return; }
    }
    if (grid < 0) return;
    if (hipMemsetAsync((char*)d_ws + WS_BAR, 0, 36864 + 16384, stream) != hipSuccess) { fprintf(stderr, "kernel_launch: memset of the barrier words failed\n"); return; }
    Args a{};
    for (int i = 0; i < 10; ++i) a.in[i] = (const float*)d_in[i];
    a.out = (float*)d_out; a.ws = (unsigned char*)d_ws; a.ph_lo = 0; a.ph_hi = 7;
    void* args[] = {&a};
    hipError_t e = hipLaunchCooperativeKernel((const void*)fwd_megakernel, dim3(grid), dim3(512), args, LDS_BYTES, stream);
    if (e != hipSuccess) fprintf(stderr, "kernel_launch: cooperative launch failed: %s (grid %d)\n", hipGetErrorString(e), grid);
}
```

```cpp
#include <hip/hip_runtime.h>
#include <hip/hip_cooperative_groups.h>
#include <hip/hip_bf16.h>
#include <cstdio>
#include <cstdint>
#include <cmath>
namespace cg = cooperative_groups;
namespace pg8 {
#define PG8_LAS __attribute__((address_space(3)))
typedef unsigned short bf16_t;
typedef short bf16x8 __attribute__((ext_vector_type(8)));
typedef float f32x4 __attribute__((ext_vector_type(4)));
typedef unsigned u32x4 __attribute__((ext_vector_type(4)));
constexpr int BM = 256, BK = 64, HALF = 128, HTB = HALF * BK * 2  , STAGE_BYTES = 8 * HTB, NXCD = 8, WGM = 8;

__host__ __device__ __forceinline__ int lds_byte(int r, int c) { const int st = (r >> 4) * 2 + (c >> 5), rr = r & 15, cc = c & 31, ob = rr * 64 + cc * 2; return st * 1024 + (ob ^ (((ob >> 9) & 1) << 5)); }
__host__ __device__ __forceinline__ void stage_rc(int b, int& R, int& C) { const int st = b / 1024, sb = b % 1024, swz = sb ^ (((sb >> 9) & 1) << 5); R = (st >> 1) * 16 + swz / 64; C = (st & 1) * 32 + (swz % 64) / 2; }
__host__ __device__ __forceinline__ int perm32(int rho) { const int n = rho >> 4, i = rho & 15; return 8 * (i >> 2) + 4 * n + (i & 3); }

struct Unit { int pm, pn; };
struct Gemm { const bf16_t* A; const bf16_t* Bt; int M, N, K; };

struct StaticOrder {
    int nM, nN, nwg, G, c;
    __host__ __device__ void init(int M, int N, int G_, int c_) { nM = M / BM; nN = N / BM; nwg = nM * nN; G = G_; c = c_; }
    __host__ __device__ bool next(int i, Unit& u) const {
        const long L = (long)i * G + c; if (L >= nwg) return false;
        int wgid = (int)L; { const int q = nwg / NXCD, r = nwg % NXCD, xcd = wgid % NXCD, off = wgid / NXCD; wgid = (xcd < r ? xcd * (q + 1) : r * (q + 1) + (xcd - r) * q) + off; }
        const int nig = WGM * nN, gid = wgid / nig, fm = gid * WGM, gsz = (nM - fm) < WGM ? (nM - fm) : WGM;
        u.pm = fm + ((wgid % nig) % gsz); u.pn = (wgid % nig) / gsz; return true;
    }
    __device__ __forceinline__ void a_ready(const Unit&) const {}
    __device__ __forceinline__ void done(const Unit&) const {}
};

__device__ __forceinline__ unsigned cvt_pk_bf16(float lo, float hi) { unsigned r; asm volatile("v_cvt_pk_bf16_f32 %0, %1, %2" : "=v"(r) : "v"(lo), "v"(hi)); return r; }
typedef float f32x2 __attribute__((ext_vector_type(2)));
template <class Epi, class Sched, bool ALIGN_EPI = false, bool SP2 = false>
__device__ __forceinline__ void gemm_phase(PG8_LAS unsigned char* lds, const Gemm g, const Sched& S, const Epi& E) {
    const int tid = threadIdx.x, wid = __builtin_amdgcn_readfirstlane(tid >> 6), lane = tid & 63, wr = wid >> 2, wc = wid & 3, fr = lane & 15, fq = lane >> 4;
    const int K = g.K, nt = K / BK;
    unsigned voffA[2], voffB[2];
#pragma unroll
    for (int i = 0; i < 2; ++i) { int R, C; stage_rc(tid * 16 + i * 8192, R, C); const int Rb = Epi::PERM ? ((R & ~31) + perm32(R & 31)) : R;
        voffA[i] = (unsigned)(R * K + C) * 2u; voffB[i] = (unsigned)(Rb * K + C) * 2u; }
    const size_t kstep = (size_t)(BK * 2);
    const size_t hstep = (size_t)HALF * K * 2;
    const size_t tstep = 2 * hstep;
    const unsigned ldsw = (unsigned)wid * 1024u;
    const int aoff = lds_byte(wr * 64 + fr, fq * 8), boff = lds_byte(wc * 32 + fr, fq * 8);
#define PG8_SA(b, h) (((b) * 2 + (h)) * HTB)
#define PG8_SB(b, h) ((4 + (b) * 2 + (h)) * HTB)
#define PG8_STAGE(bufoff, gbase, voff) do { _Pragma("unroll") for (int _i = 0; _i < 2; ++_i) \
        __builtin_amdgcn_global_load_lds((const unsigned*)((const char*)(gbase) + (voff)[_i]), (PG8_LAS unsigned*)(lds + (bufoff) + ldsw + _i * 8192), 16, 0, 0); } while (0)
#define PG8_LDA(dst, b, h) do { _Pragma("unroll") for (int m = 0; m < 4; ++m) _Pragma("unroll") for (int k = 0; k < 2; ++k) dst[m][k] = *(const PG8_LAS bf16x8*)(lds + PG8_SA(b, h) + aoff + m * 2048 + k * 1024); } while (0)
#define PG8_LDB(dst, b, h) do { _Pragma("unroll") for (int n = 0; n < 2; ++n) _Pragma("unroll") for (int k = 0; k < 2; ++k) dst[n][k] = *(const PG8_LAS bf16x8*)(lds + PG8_SB(b, h) + boff + n * 2048 + k * 1024); } while (0)
#define PG8_MMA(ai, bj, At, Bt) do { __builtin_amdgcn_s_setprio(1); _Pragma("unroll") for (int m = 0; m < 4; ++m) _Pragma("unroll") for (int n = 0; n < 2; ++n) _Pragma("unroll") for (int k = 0; k < 2; ++k) \
        acc[ai][bj][m][n] = __builtin_amdgcn_mfma_f32_16x16x32_bf16(Bt[n][k], At[m][k], acc[ai][bj][m][n], 0, 0, 0); __builtin_amdgcn_s_setprio(0); } while (0)
#define PG8_WAIT_V(n) asm volatile("s_waitcnt vmcnt(" #n ")" ::: "memory")
#define PG8_WAIT_L(n) asm volatile("s_waitcnt lgkmcnt(" #n ")" ::: "memory")
#define PG8_BAR __builtin_amdgcn_s_barrier()
#define PG8_SCHED __builtin_amdgcn_sched_barrier(0)
    Unit cur, nxt; int ui = 0;
    if (!S.next(0, cur)) return;
    f32x4 acc[2][2][4][2];
#pragma unroll
    for (int a = 0; a < 2; ++a)
#pragma unroll
        for (int b = 0; b < 2; ++b)
#pragma unroll
            for (int m = 0; m < 4; ++m)
#pragma unroll
                for (int n = 0; n < 2; ++n) acc[a][b][m][n] = (f32x4){0.f, 0.f, 0.f, 0.f};
    bf16x8 At[4][2], B0[2][2], B1[2][2];
    const char* cA = (const char*)g.A + (size_t)cur.pm * tstep; const char* cB = (const char*)g.Bt + (size_t)cur.pn * tstep;
    S.a_ready(cur);
    if constexpr (SP2) {
        PG8_STAGE(PG8_SB(0, 0), cB, voffB); PG8_STAGE(PG8_SB(0, 1), cB + hstep, voffB); PG8_STAGE(PG8_SA(0, 0), cA, voffA); PG8_STAGE(PG8_SA(0, 1), cA + hstep, voffA);
        if (wr == 1) PG8_BAR;
        PG8_WAIT_V(2); PG8_BAR;
        PG8_STAGE(PG8_SB(1, 0), cB + kstep, voffB); PG8_STAGE(PG8_SA(1, 0), cA + kstep, voffA); PG8_STAGE(PG8_SB(1, 1), cB + hstep + kstep, voffB);
        PG8_WAIT_V(6); PG8_BAR;
    } else {
        PG8_STAGE(PG8_SB(0, 0), cB, voffB); PG8_STAGE(PG8_SA(0, 0), cA, voffA); PG8_STAGE(PG8_SB(0, 1), cB + hstep, voffB); PG8_STAGE(PG8_SA(0, 1), cA + hstep, voffA);
        if (wr == 1) PG8_BAR;
        PG8_WAIT_V(4); PG8_BAR;
        PG8_STAGE(PG8_SB(1, 0), cB + kstep, voffB); PG8_STAGE(PG8_SA(1, 0), cA + kstep, voffA); PG8_STAGE(PG8_SB(1, 1), cB + hstep + kstep, voffB);
        PG8_WAIT_V(6); PG8_BAR;
    }
    for (;;) {
        const bool has_next = S.next(ui + 1, nxt);
        const char* nA = has_next ? (const char*)g.A + (size_t)nxt.pm * tstep : cA; const char* nB = has_next ? (const char*)g.Bt + (size_t)nxt.pn * tstep : cB;
        for (int t = 0; t < nt; t += 2) {
            const bool last = (t == nt - 2);
            const char* a1 = cA + (size_t)(t + 1) * kstep;
            const char* a2 = last ? nA : cA + (size_t)(t + 2) * kstep; const char* b2 = last ? nB : cB + (size_t)(t + 2) * kstep;
            const char* a3 = a2 + kstep; const char* b3 = b2 + kstep;
            if (last && has_next) S.a_ready(nxt);
            if constexpr (SP2) {
            PG8_LDB(B0, 0, 0); PG8_LDB(B1, 0, 1); PG8_SCHED; PG8_LDA(At, 0, 0); PG8_STAGE(PG8_SA(1, 1), a1 + hstep, voffA);
            PG8_WAIT_V(8); PG8_WAIT_L(0); PG8_BAR; PG8_MMA(0, 0, At, B0); PG8_MMA(0, 1, At, B1); PG8_BAR; PG8_SCHED;
            PG8_LDA(At, 0, 1); PG8_STAGE(PG8_SB(0, 0), b2, voffB); PG8_STAGE(PG8_SB(0, 1), b2 + hstep, voffB); PG8_STAGE(PG8_SA(0, 0), a2, voffA);
            PG8_WAIT_V(8); PG8_WAIT_L(0); PG8_BAR; PG8_MMA(1, 0, At, B0); PG8_MMA(1, 1, At, B1); PG8_BAR; PG8_SCHED;
            PG8_LDB(B0, 1, 0); PG8_LDB(B1, 1, 1); PG8_SCHED; PG8_LDA(At, 1, 0); PG8_STAGE(PG8_SA(0, 1), a2 + hstep, voffA);
            PG8_WAIT_V(8); PG8_WAIT_L(0); PG8_BAR; PG8_MMA(0, 0, At, B0); PG8_MMA(0, 1, At, B1); PG8_BAR; PG8_SCHED;
            PG8_LDA(At, 1, 1); PG8_STAGE(PG8_SB(1, 0), b3, voffB); PG8_STAGE(PG8_SB(1, 1), b3 + hstep, voffB); PG8_STAGE(PG8_SA(1, 0), a3, voffA);
            PG8_WAIT_V(8); PG8_WAIT_L(0); PG8_BAR; PG8_MMA(1, 0, At, B0); PG8_MMA(1, 1, At, B1); PG8_BAR; PG8_SCHED;
            } else {
            PG8_LDB(B0, 0, 0); PG8_SCHED; PG8_LDA(At, 0, 0); PG8_STAGE(PG8_SA(1, 1), a1 + hstep, voffA);
            PG8_WAIT_L(8); PG8_BAR; PG8_WAIT_L(0); PG8_MMA(0, 0, At, B0); PG8_BAR; PG8_SCHED;
            PG8_LDB(B1, 0, 1); PG8_STAGE(PG8_SB(0, 0), b2, voffB);
            PG8_BAR; PG8_WAIT_L(0); PG8_MMA(0, 1, At, B1); PG8_BAR;
            PG8_LDA(At, 0, 1); PG8_STAGE(PG8_SA(0, 0), a2, voffA);
            PG8_BAR; PG8_WAIT_L(0); PG8_MMA(1, 0, At, B0); PG8_BAR; PG8_SCHED;
            PG8_STAGE(PG8_SB(0, 1), b2 + hstep, voffB);
            PG8_WAIT_V(6); PG8_BAR; PG8_MMA(1, 1, At, B1); PG8_BAR;
            PG8_LDB(B0, 1, 0); PG8_SCHED; PG8_LDA(At, 1, 0); PG8_STAGE(PG8_SA(0, 1), a2 + hstep, voffA);
            PG8_WAIT_L(8); PG8_BAR; PG8_WAIT_L(0); PG8_MMA(0, 0, At, B0); PG8_BAR; PG8_SCHED;
            PG8_LDB(B1, 1, 1); PG8_STAGE(PG8_SB(1, 0), b3, voffB);
            PG8_BAR; PG8_WAIT_L(0); PG8_MMA(0, 1, At, B1); PG8_BAR;
            PG8_LDA(At, 1, 1); PG8_STAGE(PG8_SA(1, 0), a3, voffA);
            PG8_BAR; PG8_WAIT_L(0); PG8_MMA(1, 0, At, B0); PG8_BAR; PG8_SCHED;
            PG8_STAGE(PG8_SB(1, 1), b3 + hstep, voffB);
            PG8_WAIT_V(6); PG8_BAR; PG8_MMA(1, 1, At, B1); PG8_BAR;
            }
        }
        if constexpr (ALIGN_EPI) { if (wr == 0) PG8_BAR; }
        if constexpr (!Epi::AFTER_DRAIN) { E(acc, cur, wr, wc, fr, fq); S.done(cur); }
        if (!has_next) break;
#pragma unroll
        for (int a = 0; a < 2; ++a)
#pragma unroll
            for (int b = 0; b < 2; ++b)
#pragma unroll
                for (int m = 0; m < 4; ++m)
#pragma unroll
                    for (int n = 0; n < 2; ++n) acc[a][b][m][n] = (f32x4){0.f, 0.f, 0.f, 0.f};
        cur = nxt; cA = nA; cB = nB; ++ui;
        if constexpr (ALIGN_EPI) { if (wr == 1) PG8_BAR; }
    }
    PG8_WAIT_V(0);
    if constexpr (!ALIGN_EPI) { if (wr == 0) PG8_BAR; }
    PG8_BAR;
    if constexpr (Epi::AFTER_DRAIN) { E.fused(acc, cur, wr, wc, fr, fq, lds, wid, lane); S.done(cur); }
#undef PG8_SA
#undef PG8_SB
#undef PG8_STAGE
#undef PG8_LDA
#undef PG8_LDB
#undef PG8_MMA
#undef PG8_WAIT_V
#undef PG8_WAIT_L
#undef PG8_BAR
#undef PG8_SCHED
}
}

#define LAS __attribute__((address_space(3)))
typedef unsigned short u16;
typedef short bf16x8 __attribute__((ext_vector_type(8)));
typedef short s16x4 __attribute__((ext_vector_type(4)));
typedef float f32x4 __attribute__((ext_vector_type(4)));
typedef float f32x2 __attribute__((ext_vector_type(2)));
typedef unsigned u32x4 __attribute__((ext_vector_type(4)));
typedef unsigned u32x2 __attribute__((ext_vector_type(2)));

constexpr int TT = 16384, DM = 1024, SEQ = 2048, NIN = 11264;
constexpr int ZBP = 4608;
constexpr size_t MiB = 1u << 20;
constexpr size_t WS_WT = 0;
constexpr size_t WS_WA = 22 * MiB, WS_WB = 24 * MiB, WS_WO = 25 * MiB;
constexpr size_t WS_COS = 27 * MiB, WS_SIN = 29 * MiB;
constexpr size_t WS_BAR = 31 * MiB;
constexpr size_t WS_H = 32 * MiB;
constexpr size_t WS_Z = 64 * MiB;
constexpr size_t Z_QA = WS_Z, Z_G = WS_Z + 32 * MiB, Z_VA = WS_Z + 64 * MiB, Z_HG = WS_Z + 96 * MiB, Z_GATES = WS_Z + 128 * MiB;
constexpr size_t Z_MERGED = WS_Z + 64 * MiB;
constexpr size_t WS_END = 256 * MiB;
constexpr size_t DO_OG = 0, DO_AG = 48 * MiB, DO_TMPB = 16 * MiB;
constexpr int LDS_BYTES = 163840;
constexpr float NORM_EPS = 1e-6f;

__device__ __forceinline__ unsigned pk_bf16(float lo, float hi) { typedef __bf16 b2 __attribute__((ext_vector_type(2))); f32x2 v = {lo, hi}; b2 b = __builtin_convertvector(v, b2); return __builtin_bit_cast(unsigned, b); }
__device__ __forceinline__ unsigned pk_f16(float lo, float hi) { typedef _Float16 h2 __attribute__((ext_vector_type(2))); h2 h = {(_Float16)lo, (_Float16)hi}; return __builtin_bit_cast(unsigned, h); }
__device__ __forceinline__ float bflo(unsigned u) { return __uint_as_float(u << 16); }
__device__ __forceinline__ float bfhi(unsigned u) { return __uint_as_float(u & 0xffff0000u); }
__device__ __forceinline__ float f16lo(unsigned u) { return (float)__builtin_bit_cast(_Float16, (unsigned short)(u & 0xffffu)); }
__device__ __forceinline__ float f16hi(unsigned u) { return (float)__builtin_bit_cast(_Float16, (unsigned short)(u >> 16)); }
__device__ __forceinline__ float sigm(float x) { return __builtin_amdgcn_rcpf(1.0f + __expf(-x)); }
__device__ __forceinline__ s16x4 ds_tr(const LAS u16* p) { typedef short v4 __attribute__((ext_vector_type(4))); return __builtin_bit_cast(s16x4, __builtin_amdgcn_ds_read_tr16_b64_v4i16((LAS v4*)p)); }
__device__ __forceinline__ bf16x8 cat8(s16x4 lo, s16x4 hi) { return (bf16x8){lo[0], lo[1], lo[2], lo[3], hi[0], hi[1], hi[2], hi[3]}; }
__device__ __forceinline__ f32x4 mfma16(bf16x8 a, bf16x8 b, f32x4 c) { return __builtin_amdgcn_mfma_f32_16x16x32_bf16(a, b, c, 0, 0, 0); }
__device__ __forceinline__ void store16_wt(void* p, u32x4 v) { asm volatile("global_store_dwordx4 %0, %1, off sc1\n\ts_nop 1" :: "v"(p), "v"(v) : "memory"); }
template <bool WT> __device__ __forceinline__ void store16(void* p, u32x4 v) { if (WT) store16_wt(p, v); else *(u32x4*)p = v; }
__device__ __forceinline__ float wave_sum(float v) {
#pragma unroll
    for (int o = 1; o < 64; o <<= 1) v += __shfl_xor(v, o);
    return v;
}

using pg8::Unit;
template <int ACT  > __device__ __forceinline__ float act1(float v) { if (ACT == 1) return v * sigm(v); if (ACT == 2) return sigm(v); return v; }
template <int ACT, bool WT = false> __device__ __forceinline__ void epi_store16(const f32x4 (&acc)[2][2][4][2], u16* base, int pitch, int row0, int col0) {
#pragma unroll
    for (int ai = 0; ai < 2; ++ai)
#pragma unroll
        for (int m = 0; m < 4; ++m) { u16* rowp = base + (size_t)(row0 + ai * 128 + m * 16) * pitch + col0;
#pragma unroll
            for (int bj = 0; bj < 2; ++bj) { const f32x4 v0 = acc[ai][bj][m][0], v1 = acc[ai][bj][m][1]; u32x4 w;
                w.x = pk_bf16(act1<ACT>(v0[0]), act1<ACT>(v0[1])); w.y = pk_bf16(act1<ACT>(v0[2]), act1<ACT>(v0[3]));
                w.z = pk_bf16(act1<ACT>(v1[0]), act1<ACT>(v1[1])); w.w = pk_bf16(act1<ACT>(v1[2]), act1<ACT>(v1[3]));
                store16<WT>(rowp + bj * 128, w); } }
}
template <bool WT> struct EpiZT {
    static constexpr bool PERM = true, AFTER_DRAIN = false;
    int mode;
    unsigned char* ws; unsigned char* dout; const float* lbl;
    __device__ __forceinline__ void operator()(const f32x4 (&acc)[2][2][4][2], const Unit& u, int wr, int wc, int fr, int fq) const {
        const int pn = u.pn, row0 = u.pm * 256 + wr * 64 + fr, lc = wc * 32 + 8 * fq;
        if (mode == 2) { epi_store16<2>(acc, (u16*)(ws + Z_GATES), 2048, row0, pn * 256 + lc); return; }
        if (mode == 0) {
            u16* ZB = (u16*)(ws + WS_Z);
            if (pn < 12) {
                const float sc = (pn < 6) ? 0.125f * 1.4426950408889634f : 1.0f;
                const float* cosT = (const float*)(ws + WS_COS); const float* sinT = (const float*)(ws + WS_SIN);
                const int jb = 16 * (wc & 1) + 4 * fq;
#pragma unroll
                for (int ai = 0; ai < 2; ++ai) { f32x4 cc[4], ss[4];
#pragma unroll
                    for (int m = 0; m < 4; ++m) { const int row = row0 + ai * 128 + m * 16; cc[m] = *(const f32x4*)(cosT + (size_t)row * 32 + jb); ss[m] = *(const f32x4*)(sinT + (size_t)row * 32 + jb); }
#pragma unroll
                    for (int m = 0; m < 4; ++m) { const int row = row0 + ai * 128 + m * 16; const f32x4 c = cc[m], s = ss[m];
                        u16* rowp = ZB + ((size_t)(pn * 4 + (wc >> 1)) * TT + row) * 64 + (lc & 63);
#pragma unroll
                        for (int bj = 0; bj < 2; ++bj) { const f32x4 v0 = acc[ai][bj][m][0], v1 = acc[ai][bj][m][1]; u32x4 w;
                            w.x = pk_bf16((v0[0] * c[0] - v0[1] * s[0]) * sc, (v0[1] * c[0] + v0[0] * s[0]) * sc);
                            w.y = pk_bf16((v0[2] * c[1] - v0[3] * s[1]) * sc, (v0[3] * c[1] + v0[2] * s[1]) * sc);
                            w.z = pk_bf16((v1[0] * c[2] - v1[1] * s[2]) * sc, (v1[1] * c[2] + v1[0] * s[2]) * sc);
                            w.w = pk_bf16((v1[2] * c[3] - v1[3] * s[3]) * sc, (v1[3] * c[3] + v1[2] * s[3]) * sc);
                            *(u32x4*)(rowp + (size_t)bj * 2 * TT * 64) = w; } } }
            } else if (pn < 18) {
#pragma unroll
                for (int ai = 0; ai < 2; ++ai)
#pragma unroll
                    for (int m = 0; m < 4; ++m) { u16* rowp = ZB + ((size_t)(pn * 4 + (wc >> 1)) * TT + (row0 + ai * 128 + m * 16)) * 64 + (lc & 63);
#pragma unroll
                        for (int bj = 0; bj < 2; ++bj) { const f32x4 v0 = acc[ai][bj][m][0], v1 = acc[ai][bj][m][1]; u32x4 w;
                            w.x = pk_bf16(v0[0], v0[1]); w.y = pk_bf16(v0[2], v0[3]); w.z = pk_bf16(v1[0], v1[1]); w.w = pk_bf16(v1[2], v1[3]);
                            *(u32x4*)(rowp + (size_t)bj * 2 * TT * 64) = w; } }
            }
            else epi_store16<1>(acc, (u16*)(dout + DO_AG), 512, row0, (pn - 18) * 256 + lc);
        } else {
            if (pn < 4) epi_store16<1, WT>(acc, (u16*)(ws + Z_QA), 1024, row0, pn * 256 + lc);
            else if (pn < 8) {
                const int cb = (pn - 4) * 256 + lc; float lb[2][8];
#pragma unroll
                for (int bj = 0; bj < 2; ++bj)
#pragma unroll
                    for (int e = 0; e < 8; ++e) { const int idx = cb + bj * 128 + e; lb[bj][e] = 1.0f / (1.0f + __expf(lbl[1024 + idx] - lbl[idx])); }
                u16* G = (u16*)(ws + Z_G);
#pragma unroll
                for (int ai = 0; ai < 2; ++ai)
#pragma unroll
                    for (int m = 0; m < 4; ++m) { u16* rowp = G + (size_t)(row0 + ai * 128 + m * 16) * 1024 + cb;
#pragma unroll
                        for (int bj = 0; bj < 2; ++bj) { const f32x4 v0 = acc[ai][bj][m][0], v1 = acc[ai][bj][m][1]; float g[8];
#pragma unroll
                            for (int e = 0; e < 8; ++e) { const float v = e < 4 ? v0[e & 3] : v1[e & 3]; g[e] = lb[bj][e] + (1.0f - lb[bj][e]) * sigm(v); }
                            u32x4 w; w.x = pk_f16(g[0], g[1]); w.y = pk_f16(g[2], g[3]); w.z = pk_f16(g[4], g[5]); w.w = pk_f16(g[6], g[7]);
                            store16<WT>(rowp + bj * 128, w); } }
            } else if (pn < 12) epi_store16<0, WT>(acc, (u16*)(ws + Z_VA), 1024, row0, (pn - 8) * 256 + lc);
            else if (pn < 16) epi_store16<1, WT>(acc, (u16*)(ws + Z_HG), 1024, row0, (pn - 12) * 256 + lc);
            else epi_store16<2>(acc, (u16*)(ws + Z_GATES), 2048, row0, (pn - 16) * 256 + lc);
        }
    }
};
typedef EpiZT<false> EpiZ;
struct EpiGateB {
    static constexpr bool PERM = true, AFTER_DRAIN = false;
    const u16* gates; u16* tmpb;
    __device__ __forceinline__ void operator()(const f32x4 (&acc)[2][2][4][2], const Unit& u, int wr, int wc, int fr, int fq) const {
        const int row0 = u.pm * 256 + wr * 64 + fr, col0 = u.pn * 256 + wc * 32 + 8 * fq;
#pragma unroll
        for (int ai = 0; ai < 2; ++ai) { u32x4 gg[4][2];
#pragma unroll
            for (int m = 0; m < 4; ++m)
#pragma unroll
                for (int bj = 0; bj < 2; ++bj) gg[m][bj] = __builtin_nontemporal_load((const u32x4*)(gates + (size_t)(row0 + ai * 128 + m * 16) * 2048 + 1024 + col0 + bj * 128));
#pragma unroll
            for (int m = 0; m < 4; ++m) { const size_t row = row0 + ai * 128 + m * 16;
#pragma unroll
                for (int bj = 0; bj < 2; ++bj) { const int col = col0 + bj * 128; const u32x4 g = gg[m][bj];
                    const f32x4 v0 = acc[ai][bj][m][0], v1 = acc[ai][bj][m][1]; u32x4 w;
                    w.x = pk_bf16(v0[0] * bflo(g.x), v0[1] * bfhi(g.x)); w.y = pk_bf16(v0[2] * bflo(g.y), v0[3] * bfhi(g.y));
                    w.z = pk_bf16(v1[0] * bflo(g.z), v1[1] * bfhi(g.z)); w.w = pk_bf16(v1[2] * bflo(g.w), v1[3] * bfhi(g.w));
                    *(u32x4*)(tmpb + row * 1024 + col) = w; } } }
    }
};
struct EpiGateA {
    static constexpr bool PERM = true, AFTER_DRAIN = false;
    const u16* gates; const u16* tmpb; u16* merged;
    __device__ __forceinline__ void operator()(const f32x4 (&acc)[2][2][4][2], const Unit& u, int wr, int wc, int fr, int fq) const {
        const int row0 = u.pm * 256 + wr * 64 + fr, col0 = u.pn * 256 + wc * 32 + 8 * fq;
#pragma unroll
        for (int ai = 0; ai < 2; ++ai) { u32x4 gg[4][2], tb[4][2];
#pragma unroll
            for (int m = 0; m < 4; ++m)
#pragma unroll
                for (int bj = 0; bj < 2; ++bj) { const size_t row = row0 + ai * 128 + m * 16; gg[m][bj] = __builtin_nontemporal_load((const u32x4*)(gates + row * 2048 + col0 + bj * 128)); tb[m][bj] = __builtin_nontemporal_load((const u32x4*)(tmpb + row * 1024 + col0 + bj * 128)); }
#pragma unroll
            for (int m = 0; m < 4; ++m) { const size_t row = row0 + ai * 128 + m * 16;
#pragma unroll
                for (int bj = 0; bj < 2; ++bj) { const int col = col0 + bj * 128; const u32x4 g = gg[m][bj], t = tb[m][bj];
                    const f32x4 v0 = acc[ai][bj][m][0], v1 = acc[ai][bj][m][1]; u32x4 w;
                    w.x = pk_bf16(bflo(t.x) + v0[0] * bflo(g.x), bfhi(t.x) + v0[1] * bfhi(g.x)); w.y = pk_bf16(bflo(t.y) + v0[2] * bflo(g.y), bfhi(t.y) + v0[3] * bfhi(g.y));
                    w.z = pk_bf16(bflo(t.z) + v1[0] * bflo(g.z), bfhi(t.z) + v1[1] * bfhi(g.z)); w.w = pk_bf16(bflo(t.w) + v1[2] * bflo(g.w), bfhi(t.w) + v1[3] * bfhi(g.w));
                    *(u32x4*)(merged + row * 1024 + col) = w; } } }
    }
};
struct ListOrder { int pm0; unsigned list;
    __device__ __forceinline__ bool next(int i, Unit& u) const { const unsigned c = (i < 4) ? ((list >> (8 * i)) & 0xffu) : 0xffu; if (c == 0xffu) return false; u.pm = pm0 + (int)(c & 7u); u.pn = (int)(c >> 3); return true; }
    __device__ __forceinline__ void a_ready(const Unit&) const {} __device__ __forceinline__ void done(const Unit&) const {} };
struct DefOrder { pg8::StaticOrder base;
    __device__ __forceinline__ bool next(int i, Unit& u) const { if (!base.next(i, u)) return false; u.pm = (u.pm / 6) * 8 + (u.pm % 6); return true; }
    __device__ __forceinline__ void a_ready(const Unit&) const {} __device__ __forceinline__ void done(const Unit&) const {} };
__device__ __forceinline__ unsigned lo_code(int idx, int base) { return (unsigned)(((base + (idx >> 3)) << 3) | (idx & 7)); }
struct EpiOutNorm {
    static constexpr bool PERM = true, AFTER_DRAIN = true;
    const float* x; float* out; const float* fnw; float* xbuf; unsigned* cnt;
    __device__ __forceinline__ void operator()(const f32x4 (&)[2][2][4][2], const Unit&, int, int, int, int) const {}
    __device__ __forceinline__ void fused(f32x4 (&acc)[2][2][4][2], const Unit& u, int wr, int wc, int fr, int fq, PG8_LAS unsigned char* lds, int wid, int lane) const {
        const int row0 = u.pm * 256 + wr * 64 + fr, col0 = u.pn * 256 + wc * 32 + 8 * fq;
        LAS float* PS = (LAS float*)lds;
        LAS float* RS = (LAS float*)(lds + 4096);
#pragma unroll
        for (int ai = 0; ai < 2; ++ai)
#pragma unroll
            for (int mh = 0; mh < 2; ++mh) { f32x4 xv[2][2][2];
#pragma unroll
                for (int mm = 0; mm < 2; ++mm)
#pragma unroll
                    for (int bj = 0; bj < 2; ++bj) { const size_t o = (size_t)(row0 + ai * 128 + (2 * mh + mm) * 16) * 1024 + col0 + bj * 128; xv[mm][bj][0] = __builtin_nontemporal_load((const f32x4*)(x + o)); xv[mm][bj][1] = __builtin_nontemporal_load((const f32x4*)(x + o + 4)); }
#pragma unroll
                for (int mm = 0; mm < 2; ++mm) { const int m = 2 * mh + mm; float sq = 0.f;
#pragma unroll
                    for (int bj = 0; bj < 2; ++bj)
#pragma unroll
                        for (int n = 0; n < 2; ++n) { const f32x4 v = acc[ai][bj][m][n] + xv[mm][bj][n]; acc[ai][bj][m][n] = v; sq += (v[0] * v[0] + v[1] * v[1]) + (v[2] * v[2] + v[3] * v[3]); }
                    sq += __shfl_xor(sq, 16); sq += __shfl_xor(sq, 32);
                    if (fq == 0) PS[(ai * 128 + wr * 64 + m * 16 + fr) * 4 + wc] = sq; } }
        asm volatile("s_waitcnt lgkmcnt(0)" ::: "memory"); __builtin_amdgcn_s_barrier(); asm volatile("" ::: "memory");
        const int tid = wid * 64 + lane;
        if (tid < 256) { const f32x4 p = *(const LAS f32x4*)(PS + tid * 4);
            __hip_atomic_store(xbuf + (size_t)(u.pm * 256 + tid) * 4 + u.pn, (p[0] + p[1]) + (p[2] + p[3]), __ATOMIC_RELAXED, __HIP_MEMORY_SCOPE_AGENT); }
        asm volatile("s_waitcnt vmcnt(0)" ::: "memory"); __builtin_amdgcn_s_barrier(); asm volatile("" ::: "memory");
        if (tid == 0) {
            __hip_atomic_fetch_add(cnt + 64 * u.pm, 1u, __ATOMIC_RELAXED, __HIP_MEMORY_SCOPE_AGENT);
            unsigned sp = 0u; while (__hip_atomic_load(cnt + 64 * u.pm, __ATOMIC_RELAXED, __HIP_MEMORY_SCOPE_AGENT) < 4u) { __builtin_amdgcn_s_sleep(2); if (++sp > (1u << 22)) break; }
            __builtin_amdgcn_fence(__ATOMIC_ACQUIRE, "agent"); asm volatile("s_waitcnt vmcnt(0)" ::: "memory"); }
        __builtin_amdgcn_s_barrier(); asm volatile("" ::: "memory");
        if (tid < 256) { const float* sl = xbuf + (size_t)(u.pm * 256 + tid) * 4; float t = 0.f;
#pragma unroll
            for (int k = 0; k < 4; ++k) t += __hip_atomic_load(sl + k, __ATOMIC_RELAXED, __HIP_MEMORY_SCOPE_AGENT);
            RS[tid] = rsqrtf(t * (1.0f / 1024.0f) + NORM_EPS); }
        asm volatile("s_waitcnt vmcnt(0) lgkmcnt(0)" ::: "memory"); __builtin_amdgcn_s_barrier(); asm volatile("" ::: "memory");
        f32x4 wv[2][2];
#pragma unroll
        for (int bj = 0; bj < 2; ++bj) { wv[bj][0] = *(const f32x4*)(fnw + col0 + bj * 128); wv[bj][1] = *(const f32x4*)(fnw + col0 + bj * 128 + 4); }
#pragma unroll
        for (int ai = 0; ai < 2; ++ai)
#pragma unroll
            for (int m = 0; m < 4; ++m) { const int rl = ai * 128 + wr * 64 + m * 16 + fr; const float rs = RS[rl]; const size_t o = (size_t)(u.pm * 256 + rl) * 1024 + col0;
#pragma unroll
                for (int bj = 0; bj < 2; ++bj) { *(f32x4*)(out + o + bj * 128) = acc[ai][bj][m][0] * rs * wv[bj][0]; *(f32x4*)(out + o + bj * 128 + 4) = acc[ai][bj][m][1] * rs * wv[bj][1]; } }
    }
};

__device__ __forceinline__ int wt_row_of_col(int n) {
    if (n < 4096) return n;
    if (n >= 9216) return 4096 + (n - 9216);
    int a = n - 4096;
    if (a < 3072) { const int e = a & 63; a = (a - e) + (e < 32 ? 2 * e : 2 * (e - 32) + 1); }
    return 6144 + a;
}
template <bool MAP> __device__ __forceinline__ void p0_transpose_item(const float* W, int K, int N, u16* WT, LAS float* scr, int item, int lane) {
    const int nblk = N / 32, kb = item / nblk, nb = item % nblk, k0 = 64 * kb, n0 = 32 * nb;
    float tv[32];
#pragma unroll
    for (int i = 0; i < 32; ++i) tv[i] = W[(size_t)(k0 + 2 * i + (lane >> 5)) * N + n0 + (lane & 31)];
#pragma unroll
    for (int i = 0; i < 32; ++i) scr[(2 * i + (lane >> 5)) * 33 + (lane & 31)] = tv[i];
    asm volatile("s_waitcnt lgkmcnt(0)" ::: "memory");
    const int c = lane & 7;
#pragma unroll
    for (int j = 0; j < 4; ++j) { const int n = (lane >> 3) + 8 * j; const LAS float* s = scr + (8 * c) * 33 + n;
        u32x4 o; o.x = pk_bf16(s[0 * 33], s[1 * 33]); o.y = pk_bf16(s[2 * 33], s[3 * 33]); o.z = pk_bf16(s[4 * 33], s[5 * 33]); o.w = pk_bf16(s[6 * 33], s[7 * 33]);
        const int r = MAP ? wt_row_of_col(n0 + n) : (n0 + n);
        *(u32x4*)(WT + (size_t)r * K + k0 + 8 * c) = o; }
    asm volatile("s_waitcnt lgkmcnt(0)" ::: "memory");
}
struct Ptrs { const float* x; const int* pos; const float* norm_w; const float* w_in; const float* lbl; const float* hnw; const float* wa; const float* wb; const float* wo; const float* fnw; float* out; unsigned char* ws; };

__device__ __forceinline__ void p0_prologue(const Ptrs& P, LAS unsigned char* lds, int vcu, int G) {
    const int tid = threadIdx.x, lane = tid & 63, wave = __builtin_amdgcn_readfirstlane(tid >> 6);
    LAS float* scr = (LAS float*)(lds + wave * 16384);
    const int gw = vcu * 8 + wave, NGW = G * 8;
    constexpr int I_IN = 16 * (NIN / 32), I_A = 16 * 32, I_B = 8 * 32, I_O = 16 * 32, NITEMS = I_IN + I_A + I_B + I_O;
    for (int it = gw; it < NITEMS; it += NGW) {
        int r = it;
        if (r < I_IN) { p0_transpose_item<true>(P.w_in, 1024, NIN, (u16*)(P.ws + WS_WT), scr, r, lane); continue; } r -= I_IN;
        if (r < I_A) { p0_transpose_item<false>(P.wa, 1024, 1024, (u16*)(P.ws + WS_WA), scr, r, lane); continue; } r -= I_A;
        if (r < I_B) { p0_transpose_item<false>(P.wb, 512, 1024, (u16*)(P.ws + WS_WB), scr, r, lane); continue; } r -= I_B;
        p0_transpose_item<false>(P.wo, 1024, 1024, (u16*)(P.ws + WS_WO), scr, r, lane);
    }
    u16* H = (u16*)(P.ws + WS_H);
    for (int m = gw; m < TT; m += 2 * NGW) {
        const int m2 = (m + NGW < TT) ? m + NGW : m;
        const f32x4* xr = (const f32x4*)(P.x + (size_t)m * DM) + lane; const f32x4* xr2 = (const f32x4*)(P.x + (size_t)m2 * DM) + lane; f32x4 v[4], v2[4]; float s = 0.f, s2 = 0.f;
#pragma unroll
        for (int j = 0; j < 4; ++j) { v[j] = xr[64 * j]; v2[j] = xr2[64 * j]; }
#pragma unroll
        for (int j = 0; j < 4; ++j) { s += (v[j].x * v[j].x + v[j].y * v[j].y) + (v[j].z * v[j].z + v[j].w * v[j].w); s2 += (v2[j].x * v2[j].x + v2[j].y * v2[j].y) + (v2[j].z * v2[j].z + v2[j].w * v2[j].w); }
        const float rstd = rsqrtf(wave_sum(s) * (1.0f / DM) + NORM_EPS), rstd2 = rsqrtf(wave_sum(s2) * (1.0f / DM) + NORM_EPS);
        u32x2* o8 = (u32x2*)(H + (size_t)m * DM) + lane; u32x2* o82 = (u32x2*)(H + (size_t)m2 * DM) + lane;
#pragma unroll
        for (int j = 0; j < 4; ++j) { const f32x4 w4 = ((const f32x4*)P.norm_w)[lane + 64 * j];
            o8[64 * j] = (u32x2){pk_bf16(v[j].x * rstd * w4.x, v[j].y * rstd * w4.y), pk_bf16(v[j].z * rstd * w4.z, v[j].w * rstd * w4.w)};
            o82[64 * j] = (u32x2){pk_bf16(v2[j].x * rstd2 * w4.x, v2[j].y * rstd2 * w4.y), pk_bf16(v2[j].z * rstd2 * w4.z, v2[j].w * rstd2 * w4.w)}; }
    }
    float* cosT = (float*)(P.ws + WS_COS); float* sinT = (float*)(P.ws + WS_SIN);
    for (int e = (vcu * 512 + tid); e < TT * 32; e += G * 512) {
        const int row = e >> 5, j = e & 31;
        const float inv = exp2f(-(float)j * (13.287712379549449f / 32.0f));
        const float ang = (float)P.pos[row] * inv;
        const double rev = (double)ang * 0.15915494309189535; const float fr = (float)(rev - __builtin_rint(rev));
        cosT[e] = __builtin_amdgcn_cosf(fr); sinT[e] = __builtin_amdgcn_sinf(fr);
    }
}

#define LBAR() asm volatile("s_waitcnt lgkmcnt(0)\n\ts_barrier" ::: "memory")
__device__ __forceinline__ void attn_phase(LAS unsigned char* lds, const u16* ZB, u16* OG, float* LSE, int bid, int G) {
    const int tid = threadIdx.x, lane = tid & 63, w = __builtin_amdgcn_readfirstlane(tid >> 6), l15 = lane & 15, q4 = lane >> 4, sb = w >> 2, wq = w & 3;
    constexpr int KP = 72;
    LAS u16* KI = (LAS u16*)lds; LAS u16* VI = (LAS u16*)(lds + 384 * KP * 2);
    u32x4 kr[6], vr[6]; bf16x8 qn[2][2];
#define AT_DEC(un_) const int b_ = (un_) / 192, rem_ = (un_) % 192, g_ = rem_ >> 6, h_ = (rem_ >> 3) & 7, su_ = rem_ & 7; \
        const int d_ = (g_ == 0) ? 1 : (g_ == 1 ? 4 : 16); const size_t tb_ = (size_t)b_ * SEQ; \
        const int r0_ = (g_ == 0) ? 0 : (g_ == 1 ? (su_ >> 1) : 2 * su_), c0_ = (g_ == 0) ? 2 * su_ : (g_ == 1 ? 2 * (su_ & 1) : 0); \
        const int rq_ = (g_ == 2) ? r0_ + sb : r0_, cq_ = (g_ == 2) ? 0 : c0_ + sb;
#define AT_LOAD(un_) do { AT_DEC(un_) \
        _Pragma("unroll") for (int i = 0; i < 6; ++i) { const int id = tid + 512 * i, j = id >> 3, ch = id & 7; \
            const int mp = (g_ == 2) ? (j & 127) : 128 * (c0_ - 1) + j, rr = (g_ == 2) ? r0_ + (j >> 7) : r0_; \
            kr[i] = (u32x4){0u, 0u, 0u, 0u}; vr[i] = (u32x4){0u, 0u, 0u, 0u}; \
            if (mp >= 0 && (g_ != 2 || j < 256)) { const size_t tk_ = tb_ + (size_t)mp * d_ + rr; kr[i] = *(const u32x4*)(ZB + ((size_t)(24 + g_ * 8 + h_) * TT + tk_) * 64 + 8 * ch); vr[i] = *(const u32x4*)(ZB + ((size_t)(48 + g_ * 8 + h_) * TT + tk_) * 64 + 8 * ch); } } \
        _Pragma("unroll") for (int qt = 0; qt < 2; ++qt) { const size_t tq_ = tb_ + (size_t)(128 * cq_ + 32 * wq + 16 * qt + l15) * d_ + rq_; \
            _Pragma("unroll") for (int ds = 0; ds < 2; ++ds) qn[qt][ds] = *(const bf16x8*)(ZB + ((size_t)(g_ * 8 + h_) * TT + tq_) * 64 + 32 * ds + 8 * q4); } } while (0)
    const bool xl = (G == 256); const int ustep = xl ? 32 : G, ubase = xl ? (bid & 7) * 192 : 0, ulim = xl ? ubase + 192 : 1536;
    { const int u0 = ubase + (xl ? (bid >> 3) : bid); AT_LOAD((u0 < ulim ? u0 : ulim - 1)); }
    for (int un = ubase + (xl ? (bid >> 3) : bid); un < ulim; un += ustep) {
        AT_DEC(un)
        const int g = g_, h = h_; const bool prev_ok = (g_ != 2) && (cq_ > 0); const int wbase = (g_ == 2) ? 128 * sb - 128 : 128 * sb;
        size_t tq[2];
#pragma unroll
        for (int qt = 0; qt < 2; ++qt) tq[qt] = tb_ + (size_t)(128 * cq_ + 32 * wq + 16 * qt + l15) * d_ + rq_;
#pragma unroll
        for (int i = 0; i < 6; ++i) { const int id = tid + 512 * i, j = id >> 3, ch = id & 7; *(LAS u32x4*)(KI + j * KP + 8 * ch) = kr[i]; *(LAS u32x4*)(VI + j * KP + 8 * ch) = vr[i]; }
        bf16x8 qf[2][2];
#pragma unroll
        for (int qt = 0; qt < 2; ++qt) { qf[qt][0] = qn[qt][0]; qf[qt][1] = qn[qt][1]; }
        LBAR();
        { const int nx = (un + ustep < ulim) ? un + ustep : un; AT_LOAD(nx); }
        f32x4 st[5][2][2]; float mx[2] = {-INFINITY, -INFINITY};
#pragma unroll
        for (int p = 0; p < 5; ++p) { const int a = wq + p; const bool on = prev_ok || a >= 4;
#pragma unroll
            for (int t = 0; t < 2; ++t) {
                if (on) { const int j0 = 32 * a + 16 * t, k = 2 * p + t; f32x4 s0 = (f32x4){0.f, 0.f, 0.f, 0.f}, s1 = (f32x4){0.f, 0.f, 0.f, 0.f};
#pragma unroll
                    for (int ds = 0; ds < 2; ++ds) { const bf16x8 kf = *(const LAS bf16x8*)(KI + (wbase + j0 + l15) * KP + 32 * ds + 8 * q4); if (k <= 8) s0 = mfma16(kf, qf[0][ds], s0); if (k >= 1) s1 = mfma16(kf, qf[1][ds], s1); }
#pragma unroll
                    for (int i = 0; i < 4; ++i) { const int kk = 4 * q4 + i;
                        if (k == 0) s0[i] = (kk >= l15) ? s0[i] : -INFINITY; if (k == 8) s0[i] = (kk <= l15) ? s0[i] : -INFINITY; if (k == 9) s0[i] = -INFINITY;
                        if (k == 1) s1[i] = (kk >= l15) ? s1[i] : -INFINITY; if (k == 9) s1[i] = (kk <= l15) ? s1[i] : -INFINITY; if (k == 0) s1[i] = -INFINITY;
                        mx[0] = fmaxf(mx[0], s0[i]); mx[1] = fmaxf(mx[1], s1[i]); }
                    st[p][t][0] = s0; st[p][t][1] = s1;
                } else { st[p][t][0] = (f32x4){-INFINITY, -INFINITY, -INFINITY, -INFINITY}; st[p][t][1] = st[p][t][0]; } } }
        float l[2] = {0.f, 0.f}; bf16x8 pf[5][2];
#pragma unroll
        for (int qt = 0; qt < 2; ++qt) { mx[qt] = fmaxf(mx[qt], __shfl_xor(mx[qt], 16)); mx[qt] = fmaxf(mx[qt], __shfl_xor(mx[qt], 32)); }
#pragma unroll
        for (int p = 0; p < 5; ++p)
#pragma unroll
            for (int qt = 0; qt < 2; ++qt) { float e[8];
#pragma unroll
                for (int t = 0; t < 2; ++t)
#pragma unroll
                    for (int i = 0; i < 4; ++i) { e[4 * t + i] = __builtin_amdgcn_exp2f(st[p][t][qt][i] - mx[qt]); l[qt] += e[4 * t + i]; }
                u32x4 pw; pw.x = pk_bf16(e[0], e[1]); pw.y = pk_bf16(e[2], e[3]); pw.z = pk_bf16(e[4], e[5]); pw.w = pk_bf16(e[6], e[7]); pf[p][qt] = __builtin_bit_cast(bf16x8, pw); }
#pragma unroll
        for (int qt = 0; qt < 2; ++qt) { l[qt] += __shfl_xor(l[qt], 16); l[qt] += __shfl_xor(l[qt], 32); }
        f32x4 o[4][2];
#pragma unroll
        for (int dt = 0; dt < 4; ++dt) { o[dt][0] = (f32x4){0.f, 0.f, 0.f, 0.f}; o[dt][1] = (f32x4){0.f, 0.f, 0.f, 0.f}; }
#pragma unroll
        for (int p = 0; p < 5; ++p) { const int a = wq + p; const bool on = prev_ok || a >= 4;
            if (on) {
#pragma unroll
                for (int dt = 0; dt < 4; ++dt) { const LAS u16* vp = VI + (wbase + 32 * a + 4 * q4 + (l15 >> 2)) * KP + 16 * dt + 4 * (l15 & 3);
                    const s16x4 lo = ds_tr(vp), hi = ds_tr(vp + 16 * KP); const bf16x8 vf = cat8(lo, hi); o[dt][0] = mfma16(vf, pf[p][0], o[dt][0]); o[dt][1] = mfma16(vf, pf[p][1], o[dt][1]); } } }
        LAS u16* stg = (LAS u16*)(lds + 2 * 384 * KP * 2 + w * 4608);
#pragma unroll
        for (int qt = 0; qt < 2; ++qt) { const float il = 1.0f / l[qt];
#pragma unroll
            for (int dt = 0; dt < 4; ++dt) *(LAS u32x2*)(stg + (16 * qt + l15) * 72 + 16 * dt + 4 * q4) = (u32x2){pk_bf16(o[dt][qt][0] * il, o[dt][qt][1] * il), pk_bf16(o[dt][qt][2] * il, o[dt][qt][3] * il)};
            if (q4 == 0) LSE[(size_t)g * TT * 8 + tq[qt] * 8 + h] = mx[qt] + __log2f(l[qt]); }
        asm volatile("s_waitcnt lgkmcnt(0)" ::: "memory");
#pragma unroll
        for (int i = 0; i < 4; ++i) { const int row = i * 8 + (lane >> 3), ch = lane & 7; const u32x4 v = *(const LAS u32x4*)(stg + row * 72 + 8 * ch);
            const size_t tr = tb_ + (size_t)(128 * cq_ + 32 * wq + row) * d_ + rq_;
            *(u32x4*)(OG + (size_t)g * TT * 512 + tr * 512 + h * 64 + 8 * ch) = v; }
        LBAR();
    }
#undef AT_DEC
#undef AT_LOAD
}
__device__ __forceinline__ void merge_phase(u16* OG, const float* LSE, const u16* AG, int bid, int nb) {
    for (int idx = bid * 512 + threadIdx.x; idx < TT * 64; idx += nb * 512) {
        const int tok = idx >> 6, h = (idx >> 3) & 7, ch = idx & 7; const size_t off = (size_t)tok * 512 + h * 64 + 8 * ch;
        const float l0 = LSE[(size_t)tok * 8 + h], l1 = LSE[(size_t)TT * 8 + (size_t)tok * 8 + h], l2 = LSE[(size_t)2 * TT * 8 + (size_t)tok * 8 + h];
        const float m = fmaxf(l0, fmaxf(l1, l2)); float w0 = __builtin_amdgcn_exp2f(l0 - m), w1 = __builtin_amdgcn_exp2f(l1 - m), w2 = __builtin_amdgcn_exp2f(l2 - m);
        const float inv = 1.0f / (w0 + w1 + w2); w0 *= inv; w1 *= inv; w2 *= inv;
        const u32x4 a = *(const u32x4*)(OG + off), bq = *(const u32x4*)(OG + (size_t)TT * 512 + off), cq = *(const u32x4*)(OG + (size_t)2 * TT * 512 + off), gq = *(const u32x4*)(AG + off);
        u32x4 o;
#define MRG(F) o.F = pk_bf16((w0 * bflo(a.F) + w1 * bflo(bq.F) + w2 * bflo(cq.F)) * bflo(gq.F), (w0 * bfhi(a.F) + w1 * bfhi(bq.F) + w2 * bfhi(cq.F)) * bfhi(gq.F))
        MRG(x); MRG(y); MRG(z); MRG(w);
#undef MRG
        store16_wt(OG + off, o);
    }
}

template <int MODE = 0> __device__ __forceinline__ void hgrn_unit(LAS unsigned char* lds, int b, int h, const u16* QA, const u16* GG, const u16* VA, const u16* HG, const float* nw, u16* OA, unsigned* dcnt) {
    const int tid = threadIdx.x, lane = tid & 63, w = __builtin_amdgcn_readfirstlane(tid >> 6), l15 = lane & 15, q4 = lane >> 4;
    constexpr int P = 136, IMGB = 52224;
    LAS u16* SB = (LAS u16*)(lds + 104448); LAS float* TOT = (LAS float*)(lds + 139264); LAS float* DFB = (LAS float*)(lds + 143360); LAS float* SSQ = (LAS float*)(lds + 146432);
    f32x4 S[8];
#pragma unroll
    for (int i = 0; i < 8; ++i) S[i] = (f32x4){0.f, 0.f, 0.f, 0.f};
    const int kp = lane, seg = w, tt = (w < 4) ? (w >> 1) : 3 - ((w - 4) >> 1), vh = w & 1;
    const size_t tok0 = (size_t)b * SEQ;
    unsigned gq0[8], qq0[8], gq1[8], qq1[8]; u32x4 vv0[2], vv1[2]; u32x2 hg0[4], hg1[4];
    f32x4 O[4]; float sqp = 0.f;
#pragma unroll
    for (int j = 0; j < 4; ++j) O[j] = (f32x4){0.f, 0.f, 0.f, 0.f};
#define HG_LOAD(c, gq, qq, vv) do { const size_t t0_ = tok0 + 64 * (c); \
        _Pragma("unroll") for (int i = 0; i < 8; ++i) { const size_t o_ = (t0_ + 8 * seg + i) * 1024 + h * 128 + 2 * kp; gq[i] = *(const unsigned*)(GG + o_); qq[i] = *(const unsigned*)(QA + o_); } \
        _Pragma("unroll") for (int u_ = 0; u_ < 2; ++u_) { const int id_ = tid + 512 * u_; vv[u_] = *(const u32x4*)(VA + (t0_ + (id_ >> 4)) * 1024 + h * 128 + 8 * (id_ & 15)); } } while (0)
#define HG_LOADG(c, hgv) do { const size_t tq_ = tok0 + 64 * (c) + 16 * tt + l15; \
        _Pragma("unroll") for (int j = 0; j < 4; ++j) hgv[j] = *(const u32x2*)(HG + tq_ * 1024 + h * 128 + 16 * (4 * vh + j) + 4 * q4); } while (0)
#define HG_PREP1(gq) do { float r0_ = 1.f, r1_ = 1.f; \
        _Pragma("unroll") for (int i = 0; i < 8; ++i) { r0_ *= f16lo(gq[i]); r1_ *= f16hi(gq[i]); } \
        *(LAS f32x2*)(TOT + seg * 128 + 2 * kp) = (f32x2){__log2f(r0_), __log2f(r1_)}; } while (0)
#define HG_PREP2(buf, gq, qq, vv) do { LAS u16* QM_ = (LAS u16*)(lds + (buf) * IMGB); LAS u16* KM_ = (LAS u16*)(lds + (buf) * IMGB + 17408); LAS u16* VI_ = (LAS u16*)(lds + (buf) * IMGB + 34816); LAS float* DF_ = DFB + (buf) * 384; \
        float off0 = 0.f, off1 = 0.f, br0 = 0.f, br1 = 0.f, bl0 = 0.f, bl1 = 0.f; \
        _Pragma("unroll") for (int s2 = 0; s2 < 8; ++s2) { const f32x2 t_ = *(const LAS f32x2*)(TOT + s2 * 128 + 2 * kp); \
            if (s2 < seg) { off0 += t_.x; off1 += t_.y; } if (s2 < 4) { br0 += t_.x; br1 += t_.y; } bl0 += t_.x; bl1 += t_.y; } \
        off0 -= br0; off1 -= br1; \
        float E0 = __builtin_amdgcn_exp2f(fminf(off0, 115.f)), E1 = __builtin_amdgcn_exp2f(fminf(off1, 115.f)), I0 = __builtin_amdgcn_exp2f(fminf(-off0, 115.f)), I1 = __builtin_amdgcn_exp2f(fminf(-off1, 115.f)); \
        _Pragma("unroll") for (int i = 0; i < 8; ++i) { const int s_ = 8 * seg + i; const float f0_ = f16lo(gq[i]), f1_ = f16hi(gq[i]); \
            E0 *= f0_; E1 *= f1_; I0 *= __builtin_amdgcn_rcpf(f0_); I1 *= __builtin_amdgcn_rcpf(f1_); \
            *(LAS unsigned*)(QM_ + s_ * P + 2 * kp) = pk_bf16(bflo(qq[i]) * E0, bfhi(qq[i]) * E1); \
            *(LAS unsigned*)(KM_ + s_ * P + 2 * kp) = pk_bf16((1.0f - f0_) * I0, (1.0f - f1_) * I1); } \
        if (seg == 0) { *(LAS f32x2*)(DF_ + 2 * kp) = (f32x2){__builtin_amdgcn_exp2f(bl0), __builtin_amdgcn_exp2f(bl1)}; *(LAS f32x2*)(DF_ + 128 + 2 * kp) = (f32x2){__builtin_amdgcn_exp2f(bl0 - br0), __builtin_amdgcn_exp2f(bl1 - br1)}; *(LAS f32x2*)(DF_ + 256 + 2 * kp) = (f32x2){__builtin_amdgcn_exp2f(br0), __builtin_amdgcn_exp2f(br1)}; } \
        _Pragma("unroll") for (int u_ = 0; u_ < 2; ++u_) { const int id_ = tid + 512 * u_; *(LAS u32x4*)(VI_ + (id_ >> 4) * P + 8 * (id_ & 15)) = vv[u_]; } } while (0)
#define HG_STAGE(hgv) do { \
        _Pragma("unroll") for (int j = 0; j < 4; ++j) { const f32x4 n4 = nwv[j]; const int row_ = 16 * tt + l15, c16_ = 2 * (4 * vh + j) + (q4 >> 1); \
            *(LAS u32x2*)(STG + row_ * 256 + ((c16_ ^ l15) << 4) + 8 * (q4 & 1)) = (u32x2){pk_bf16(O[j][0] * n4[0] * bflo(hgv[j].x), O[j][1] * n4[1] * bfhi(hgv[j].x)), \
                                                                                         pk_bf16(O[j][2] * n4[2] * bflo(hgv[j].y), O[j][3] * n4[3] * bfhi(hgv[j].y))}; } } while (0)
#define HG_COPY(c) do { \
        _Pragma("unroll") for (int u_ = 0; u_ < 2; ++u_) { const int id_ = tid + 512 * u_, row_ = id_ >> 4, ch_ = id_ & 15; \
            const float sc_ = rsqrtf((SSQ[((row_ >> 4) * 2) * 16 + (row_ & 15)] + SSQ[((row_ >> 4) * 2 + 1) * 16 + (row_ & 15)]) * (1.0f / 128.0f) + NORM_EPS); \
            const u32x4 v_ = *(const LAS u32x4*)(STG + row_ * 256 + ((ch_ ^ (row_ & 15)) << 4)); u32x4 o_; \
            o_.x = pk_bf16(bflo(v_.x) * sc_, bfhi(v_.x) * sc_); o_.y = pk_bf16(bflo(v_.y) * sc_, bfhi(v_.y) * sc_); o_.z = pk_bf16(bflo(v_.z) * sc_, bfhi(v_.z) * sc_); o_.w = pk_bf16(bflo(v_.w) * sc_, bfhi(v_.w) * sc_); \
            if (MODE & 8) { dacc_ ^= o_.x ^ o_.w; } else *(u32x4*)(OA + (tok0 + 64 * (c) + row_) * 1024 + h * 128 + 8 * ch_) = o_; } } while (0)
    unsigned dacc_ = 0u;
    LAS unsigned char* STG = lds + 146944;
    f32x4 nwv[4];
#pragma unroll
    for (int j = 0; j < 4; ++j) nwv[j] = *(const f32x4*)(nw + 16 * (4 * vh + j) + 4 * q4);
    HG_LOAD(0, gq0, qq0, vv0); HG_LOADG(0, hg0); HG_LOADG(0, hg1); if (tid < 128) SSQ[tid] = 1.0f; HG_PREP1(gq0); LBAR(); HG_PREP2(0, gq0, qq0, vv0);
    for (int i = tid; i < 128 * P / 2; i += 512) ((LAS unsigned*)SB)[i] = 0u;
    HG_LOAD(1, gq1, qq1, vv1); HG_LOAD(2, gq0, qq0, vv0); LBAR(); HG_PREP1(gq1); LBAR();
#ifdef PROBE_ACC
    unsigned tacc_ = 0u, tlast_ = (unsigned)__builtin_amdgcn_s_memrealtime();
#define HG_T(k) do { if (blockIdx.x == 0 && tid == 448) { const unsigned n_ = (unsigned)__builtin_amdgcn_s_memrealtime(); if ((k) == PROBE_ACC) tacc_ += n_ - tlast_; tlast_ = n_; } } while (0)
#else
#define HG_T(k) do {} while (0)
#endif
#define HG_STEP(c, G2, Q2, V2, G1, HGU, HGL) do { HG_T(2); \
        const int cur = (c) & 1, nxt = cur ^ 1; \
        const LAS u16* QM = (const LAS u16*)(lds + cur * IMGB); const LAS u16* KM = (const LAS u16*)(lds + cur * IMGB + 17408); const LAS u16* VI = (const LAS u16*)(lds + cur * IMGB + 34816); const LAS float* DF = DFB + cur * 384; \
        if (!(MODE & 4)) HG_COPY(((c) > 0 ? (c) - 1 : 0)); \
        if (!(MODE & 2)) HG_PREP2(nxt, G2, Q2, V2); HG_LOADG(((c) + 1 < 32 ? (c) + 1 : 31), HGL); \
        HG_LOAD(((c) + 3 < 32 ? (c) + 3 : 31), G2, Q2, V2); HG_T(0); \
        if (!(MODE & 1)) { \
        bf16x8 qm[4]; \
        _Pragma("unroll") for (int ks = 0; ks < 4; ++ks) qm[ks] = *(const LAS bf16x8*)(QM + (16 * tt + l15) * P + 32 * ks + 8 * q4); \
        f32x4 Dm[4]; \
        _Pragma("unroll") for (int st = 0; st < 4; ++st) { Dm[st] = (f32x4){0.f, 0.f, 0.f, 0.f}; \
            _Pragma("unroll") for (int ks = 0; ks < 4; ++ks) { const bf16x8 kf = *(const LAS bf16x8*)(KM + (16 * st + l15) * P + 32 * ks + 8 * q4); Dm[st] = mfma16(kf, qm[ks], Dm[st]); } \
            _Pragma("unroll") for (int i = 0; i < 4; ++i) { const bool keep_ = (st < tt) || (st == tt && 4 * q4 + i <= l15); Dm[st][i] = keep_ ? Dm[st][i] : 0.f; } } \
        bf16x8 pf[2]; \
        _Pragma("unroll") for (int a = 0; a < 2; ++a) { u32x4 pw; pw.x = pk_bf16(Dm[2 * a][0], Dm[2 * a][1]); pw.y = pk_bf16(Dm[2 * a][2], Dm[2 * a][3]); pw.z = pk_bf16(Dm[2 * a + 1][0], Dm[2 * a + 1][1]); pw.w = pk_bf16(Dm[2 * a + 1][2], Dm[2 * a + 1][3]); pf[a] = __builtin_bit_cast(bf16x8, pw); } \
        _Pragma("unroll") for (int j = 0; j < 4; ++j) { const int vt = 4 * vh + j; f32x4 o = (f32x4){0.f, 0.f, 0.f, 0.f}; \
            _Pragma("unroll") for (int a = 0; a < 2; ++a) { const LAS u16* vp = VI + (32 * a + 4 * q4 + (l15 >> 2)) * P + 16 * vt + 4 * (l15 & 3); \
                const s16x4 lo = ds_tr(vp), hi = ds_tr(vp + 16 * P); o = mfma16(cat8(lo, hi), pf[a], o); } \
            _Pragma("unroll") for (int ks = 0; ks < 4; ++ks) { const bf16x8 sf = *(const LAS bf16x8*)(SB + (16 * vt + l15) * P + 32 * ks + 8 * q4); o = mfma16(sf, qm[ks], o); } \
            O[j] = o; } \
        { bf16x8 ka[2]; \
            _Pragma("unroll") for (int a = 0; a < 2; ++a) { const LAS u16* kpp = KM + (32 * a + 8 * q4 + (l15 >> 2)) * P + 16 * w + 4 * (l15 & 3); const s16x4 lo = ds_tr(kpp), hi = ds_tr(kpp + 4 * P); ka[a] = cat8(lo, hi); } \
            const f32x4 d1 = *(const LAS f32x4*)(DF + 16 * w + 4 * q4), d2 = *(const LAS f32x4*)(DF + 128 + 16 * w + 4 * q4); \
            _Pragma("unroll") for (int vt = 0; vt < 8; ++vt) { f32x4 U = (f32x4){0.f, 0.f, 0.f, 0.f}; \
                _Pragma("unroll") for (int a = 0; a < 2; ++a) { const LAS u16* vp = VI + (32 * a + 8 * q4 + (l15 >> 2)) * P + 16 * vt + 4 * (l15 & 3); const s16x4 lo = ds_tr(vp), hi = ds_tr(vp + 4 * P); U = mfma16(ka[a], cat8(lo, hi), U); } \
                S[vt] = d1 * S[vt] + d2 * U; } } \
        { float sq = 0.f; \
            _Pragma("unroll") for (int j = 0; j < 4; ++j) sq += (O[j][0] * O[j][0] + O[j][1] * O[j][1]) + (O[j][2] * O[j][2] + O[j][3] * O[j][3]); \
            sq += __shfl_xor(sq, 16); sq += __shfl_xor(sq, 32); sqp = sq; } } \
        HG_T(1); \
        LBAR(); HG_T(2); \
        { const f32x4 eb = *(const LAS f32x4*)(DFB + nxt * 384 + 256 + 16 * w + 4 * q4); \
            _Pragma("unroll") for (int vt = 0; vt < 8; ++vt) *(LAS u32x2*)(SB + (16 * vt + l15) * P + 16 * w + 4 * q4) = (u32x2){pk_bf16(S[vt][0] * eb[0], S[vt][1] * eb[1]), pk_bf16(S[vt][2] * eb[2], S[vt][3] * eb[3])}; } \
        if (q4 == 0) SSQ[(tt * 2 + vh) * 16 + l15] = sqp; \
        if (!(MODE & 4)) HG_STAGE(HGU); \
        if (!(MODE & 2)) HG_PREP1(G1); HG_T(3); \
        LBAR(); } while (0)
    for (int c = 0; c < 32; c += 2) {
        if (c == 20 && dcnt) {
            if (tid == 0) { unsigned sp = 0u;
                while (__hip_atomic_load(dcnt + 64 * (8 * b + 6), __ATOMIC_RELAXED, __HIP_MEMORY_SCOPE_AGENT) < 16u || __hip_atomic_load(dcnt + 64 * (8 * b + 7), __ATOMIC_RELAXED, __HIP_MEMORY_SCOPE_AGENT) < 16u) { __builtin_amdgcn_s_sleep(2); if (++sp > (1u << 22)) break; }
                __builtin_amdgcn_fence(__ATOMIC_ACQUIRE, "agent"); asm volatile("s_waitcnt vmcnt(0)" ::: "memory"); }
            LBAR(); }
        HG_STEP(c, gq1, qq1, vv1, gq0, hg0, hg1);
        HG_STEP(c + 1, gq0, qq0, vv0, gq1, hg1, hg0);
    }
    HG_COPY(31);
    if (MODE & 8) { if (dacc_ == 0x12345678u) OA[tid] = (u16)dacc_; }
#ifdef PROBE_ACC
    if (blockIdx.x == 0 && tid == 448) ((LAS unsigned long long*)(lds + 163344))[10] = (unsigned long long)tacc_;
#endif
#undef HG_STEP
#undef HG_LOAD
#undef HG_LOADG
#undef HG_PREP1
#undef HG_PREP2
#undef HG_STAGE
#undef HG_COPY
    LBAR();
}

#define XB_TMO      128
#define XB_XCNT(j)  (256  + 64 * (j))
#define XB_XSUB(j)  (1280 + 64 * (j))
#define XB_XGEN(j)  (2304 + 64 * (j))
#define XB_TOP      3328
#define XB_TOPGEN   3392
#define XCD_BAR_WORDS 3456
#define XB_SPIN_CAP (1u << 18)

__device__ __forceinline__ unsigned xb_ld(unsigned* p)              { return __hip_atomic_load(p, __ATOMIC_RELAXED, __HIP_MEMORY_SCOPE_AGENT); }
__device__ __forceinline__ unsigned xb_add(unsigned* p, unsigned v) { return __hip_atomic_fetch_add(p, v, __ATOMIC_RELAXED, __HIP_MEMORY_SCOPE_AGENT); }
__device__ __forceinline__ unsigned xb_xcc_id() { return (unsigned)__builtin_amdgcn_s_getreg((3 << 11) | 20) & 0xFu; }
#define XB_SPIN(cond, bar) do { unsigned _sp = 0; while (cond) { __builtin_amdgcn_s_sleep(1); \
    if ((++_sp & 255u) == 0u) { if (xb_ld(&(bar)[XB_TMO])) break; if (_sp > XB_SPIN_CAP) { atomicAdd(&(bar)[XB_TMO], 1u); break; } } } } while (0)

struct XcdBarrier {
    unsigned* bar; unsigned x;
    volatile LAS unsigned* st;
};

__device__ __forceinline__ XcdBarrier xcd_barrier_post(unsigned* bar, volatile LAS unsigned* st) {
    XcdBarrier b; b.bar = bar; b.x = xb_xcc_id(); b.st = st;
    if (threadIdx.x == 0) (void)xb_add(&bar[XB_XCNT(b.x)], 1u);
    return b;
}
__device__ __forceinline__ void xcd_barrier_complete(unsigned* bar, unsigned x, unsigned& nloc, unsigned& nx) {
    const unsigned G = gridDim.x * gridDim.y * gridDim.z;
    unsigned sum, cnt, mine, sp = 0u;
    for (;;) {
        sum = 0u; cnt = 0u; mine = 0u;
#pragma unroll
        for (unsigned j = 0; j < 16; ++j) { const unsigned c = xb_ld(&bar[XB_XCNT(j)]); sum += c; cnt += (c > 0u) ? 1u : 0u; mine = (j == x) ? c : mine; }
        if (sum == G) break;
        __builtin_amdgcn_s_sleep(1);
        if ((++sp & 255u) == 0u) { if (xb_ld(&bar[XB_TMO])) break; if (sp > XB_SPIN_CAP) { atomicAdd(&bar[XB_TMO], 1u); break; } }
    }
    nloc = mine > 0u ? mine : 1u; nx = cnt > 0u ? cnt : 1u;
}

__device__ __forceinline__ void xcd_barrier(const XcdBarrier& b) {
    asm volatile("s_waitcnt vmcnt(0)" ::: "memory");
    __syncthreads();
    if (threadIdx.x == 0) {
        unsigned* bar = b.bar;
        __builtin_amdgcn_s_waitcnt(0);
        unsigned nloc = b.st[0], nx = b.st[1];
        if (nloc == 0u) { xcd_barrier_complete(bar, b.x, nloc, nx); b.st[0] = nloc; b.st[1] = nx; }
        const unsigned old = xb_add(&bar[XB_XSUB(b.x)], 1u);
        const unsigned gen = old / nloc;
        if (old + 1u == (gen + 1u) * nloc) {
            __builtin_amdgcn_fence(__ATOMIC_RELEASE, "agent");
            asm volatile("s_waitcnt vmcnt(0)" ::: "memory");
            const unsigned og = xb_add(&bar[XB_TOP], 1u);
            const unsigned tg = og / nx;
            if (og + 1u == (tg + 1u) * nx) xb_add(&bar[XB_TOPGEN], 1u);
            else XB_SPIN(xb_ld(&bar[XB_TOPGEN]) == tg, bar);
            __builtin_amdgcn_fence(__ATOMIC_ACQUIRE, "agent");
            xb_add(&bar[XB_XGEN(b.x)], 1u);
            asm volatile("s_waitcnt vmcnt(0)" ::: "memory");
        } else {
            XB_SPIN(xb_ld(&bar[XB_XGEN(b.x)]) == gen, bar);
            __builtin_amdgcn_fence(__ATOMIC_ACQUIRE, "agent");
            asm volatile("s_waitcnt vmcnt(0)" ::: "memory");
        }
    }
    __syncthreads();
}

struct Args { const float* in[10]; float* out; unsigned char* ws; int ph_lo, ph_hi; };
__global__ void __launch_bounds__(512, 2) fwd_megakernel(Args a) {
    extern __shared__ __attribute__((aligned(16))) unsigned char lds_raw[];
    LAS unsigned char* lds = (LAS unsigned char*)lds_raw;
    cg::grid_group grid = cg::this_grid();
    const int G = gridDim.x, bx = blockIdx.x, vcu = (G % 8 == 0) ? (bx % 8) * (G / 8) + bx / 8 : bx;
    const int tid = threadIdx.x, lane = tid & 63, wave = __builtin_amdgcn_readfirstlane(tid >> 6);
    Ptrs P; P.x = a.in[0]; P.pos = (const int*)a.in[1]; P.norm_w = a.in[2]; P.w_in = a.in[3]; P.lbl = a.in[4]; P.hnw = a.in[5]; P.wa = a.in[6]; P.wb = a.in[7]; P.wo = a.in[8]; P.fnw = a.in[9];
    P.out = a.out; P.ws = a.ws;
    unsigned char* ws = a.ws; unsigned char* dout = (unsigned char*)a.out;
    const int lo = a.ph_lo, hi = a.ph_hi;
#ifndef REP_MASK
#define REP_MASK 0
#endif
#define IN(k) (lo <= (k) && (k) < hi)
#define REPS(k) for (int rep_ = 0; rep_ < 1 + ((REP_MASK >> (k)) & 1); ++rep_)
#ifdef PROBE_K
#ifndef PROBE_A
#define PROBE_A PROBE_K
#define PROBE_B (PROBE_K + 1)
#endif
#define STAMP(k) do { if (bx == 0 && tid == 0) ((LAS unsigned long long*)(lds + 163344))[k] = __builtin_amdgcn_s_memrealtime(); } while (0)
#else
#define STAMP(k) do {} while (0)
#endif
#define SEAM(k) do { if (IN(k) && IN((k) + 1)) xcd_barrier(bar); STAMP((k) + 1); } while (0)
    if (tid < 4) ((LAS unsigned*)(lds + 163328))[tid] = 0u;
    __syncthreads();
    const XcdBarrier bar = xcd_barrier_post((unsigned*)(ws + WS_BAR), (volatile LAS unsigned*)(lds + 163328));
    if (a.ph_hi > 1000) grid.sync();
    STAMP(0);
    if (IN(0)) REPS(0) p0_prologue(P, lds, vcu, G);
    SEAM(0);
#ifdef EXTRA_SYNCS
    for (int i_ = 0; i_ < EXTRA_SYNCS; ++i_) xcd_barrier(bar);
#endif
    if (IN(1)) REPS(1) { pg8::Gemm g{(const u16*)(ws + WS_H), (const u16*)(ws + WS_WT) + (size_t)6144 * 1024, TT, 5120, 1024}; pg8::StaticOrder S; S.init(TT, 5120, G, bx);
        EpiZ E{0, ws, dout, P.lbl}; pg8::gemm_phase<EpiZ, pg8::StaticOrder, true, true>(lds, g, S, E); }
    SEAM(1);
    if (IN(2)) REPS(2) attn_phase(lds, (const u16*)(ws + WS_Z), (u16*)(dout + DO_OG), (float*)(ws + WS_COS), bx, G);
    SEAM(2);
    if (IN(3)) {
        pg8::Gemm g{(const u16*)(ws + WS_H), (const u16*)(ws + WS_WT), TT, 4096, 1024}; DefOrder S; S.base.init(48 * 256, 4096, G, bx);
        EpiZ E{1, ws, dout, P.lbl}; pg8::gemm_phase<EpiZ, DefOrder, true, true>(lds, g, S, E); }
    SEAM(3);
    if (IN(4)) {
        {
            if (bx < 64) { hgrn_unit(lds, bx >> 3, bx & 7, (const u16*)(ws + Z_QA), (const u16*)(ws + Z_G), (const u16*)(ws + Z_VA), (const u16*)(ws + Z_HG), P.hnw, (u16*)(ws + Z_QA), (unsigned*)(ws + WS_BAR + 36864)); STAMP(9);
            }
            else { const int x = bx & 7, r = (bx >> 3) - 8;
                const pg8::Gemm gG{(const u16*)(ws + WS_H), (const u16*)(ws + WS_WT) + (size_t)4096 * 1024, TT, 2048, 1024}; const pg8::Gemm gB{(const u16*)(dout + DO_OG), (const u16*)(ws + WS_WB), TT, 1024, 512};
                const EpiZ EG{2, ws, dout, P.lbl}; const EpiGateB EB{(const u16*)(ws + Z_GATES), (u16*)(dout + DO_TMPB)};
                unsigned lg, lb2;
                if (r < 8) { lg = lo_code(r, 4) | (lo_code(r + 24, 4) << 8) | 0xffff0000u; lb2 = lo_code(r, 0) | (lo_code(r + 24, 0) << 8) | 0xffff0000u; }
                else { lg = lo_code(r, 4) | (lo_code(2 * (r - 8), 0) << 8) | (lo_code(2 * (r - 8) + 1, 0) << 16) | 0xff000000u; lb2 = lo_code(r, 0) | 0xffffff00u; }
                unsigned* mcnt = (unsigned*)(ws + WS_BAR + 16384 + 64 * 64 * 4);
                unsigned* dcnt = (unsigned*)(ws + WS_BAR + 36864);
                { unsigned ld; if (r < 8) ld = (unsigned)(((2 * r) << 3) | 6) | ((unsigned)(((2 * r + 1) << 3) | 6) << 8) | 0xffff0000u; else ld = (unsigned)(((r - 8) << 3) | 7) | 0xffffff00u;
                  const pg8::Gemm gD{(const u16*)(ws + WS_H), (const u16*)(ws + WS_WT), TT, 4096, 1024}; const EpiZT<true> ED{1, ws, dout, P.lbl};
                  ListOrder S{8 * x, ld}; pg8::gemm_phase<EpiZT<true>, ListOrder, true, true>(lds, gD, S, ED);
                  asm volatile("s_waitcnt vmcnt(0)" ::: "memory"); __syncthreads();
                  if (tid == 0) __hip_atomic_fetch_add(dcnt + 64 * (8 * x + (r < 8 ? 6 : 7)), (r < 8 ? 2u : 1u), __ATOMIC_RELAXED, __HIP_MEMORY_SCOPE_AGENT); }
                merge_phase((u16*)(dout + DO_OG), (const float*)(ws + WS_COS), (const u16*)(dout + DO_AG), bx - 64, 192);
                asm volatile("s_waitcnt vmcnt(0)" ::: "memory"); __syncthreads();
                if (tid == 0) __hip_atomic_fetch_add(mcnt, 1u, __ATOMIC_RELAXED, __HIP_MEMORY_SCOPE_AGENT);
                { ListOrder S{8 * x, lg}; pg8::gemm_phase<EpiZ, ListOrder, true, true>(lds, gG, S, EG); }
                if (tid == 0) { unsigned sp = 0u; while (__hip_atomic_load(mcnt, __ATOMIC_RELAXED, __HIP_MEMORY_SCOPE_AGENT) < 192u) { __builtin_amdgcn_s_sleep(2); if (++sp > (1u << 22)) break; }
                    __builtin_amdgcn_fence(__ATOMIC_ACQUIRE, "agent"); asm volatile("s_waitcnt vmcnt(0)" ::: "memory"); }
                __syncthreads();
                { ListOrder S{8 * x, lb2}; pg8::gemm_phase<EpiGateB, ListOrder, true, true>(lds, gB, S, EB); } }
        }
    }
    SEAM(4);
    if (IN(5)) { pg8::Gemm g{(const u16*)(ws + Z_QA), (const u16*)(ws + WS_WA), TT, 1024, 1024}; pg8::StaticOrder S; S.init(TT, 1024, G, bx);
        EpiGateA E{(const u16*)(ws + Z_GATES), (const u16*)(dout + DO_TMPB), (u16*)(ws + Z_MERGED)}; pg8::gemm_phase<EpiGateA, pg8::StaticOrder, true, true>(lds, g, S, E); }
    SEAM(5);
    if (IN(6)) { pg8::Gemm g{(const u16*)(ws + Z_MERGED), (const u16*)(ws + WS_WO), TT, 1024, 1024}; pg8::StaticOrder S; S.init(TT, 1024, G, bx);
        EpiOutNorm E{P.x, P.out, P.fnw, (float*)(ws + WS_BAR + 65536), (unsigned*)(ws + WS_BAR + 16384)}; pg8::gemm_phase<EpiOutNorm, pg8::StaticOrder, false, true>(lds, g, S, E); }
#ifdef HG_PROBE_MODE
    if (bx < 64) hgrn_unit<HG_PROBE_MODE>(lds, bx >> 3, bx & 7, (const u16*)(ws + Z_QA), (const u16*)(ws + Z_G), (const u16*)(ws + Z_VA), (const u16*)(ws + Z_HG), P.hnw, (u16*)(ws + Z_HG), nullptr);
#endif
#ifdef PROBE_K
    STAMP(7);
    if (bx == 0 && tid == 0) { const LAS unsigned long long* ts = (const LAS unsigned long long*)(lds + 163344);
#ifdef PROBE_ACC
        const unsigned long long dt = ts[10], t0
#else
        const unsigned long long dt = ts[PROBE_B] - ts[PROBE_A], t0
#endif
 = __builtin_amdgcn_s_memrealtime();
        while (__builtin_amdgcn_s_memrealtime() - t0 < dt) __builtin_amdgcn_s_sleep(8); }
#endif
#undef IN
#undef SEAM
}

extern "C" void kernel_launch(void* const* d_in, const int* in_sizes, int n_in, void* d_out, int out_size, void* d_ws, size_t ws_size, hipStream_t stream) {
    static int grid = 0;
    if (grid == 0) {
        if (n_in != 10 || in_sizes[0] != TT * DM || out_size != TT * DM || ws_size < WS_END) { fprintf(stderr, "kernel_launch: unexpected shapes (n_in %d, in0 %d, out %d, ws %zu)\n", n_in, n_in > 0 ? in_sizes[0] : -1, out_size, ws_size); grid = -1; return; }
        int dev = 0, cus = 0, per_cu = 0;
        hipGetDevice(&dev); hipDeviceGetAttribute(&cus, hipDeviceAttributeMultiprocessorCount, dev);
        if (hipFuncSetAttribute((const void*)fwd_megakernel, hipFuncAttributeMaxDynamicSharedMemorySize, LDS_BYTES) != hipSuccess) { fprintf(stderr, "kernel_launch: hipFuncSetAttribute failed\n"); grid = -1; return; }
        if (hipOccupancyMaxActiveBlocksPerMultiprocessor(&per_cu, (const void*)fwd_megakernel, 512, LDS_BYTES) != hipSuccess || per_cu < 1) { fprintf(stderr, "kernel_launch: occupancy query says %d\n", per_cu); per_cu = 1; }
        (void)hipGetLastError();
        grid = cus * (per_cu > 1 ? 1 : per_cu);
        if (grid != 256) { fprintf(stderr, "kernel_launch: built for a 256-CU device (one workgroup per CU); got %d\n", grid); grid = -1; return; }
    }
    if (grid < 0) return;
    if (hipMemsetAsync((char*)d_ws + WS_BAR, 0, 36864 + 16384, stream) != hipSuccess) { fprintf(stderr, "kernel_launch: memset of the barrier words failed\n"); return; }
    Args a{};
    for (int i = 0; i < 10; ++i) a.in[i] = (const float*)d_in[i];
    a.out = (float*)d_out; a.ws = (unsigned char*)d_ws; a.ph_lo = 0; a.ph_hi = 7;
    void* args[] = {&a};
    hipError_t e = hipLaunchCooperativeKernel((const void*)fwd_megakernel, dim3(grid), dim3(512), args, LDS_BYTES, stream);
    if (e != hipSuccess) fprintf(stderr, "kernel_launch: cooperative launch failed: %s (grid %d)\n", hipGetErrorString(e), grid);
}
```

```cpp
#include <hip/hip_runtime.h>
#include <hip/hip_cooperative_groups.h>
#include <hip/hip_bf16.h>
#include <cstdio>
#include <cstdint>
#include <cmath>
namespace cg = cooperative_groups;
namespace pg8 {
#define PG8_LAS __attribute__((address_space(3)))
typedef unsigned short bf16_t;
typedef short bf16x8 __attribute__((ext_vector_type(8)));
typedef float f32x4 __attribute__((ext_vector_type(4)));
typedef unsigned u32x4 __attribute__((ext_vector_type(4)));
constexpr int BM = 256, BK = 64, HALF = 128, HTB = HALF * BK * 2  , STAGE_BYTES = 8 * HTB, NXCD = 8, WGM = 8;

__host__ __device__ __forceinline__ int lds_byte(int r, int c) { const int st = (r >> 4) * 2 + (c >> 5), rr = r & 15, cc = c & 31, ob = rr * 64 + cc * 2; return st * 1024 + (ob ^ (((ob >> 9) & 1) << 5)); }
__host__ __device__ __forceinline__ void stage_rc(int b, int& R, int& C) { const int st = b / 1024, sb = b % 1024, swz = sb ^ (((sb >> 9) & 1) << 5); R = (st >> 1) * 16 + swz / 64; C = (st & 1) * 32 + (swz % 64) / 2; }
__host__ __device__ __forceinline__ int perm32(int rho) { const int n = rho >> 4, i = rho & 15; return 8 * (i >> 2) + 4 * n + (i & 3); }

struct Unit { int pm, pn; };
struct Gemm { const bf16_t* A; const bf16_t* Bt; int M, N, K; };

struct StaticOrder {
    int nM, nN, nwg, G, c;
    __host__ __device__ void init(int M, int N, int G_, int c_) { nM = M / BM; nN = N / BM; nwg = nM * nN; G = G_; c = c_; }
    __host__ __device__ bool next(int i, Unit& u) const {
        const long L = (long)i * G + c; if (L >= nwg) return false;
        int wgid = (int)L; { const int q = nwg / NXCD, r = nwg % NXCD, xcd = wgid % NXCD, off = wgid / NXCD; wgid = (xcd < r ? xcd * (q + 1) : r * (q + 1) + (xcd - r) * q) + off; }
        const int nig = WGM * nN, gid = wgid / nig, fm = gid * WGM, gsz = (nM - fm) < WGM ? (nM - fm) : WGM;
        u.pm = fm + ((wgid % nig) % gsz); u.pn = (wgid % nig) / gsz; return true;
    }
    __device__ __forceinline__ void a_ready(const Unit&) const {}
    __device__ __forceinline__ void done(const Unit&) const {}
};

__device__ __forceinline__ unsigned cvt_pk_bf16(float lo, float hi) { unsigned r; asm volatile("v_cvt_pk_bf16_f32 %0, %1, %2" : "=v"(r) : "v"(lo), "v"(hi)); return r; }
typedef float f32x2 __attribute__((ext_vector_type(2)));
template <class Epi, class Sched, bool ALIGN_EPI = false, bool SP2 = false>
__device__ __forceinline__ void gemm_phase(PG8_LAS unsigned char* lds, const Gemm g, const Sched& S, const Epi& E) {
    const int tid = threadIdx.x, wid = __builtin_amdgcn_readfirstlane(tid >> 6), lane = tid & 63, wr = wid >> 2, wc = wid & 3, fr = lane & 15, fq = lane >> 4;
    const int K = g.K, nt = K / BK;
    unsigned voffA[2], voffB[2];
#pragma unroll
    for (int i = 0; i < 2; ++i) { int R, C; stage_rc(tid * 16 + i * 8192, R, C); const int Rb = Epi::PERM ? ((R & ~31) + perm32(R & 31)) : R;
        voffA[i] = (unsigned)(R * K + C) * 2u; voffB[i] = (unsigned)(Rb * K + C) * 2u; }
    const size_t kstep = (size_t)(BK * 2);
    const size_t hstep = (size_t)HALF * K * 2;
    const size_t tstep = 2 * hstep;
    const unsigned ldsw = (unsigned)wid * 1024u;
    const int aoff = lds_byte(wr * 64 + fr, fq * 8), boff = lds_byte(wc * 32 + fr, fq * 8);
#define PG8_SA(b, h) (((b) * 2 + (h)) * HTB)
#define PG8_SB(b, h) ((4 + (b) * 2 + (h)) * HTB)
#define PG8_STAGE(bufoff, gbase, voff) do { _Pragma("unroll") for (int _i = 0; _i < 2; ++_i) \
        __builtin_amdgcn_global_load_lds((const unsigned*)((const char*)(gbase) + (voff)[_i]), (PG8_LAS unsigned*)(lds + (bufoff) + ldsw + _i * 8192), 16, 0, 0); } while (0)
#define PG8_LDA(dst, b, h) do { _Pragma("unroll") for (int m = 0; m < 4; ++m) _Pragma("unroll") for (int k = 0; k < 2; ++k) dst[m][k] = *(const PG8_LAS bf16x8*)(lds + PG8_SA(b, h) + aoff + m * 2048 + k * 1024); } while (0)
#define PG8_LDB(dst, b, h) do { _Pragma("unroll") for (int n = 0; n < 2; ++n) _Pragma("unroll") for (int k = 0; k < 2; ++k) dst[n][k] = *(const PG8_LAS bf16x8*)(lds + PG8_SB(b, h) + boff + n * 2048 + k * 1024); } while (0)
#define PG8_MMA(ai, bj, At, Bt) do { __builtin_amdgcn_s_setprio(1); _Pragma("unroll") for (int m = 0; m < 4; ++m) _Pragma("unroll") for (int n = 0; n < 2; ++n) _Pragma("unroll") for (int k = 0; k < 2; ++k) \
        acc[ai][bj][m][n] = __builtin_amdgcn_mfma_f32_16x16x32_bf16(Bt[n][k], At[m][k], acc[ai][bj][m][n], 0, 0, 0); __builtin_amdgcn_s_setprio(0); } while (0)
#define PG8_WAIT_V(n) asm volatile("s_waitcnt vmcnt(" #n ")" ::: "memory")
#define PG8_WAIT_L(n) asm volatile("s_waitcnt lgkmcnt(" #n ")" ::: "memory")
#define PG8_BAR __builtin_amdgcn_s_barrier()
#define PG8_SCHED __builtin_amdgcn_sched_barrier(0)
    Unit cur, nxt; int ui = 0;
    if (!S.next(0, cur)) return;
    f32x4 acc[2][2][4][2];
#pragma unroll
    for (int a = 0; a < 2; ++a)
#pragma unroll
        for (int b = 0; b < 2; ++b)
#pragma unroll
            for (int m = 0; m < 4; ++m)
#pragma unroll
                for (int n = 0; n < 2; ++n) acc[a][b][m][n] = (f32x4){0.f, 0.f, 0.f, 0.f};
    bf16x8 At[4][2], B0[2][2], B1[2][2];
    const char* cA = (const char*)g.A + (size_t)cur.pm * tstep; const char* cB = (const char*)g.Bt + (size_t)cur.pn * tstep;
    S.a_ready(cur);
    if constexpr (SP2) {
        PG8_STAGE(PG8_SB(0, 0), cB, voffB); PG8_STAGE(PG8_SB(0, 1), cB + hstep, voffB); PG8_STAGE(PG8_SA(0, 0), cA, voffA); PG8_STAGE(PG8_SA(0, 1), cA + hstep, voffA);
        if (wr == 1) PG8_BAR;
        PG8_WAIT_V(2); PG8_BAR;
        PG8_STAGE(PG8_SB(1, 0), cB + kstep, voffB); PG8_STAGE(PG8_SA(1, 0), cA + kstep, voffA); PG8_STAGE(PG8_SB(1, 1), cB + hstep + kstep, voffB);
        PG8_WAIT_V(6); PG8_BAR;
    } else {
        PG8_STAGE(PG8_SB(0, 0), cB, voffB); PG8_STAGE(PG8_SA(0, 0), cA, voffA); PG8_STAGE(PG8_SB(0, 1), cB + hstep, voffB); PG8_STAGE(PG8_SA(0, 1), cA + hstep, voffA);
        if (wr == 1) PG8_BAR;
        PG8_WAIT_V(4); PG8_BAR;
        PG8_STAGE(PG8_SB(1, 0), cB + kstep, voffB); PG8_STAGE(PG8_SA(1, 0), cA + kstep, voffA); PG8_STAGE(PG8_SB(1, 1), cB + hstep + kstep, voffB);
        PG8_WAIT_V(6); PG8_BAR;
    }
    for (;;) {
        const bool has_next = S.next(ui + 1, nxt);
        const char* nA = has_next ? (const char*)g.A + (size_t)nxt.pm * tstep : cA; const char* nB = has_next ? (const char*)g.Bt + (size_t)nxt.pn * tstep : cB;
        for (int t = 0; t < nt; t += 2) {
            const bool last = (t == nt - 2);
            const char* a1 = cA + (size_t)(t + 1) * kstep;
            const char* a2 = last ? nA : cA + (size_t)(t + 2) * kstep; const char* b2 = last ? nB : cB + (size_t)(t + 2) * kstep;
            const char* a3 = a2 + kstep; const char* b3 = b2 + kstep;
            if (last && has_next) S.a_ready(nxt);
            if constexpr (SP2) {
            PG8_LDB(B0, 0, 0); PG8_LDB(B1, 0, 1); PG8_SCHED; PG8_LDA(At, 0, 0); PG8_STAGE(PG8_SA(1, 1), a1 + hstep, voffA);
            PG8_WAIT_V(8); PG8_WAIT_L(0); PG8_BAR; PG8_MMA(0, 0, At, B0); PG8_MMA(0, 1, At, B1); PG8_BAR; PG8_SCHED;
            PG8_LDA(At, 0, 1); PG8_STAGE(PG8_SB(0, 0), b2, voffB); PG8_STAGE(PG8_SB(0, 1), b2 + hstep, voffB); PG8_STAGE(PG8_SA(0, 0), a2, voffA);
            PG8_WAIT_V(8); PG8_WAIT_L(0); PG8_BAR; PG8_MMA(1, 0, At, B0); PG8_MMA(1, 1, At, B1); PG8_BAR; PG8_SCHED;
            PG8_LDB(B0, 1, 0); PG8_LDB(B1, 1, 1); PG8_SCHED; PG8_LDA(At, 1, 0); PG8_STAGE(PG8_SA(0, 1), a2 + hstep, voffA);
            PG8_WAIT_V(8); PG8_WAIT_L(0); PG8_BAR; PG8_MMA(0, 0, At, B0); PG8_MMA(0, 1, At, B1); PG8_BAR; PG8_SCHED;
            PG8_LDA(At, 1, 1); PG8_STAGE(PG8_SB(1, 0), b3, voffB); PG8_STAGE(PG8_SB(1, 1), b3 + hstep, voffB); PG8_STAGE(PG8_SA(1, 0), a3, voffA);
            PG8_WAIT_V(8); PG8_WAIT_L(0); PG8_BAR; PG8_MMA(1, 0, At, B0); PG8_MMA(1, 1, At, B1); PG8_BAR; PG8_SCHED;
            } else {
            PG8_LDB(B0, 0, 0); PG8_SCHED; PG8_LDA(At, 0, 0); PG8_STAGE(PG8_SA(1, 1), a1 + hstep, voffA);
            PG8_WAIT_L(8); PG8_BAR; PG8_WAIT_L(0); PG8_MMA(0, 0, At, B0); PG8_BAR; PG8_SCHED;
            PG8_LDB(B1, 0, 1); PG8_STAGE(PG8_SB(0, 0), b2, voffB);
            PG8_BAR; PG8_WAIT_L(0); PG8_MMA(0, 1, At, B1); PG8_BAR;
            PG8_LDA(At, 0, 1); PG8_STAGE(PG8_SA(0, 0), a2, voffA);
            PG8_BAR; PG8_WAIT_L(0); PG8_MMA(1, 0, At, B0); PG8_BAR; PG8_SCHED;
            PG8_STAGE(PG8_SB(0, 1), b2 + hstep, voffB);
            PG8_WAIT_V(6); PG8_BAR; PG8_MMA(1, 1, At, B1); PG8_BAR;
            PG8_LDB(B0, 1, 0); PG8_SCHED; PG8_LDA(At, 1, 0); PG8_STAGE(PG8_SA(0, 1), a2 + hstep, voffA);
            PG8_WAIT_L(8); PG8_BAR; PG8_WAIT_L(0); PG8_MMA(0, 0, At, B0); PG8_BAR; PG8_SCHED;
            PG8_LDB(B1, 1, 1); PG8_STAGE(PG8_SB(1, 0), b3, voffB);
            PG8_BAR; PG8_WAIT_L(0); PG8_MMA(0, 1, At, B1); PG8_BAR;
            PG8_LDA(At, 1, 1); PG8_STAGE(PG8_SA(1, 0), a3, voffA);
            PG8_BAR; PG8_WAIT_L(0); PG8_MMA(1, 0, At, B0); PG8_BAR; PG8_SCHED;
            PG8_STAGE(PG8_SB(1, 1), b3 + hstep, voffB);
            PG8_WAIT_V(6); PG8_BAR; PG8_MMA(1, 1, At, B1); PG8_BAR;
            }
        }
        if constexpr (ALIGN_EPI) { if (wr == 0) PG8_BAR; }
        if constexpr (!Epi::AFTER_DRAIN) { E(acc, cur, wr, wc, fr, fq); S.done(cur); }
        if (!has_next) break;
#pragma unroll
        for (int a = 0; a < 2; ++a)
#pragma unroll
            for (int b = 0; b < 2; ++b)
#pragma unroll
                for (int m = 0; m < 4; ++m)
#pragma unroll
                    for (int n = 0; n < 2; ++n) acc[a][b][m][n] = (f32x4){0.f, 0.f, 0.f, 0.f};
        cur = nxt; cA = nA; cB = nB; ++ui;
        if constexpr (ALIGN_EPI) { if (wr == 1) PG8_BAR; }
    }
    PG8_WAIT_V(0);
    if constexpr (!ALIGN_EPI) { if (wr == 0) PG8_BAR; }
    PG8_BAR;
    if constexpr (Epi::AFTER_DRAIN) { E.fused(acc, cur, wr, wc, fr, fq, lds, wid, lane); S.done(cur); }
#undef PG8_SA
#undef PG8_SB
#undef PG8_STAGE
#undef PG8_LDA
#undef PG8_LDB
#undef PG8_MMA
#undef PG8_WAIT_V
#undef PG8_WAIT_L
#undef PG8_BAR
#undef PG8_SCHED
}
}

#define LAS __attribute__((address_space(3)))
typedef unsigned short u16;
typedef short bf16x8 __attribute__((ext_vector_type(8)));
typedef short s16x4 __attribute__((ext_vector_type(4)));
typedef float f32x4 __attribute__((ext_vector_type(4)));
typedef float f32x2 __attribute__((ext_vector_type(2)));
typedef unsigned u32x4 __attribute__((ext_vector_type(4)));
typedef unsigned u32x2 __attribute__((ext_vector_type(2)));

constexpr int TT = 16384, DM = 1024, SEQ = 2048, NIN = 11264;
constexpr int ZBP = 4608;
constexpr size_t MiB = 1u << 20;
constexpr size_t WS_WT = 0;
constexpr size_t WS_WA = 22 * MiB, WS_WB = 24 * MiB, WS_WO = 25 * MiB;
constexpr size_t WS_COS = 27 * MiB, WS_SIN = 29 * MiB;
constexpr size_t WS_BAR = 31 * MiB;
constexpr size_t WS_H = 32 * MiB;
constexpr size_t WS_Z = 64 * MiB;
constexpr size_t Z_QA = WS_Z, Z_G = WS_Z + 32 * MiB, Z_VA = WS_Z + 64 * MiB, Z_HG = WS_Z + 96 * MiB, Z_GATES = WS_Z + 128 * MiB;
constexpr size_t Z_MERGED = WS_Z + 64 * MiB;
constexpr size_t WS_END = 256 * MiB;
constexpr size_t DO_OG = 0, DO_AG = 48 * MiB, DO_TMPB = 16 * MiB;
constexpr int LDS_BYTES = 163840;
constexpr float NORM_EPS = 1e-6f;

__device__ __forceinline__ unsigned pk_bf16(float lo, float hi) { typedef __bf16 b2 __attribute__((ext_vector_type(2))); f32x2 v = {lo, hi}; b2 b = __builtin_convertvector(v, b2); return __builtin_bit_cast(unsigned, b); }
__device__ __forceinline__ unsigned pk_f16(float lo, float hi) { typedef _Float16 h2 __attribute__((ext_vector_type(2))); h2 h = {(_Float16)lo, (_Float16)hi}; return __builtin_bit_cast(unsigned, h); }
__device__ __forceinline__ float bflo(unsigned u) { return __uint_as_float(u << 16); }
__device__ __forceinline__ float bfhi(unsigned u) { return __uint_as_float(u & 0xffff0000u); }
__device__ __forceinline__ float f16lo(unsigned u) { return (float)__builtin_bit_cast(_Float16, (unsigned short)(u & 0xffffu)); }
__device__ __forceinline__ float f16hi(unsigned u) { return (float)__builtin_bit_cast(_Float16, (unsigned short)(u >> 16)); }
__device__ __forceinline__ float sigm(float x) { return __builtin_amdgcn_rcpf(1.0f + __expf(-x)); }
__device__ __forceinline__ s16x4 ds_tr(const LAS u16* p) { typedef short v4 __attribute__((ext_vector_type(4))); return __builtin_bit_cast(s16x4, __builtin_amdgcn_ds_read_tr16_b64_v4i16((LAS v4*)p)); }
__device__ __forceinline__ bf16x8 cat8(s16x4 lo, s16x4 hi) { return (bf16x8){lo[0], lo[1], lo[2], lo[3], hi[0], hi[1], hi[2], hi[3]}; }
__device__ __forceinline__ f32x4 mfma16(bf16x8 a, bf16x8 b, f32x4 c) { return __builtin_amdgcn_mfma_f32_16x16x32_bf16(a, b, c, 0, 0, 0); }
__device__ __forceinline__ void store16_wt(void* p, u32x4 v) { asm volatile("global_store_dwordx4 %0, %1, off sc1\n\ts_nop 1" :: "v"(p), "v"(v) : "memory"); }
template <bool WT> __device__ __forceinline__ void store16(void* p, u32x4 v) { if (WT) store16_wt(p, v); else *(u32x4*)p = v; }
__device__ __forceinline__ float wave_sum(float v) {
#pragma unroll
    for (int o = 1; o < 64; o <<= 1) v += __shfl_xor(v, o);
    return v;
}

using pg8::Unit;
template <int ACT  > __device__ __forceinline__ float act1(float v) { if (ACT == 1) return v * sigm(v); if (ACT == 2) return sigm(v); return v; }
template <int ACT, bool WT = false> __device__ __forceinline__ void epi_store16(const f32x4 (&acc)[2][2][4][2], u16* base, int pitch, int row0, int col0) {
#pragma unroll
    for (int ai = 0; ai < 2; ++ai)
#pragma unroll
        for (int m = 0; m < 4; ++m) { u16* rowp = base + (size_t)(row0 + ai * 128 + m * 16) * pitch + col0;
#pragma unroll
            for (int bj = 0; bj < 2; ++bj) { const f32x4 v0 = acc[ai][bj][m][0], v1 = acc[ai][bj][m][1]; u32x4 w;
                w.x = pk_bf16(act1<ACT>(v0[0]), act1<ACT>(v0[1])); w.y = pk_bf16(act1<ACT>(v0[2]), act1<ACT>(v0[3]));
                w.z = pk_bf16(act1<ACT>(v1[0]), act1<ACT>(v1[1])); w.w = pk_bf16(act1<ACT>(v1[2]), act1<ACT>(v1[3]));
                store16<WT>(rowp + bj * 128, w); } }
}
template <int ACT, bool WT> __device__ __forceinline__ void epi_store16_hm(const f32x4 (&acc)[2][2][4][2], u16* base, int pnl, int row0, int lc) {
#pragma unroll
    for (int ai = 0; ai < 2; ++ai)
#pragma unroll
        for (int m = 0; m < 4; ++m) { const int row = row0 + ai * 128 + m * 16, b = row >> 11, t = row & 2047;
#pragma unroll
            for (int bj = 0; bj < 2; ++bj) { const f32x4 v0 = acc[ai][bj][m][0], v1 = acc[ai][bj][m][1]; u32x4 w;
                w.x = pk_bf16(act1<ACT>(v0[0]), act1<ACT>(v0[1])); w.y = pk_bf16(act1<ACT>(v0[2]), act1<ACT>(v0[3]));
                w.z = pk_bf16(act1<ACT>(v1[0]), act1<ACT>(v1[1])); w.w = pk_bf16(act1<ACT>(v1[2]), act1<ACT>(v1[3]));
                store16<WT>(base + ((size_t)(b * 8 + 2 * pnl + bj) * 2048 + t) * 128 + lc, w); } }
}
template <bool WT> struct EpiZT {
    static constexpr bool PERM = true, AFTER_DRAIN = false;
    int mode;
    unsigned char* ws; unsigned char* dout; const float* lbl;
    __device__ __forceinline__ void operator()(const f32x4 (&acc)[2][2][4][2], const Unit& u, int wr, int wc, int fr, int fq) const {
        const int pn = u.pn, row0 = u.pm * 256 + wr * 64 + fr, lc = wc * 32 + 8 * fq;
        if (mode == 2) { epi_store16<2>(acc, (u16*)(ws + Z_GATES), 2048, row0, pn * 256 + lc); return; }
        if (mode == 0) {
            u16* ZB = (u16*)(ws + WS_Z);
            if (pn < 12) {
                const float sc = (pn < 6) ? 0.125f * 1.4426950408889634f : 1.0f;
                const float* cosT = (const float*)(ws + WS_COS); const float* sinT = (const float*)(ws + WS_SIN);
                const int jb = 16 * (wc & 1) + 4 * fq;
#pragma unroll
                for (int ai = 0; ai < 2; ++ai) { f32x4 cc[4], ss[4];
#pragma unroll
                    for (int m = 0; m < 4; ++m) { const int row = row0 + ai * 128 + m * 16; cc[m] = *(const f32x4*)(cosT + (size_t)row * 32 + jb); ss[m] = *(const f32x4*)(sinT + (size_t)row * 32 + jb); }
#pragma unroll
                    for (int m = 0; m < 4; ++m) { const int row = row0 + ai * 128 + m * 16; const f32x4 c = cc[m], s = ss[m];
                        u16* rowp = ZB + ((size_t)(pn * 4 + (wc >> 1)) * TT + row) * 64 + (lc & 63);
#pragma unroll
                        for (int bj = 0; bj < 2; ++bj) { const f32x4 v0 = acc[ai][bj][m][0], v1 = acc[ai][bj][m][1]; u32x4 w;
                            w.x = pk_bf16((v0[0] * c[0] - v0[1] * s[0]) * sc, (v0[1] * c[0] + v0[0] * s[0]) * sc);
                            w.y = pk_bf16((v0[2] * c[1] - v0[3] * s[1]) * sc, (v0[3] * c[1] + v0[2] * s[1]) * sc);
                            w.z = pk_bf16((v1[0] * c[2] - v1[1] * s[2]) * sc, (v1[1] * c[2] + v1[0] * s[2]) * sc);
                            w.w = pk_bf16((v1[2] * c[3] - v1[3] * s[3]) * sc, (v1[3] * c[3] + v1[2] * s[3]) * sc);
                            *(u32x4*)(rowp + (size_t)bj * 2 * TT * 64) = w; } } }
            } else if (pn < 18) {
#pragma unroll
                for (int ai = 0; ai < 2; ++ai)
#pragma unroll
                    for (int m = 0; m < 4; ++m) { u16* rowp = ZB + ((size_t)(pn * 4 + (wc >> 1)) * TT + (row0 + ai * 128 + m * 16)) * 64 + (lc & 63);
#pragma unroll
                        for (int bj = 0; bj < 2; ++bj) { const f32x4 v0 = acc[ai][bj][m][0], v1 = acc[ai][bj][m][1]; u32x4 w;
                            w.x = pk_bf16(v0[0], v0[1]); w.y = pk_bf16(v0[2], v0[3]); w.z = pk_bf16(v1[0], v1[1]); w.w = pk_bf16(v1[2], v1[3]);
                            *(u32x4*)(rowp + (size_t)bj * 2 * TT * 64) = w; } }
            }
            else epi_store16<1>(acc, (u16*)(dout + DO_AG), 512, row0, (pn - 18) * 256 + lc);
        } else {
            if (pn < 4) epi_store16<1, WT>(acc, (u16*)(ws + Z_QA), 1024, row0, pn * 256 + lc);
            else if (pn < 8) {
                const int cb = (pn - 4) * 256 + lc; float lb[2][8];
#pragma unroll
                for (int bj = 0; bj < 2; ++bj)
#pragma unroll
                    for (int e = 0; e < 8; ++e) { const int idx = cb + bj * 128 + e; lb[bj][e] = 1.0f / (1.0f + __expf(lbl[1024 + idx] - lbl[idx])); }
                u16* G = (u16*)(ws + Z_G);
#pragma unroll
                for (int ai = 0; ai < 2; ++ai)
#pragma unroll
                    for (int m = 0; m < 4; ++m) { const int row = row0 + ai * 128 + m * 16; u16* rowp = G + ((size_t)((row >> 11) * 8 + 2 * (pn - 4)) * 2048 + (row & 2047)) * 128 + lc;
#pragma unroll
                        for (int bj = 0; bj < 2; ++bj) { const f32x4 v0 = acc[ai][bj][m][0], v1 = acc[ai][bj][m][1]; float g[8];
#pragma unroll
                            for (int e = 0; e < 8; ++e) { const float v = e < 4 ? v0[e & 3] : v1[e & 3]; g[e] = lb[bj][e] + (1.0f - lb[bj][e]) * sigm(v); }
                            u32x4 w; w.x = pk_f16(g[0], g[1]); w.y = pk_f16(g[2], g[3]); w.z = pk_f16(g[4], g[5]); w.w = pk_f16(g[6], g[7]);
                            store16<WT>(rowp + (size_t)bj * 2048 * 128, w); } }
            } else if (pn < 12) epi_store16_hm<0, WT>(acc, (u16*)(ws + Z_VA), pn - 8, row0, lc);
            else if (pn < 16) epi_store16_hm<1, WT>(acc, (u16*)(ws + Z_HG), pn - 12, row0, lc);
            else epi_store16<2>(acc, (u16*)(ws + Z_GATES), 2048, row0, (pn - 16) * 256 + lc);
        }
    }
};
typedef EpiZT<false> EpiZ;
struct EpiGateB {
    static constexpr bool PERM = true, AFTER_DRAIN = false;
    const u16* gates; u16* tmpb;
    __device__ __forceinline__ void operator()(const f32x4 (&acc)[2][2][4][2], const Unit& u, int wr, int wc, int fr, int fq) const {
        const int row0 = u.pm * 256 + wr * 64 + fr, col0 = u.pn * 256 + wc * 32 + 8 * fq;
#pragma unroll
        for (int ai = 0; ai < 2; ++ai) { u32x4 gg[4][2];
#pragma unroll
            for (int m = 0; m < 4; ++m)
#pragma unroll
                for (int bj = 0; bj < 2; ++bj) gg[m][bj] = *(const u32x4*)(gates + (size_t)(row0 + ai * 128 + m * 16) * 2048 + 1024 + col0 + bj * 128);
#pragma unroll
            for (int m = 0; m < 4; ++m) { const size_t row = row0 + ai * 128 + m * 16;
#pragma unroll
                for (int bj = 0; bj < 2; ++bj) { const int col = col0 + bj * 128; const u32x4 g = gg[m][bj];
                    const f32x4 v0 = acc[ai][bj][m][0], v1 = acc[ai][bj][m][1]; u32x4 w;
                    w.x = pk_bf16(v0[0] * bflo(g.x), v0[1] * bfhi(g.x)); w.y = pk_bf16(v0[2] * bflo(g.y), v0[3] * bfhi(g.y));
                    w.z = pk_bf16(v1[0] * bflo(g.z), v1[1] * bfhi(g.z)); w.w = pk_bf16(v1[2] * bflo(g.w), v1[3] * bfhi(g.w));
                    *(u32x4*)(tmpb + row * 1024 + col) = w; } } }
    }
};
struct EpiGateA {
    static constexpr bool PERM = true, AFTER_DRAIN = false;
    const u16* gates; const u16* tmpb; u16* merged;
    __device__ __forceinline__ void operator()(const f32x4 (&acc)[2][2][4][2], const Unit& u, int wr, int wc, int fr, int fq) const {
        const int row0 = u.pm * 256 + wr * 64 + fr, col0 = u.pn * 256 + wc * 32 + 8 * fq;
#pragma unroll
        for (int ai = 0; ai < 2; ++ai) { u32x4 gg[4][2], tb[4][2];
#pragma unroll
            for (int m = 0; m < 4; ++m)
#pragma unroll
                for (int bj = 0; bj < 2; ++bj) { const size_t row = row0 + ai * 128 + m * 16; gg[m][bj] = *(const u32x4*)(gates + row * 2048 + col0 + bj * 128); tb[m][bj] = *(const u32x4*)(tmpb + row * 1024 + col0 + bj * 128); }
#pragma unroll
            for (int m = 0; m < 4; ++m) { const size_t row = row0 + ai * 128 + m * 16;
#pragma unroll
                for (int bj = 0; bj < 2; ++bj) { const int col = col0 + bj * 128; const u32x4 g = gg[m][bj], t = tb[m][bj];
                    const f32x4 v0 = acc[ai][bj][m][0], v1 = acc[ai][bj][m][1]; u32x4 w;
                    w.x = pk_bf16(bflo(t.x) + v0[0] * bflo(g.x), bfhi(t.x) + v0[1] * bfhi(g.x)); w.y = pk_bf16(bflo(t.y) + v0[2] * bflo(g.y), bfhi(t.y) + v0[3] * bfhi(g.y));
                    w.z = pk_bf16(bflo(t.z) + v1[0] * bflo(g.z), bfhi(t.z) + v1[1] * bfhi(g.z)); w.w = pk_bf16(bflo(t.w) + v1[2] * bflo(g.w), bfhi(t.w) + v1[3] * bfhi(g.w));
                    *(u32x4*)(merged + row * 1024 + col) = w; } } }
    }
};
struct ListOrder { int pm0; unsigned list;
    __device__ __forceinline__ bool next(int i, Unit& u) const { const unsigned c = (i < 4) ? ((list >> (8 * i)) & 0xffu) : 0xffu; if (c == 0xffu) return false; u.pm = pm0 + (int)(c & 7u); u.pn = (int)(c >> 3); return true; }
    __device__ __forceinline__ void a_ready(const Unit&) const {} __device__ __forceinline__ void done(const Unit&) const {} };
struct DefOrder { pg8::StaticOrder base;
    __device__ __forceinline__ bool next(int i, Unit& u) const { if (!base.next(i, u)) return false; u.pm = (u.pm / 6) * 8 + (u.pm % 6); return true; }
    __device__ __forceinline__ void a_ready(const Unit&) const {} __device__ __forceinline__ void done(const Unit&) const {} };
__device__ __forceinline__ unsigned lo_code(int idx, int base) { return (unsigned)(((base + (idx >> 3)) << 3) | (idx & 7)); }
struct EpiOutNorm {
    static constexpr bool PERM = true, AFTER_DRAIN = true;
    const float* x; float* out; const float* fnw; float* xbuf; unsigned* cnt;
    __device__ __forceinline__ void operator()(const f32x4 (&)[2][2][4][2], const Unit&, int, int, int, int) const {}
    __device__ __forceinline__ void fused(f32x4 (&acc)[2][2][4][2], const Unit& u, int wr, int wc, int fr, int fq, PG8_LAS unsigned char* lds, int wid, int lane) const {
        const int row0 = u.pm * 256 + wr * 64 + fr, col0 = u.pn * 256 + wc * 32 + 8 * fq;
        LAS float* PS = (LAS float*)lds;
        LAS float* RS = (LAS float*)(lds + 4096);
#pragma unroll
        for (int ai = 0; ai < 2; ++ai)
#pragma unroll
            for (int mh = 0; mh < 2; ++mh) { f32x4 xv[2][2][2];
#pragma unroll
                for (int mm = 0; mm < 2; ++mm)
#pragma unroll
                    for (int bj = 0; bj < 2; ++bj) { const size_t o = (size_t)(row0 + ai * 128 + (2 * mh + mm) * 16) * 1024 + col0 + bj * 128; xv[mm][bj][0] = *(const f32x4*)(x + o); xv[mm][bj][1] = *(const f32x4*)(x + o + 4); }
#pragma unroll
                for (int mm = 0; mm < 2; ++mm) { const int m = 2 * mh + mm; float sq = 0.f;
#pragma unroll
                    for (int bj = 0; bj < 2; ++bj)
#pragma unroll
                        for (int n = 0; n < 2; ++n) { const f32x4 v = acc[ai][bj][m][n] + xv[mm][bj][n]; acc[ai][bj][m][n] = v; sq += (v[0] * v[0] + v[1] * v[1]) + (v[2] * v[2] + v[3] * v[3]); }
                    sq += __shfl_xor(sq, 16); sq += __shfl_xor(sq, 32);
                    if (fq == 0) PS[(ai * 128 + wr * 64 + m * 16 + fr) * 4 + wc] = sq; } }
        asm volatile("s_waitcnt lgkmcnt(0)" ::: "memory"); __builtin_amdgcn_s_barrier(); asm volatile("" ::: "memory");
        const int tid = wid * 64 + lane;
        if (tid < 256) { const f32x4 p = *(const LAS f32x4*)(PS + tid * 4);
            __hip_atomic_store(xbuf + (size_t)(u.pm * 256 + tid) * 4 + u.pn, (p[0] + p[1]) + (p[2] + p[3]), __ATOMIC_RELAXED, __HIP_MEMORY_SCOPE_AGENT); }
        asm volatile("s_waitcnt vmcnt(0)" ::: "memory"); __builtin_amdgcn_s_barrier(); asm volatile("" ::: "memory");
        if (tid == 0) {
            __hip_atomic_fetch_add(cnt + 64 * u.pm, 1u, __ATOMIC_RELAXED, __HIP_MEMORY_SCOPE_AGENT);
            unsigned sp = 0u; while (__hip_atomic_load(cnt + 64 * u.pm, __ATOMIC_RELAXED, __HIP_MEMORY_SCOPE_AGENT) < 4u) { __builtin_amdgcn_s_sleep(2); if (++sp > (1u << 22)) break; }
            __builtin_amdgcn_fence(__ATOMIC_ACQUIRE, "agent"); asm volatile("s_waitcnt vmcnt(0)" ::: "memory"); }
        __builtin_amdgcn_s_barrier(); asm volatile("" ::: "memory");
        if (tid < 256) { const float* sl = xbuf + (size_t)(u.pm * 256 + tid) * 4; float t = 0.f;
#pragma unroll
            for (int k = 0; k < 4; ++k) t += __hip_atomic_load(sl + k, __ATOMIC_RELAXED, __HIP_MEMORY_SCOPE_AGENT);
            RS[tid] = rsqrtf(t * (1.0f / 1024.0f) + NORM_EPS); }
        asm volatile("s_waitcnt vmcnt(0) lgkmcnt(0)" ::: "memory"); __builtin_amdgcn_s_barrier(); asm volatile("" ::: "memory");
        f32x4 wv[2][2];
#pragma unroll
        for (int bj = 0; bj < 2; ++bj) { wv[bj][0] = *(const f32x4*)(fnw + col0 + bj * 128); wv[bj][1] = *(const f32x4*)(fnw + col0 + bj * 128 + 4); }
#pragma unroll
        for (int ai = 0; ai < 2; ++ai)
#pragma unroll
            for (int m = 0; m < 4; ++m) { const int rl = ai * 128 + wr * 64 + m * 16 + fr; const float rs = RS[rl]; const size_t o = (size_t)(u.pm * 256 + rl) * 1024 + col0;
#pragma unroll
                for (int bj = 0; bj < 2; ++bj) { *(f32x4*)(out + o + bj * 128) = acc[ai][bj][m][0] * rs * wv[bj][0]; *(f32x4*)(out + o + bj * 128 + 4) = acc[ai][bj][m][1] * rs * wv[bj][1]; } }
    }
};

__device__ __forceinline__ int wt_row_of_col(int n) {
    if (n < 4096) return n;
    if (n >= 9216) return 4096 + (n - 9216);
    int a = n - 4096;
    if (a < 3072) { const int e = a & 63; a = (a - e) + (e < 32 ? 2 * e : 2 * (e - 32) + 1); }
    return 6144 + a;
}
template <bool MAP> __device__ __forceinline__ void p0_transpose_item(const float* W, int K, int N, u16* WT, LAS float* scr, int item, int lane) {
    const int nblk = N / 32, kb = item / nblk, nb = item % nblk, k0 = 64 * kb, n0 = 32 * nb;
    float tv[32];
#pragma unroll
    for (int i = 0; i < 32; ++i) tv[i] = W[(size_t)(k0 + 2 * i + (lane >> 5)) * N + n0 + (lane & 31)];
#pragma unroll
    for (int i = 0; i < 32; ++i) scr[(2 * i + (lane >> 5)) * 33 + (lane & 31)] = tv[i];
    asm volatile("s_waitcnt lgkmcnt(0)" ::: "memory");
    const int c = lane & 7;
#pragma unroll
    for (int j = 0; j < 4; ++j) { const int n = (lane >> 3) + 8 * j; const LAS float* s = scr + (8 * c) * 33 + n;
        u32x4 o; o.x = pk_bf16(s[0 * 33], s[1 * 33]); o.y = pk_bf16(s[2 * 33], s[3 * 33]); o.z = pk_bf16(s[4 * 33], s[5 * 33]); o.w = pk_bf16(s[6 * 33], s[7 * 33]);
        const int r = MAP ? wt_row_of_col(n0 + n) : (n0 + n);
        *(u32x4*)(WT + (size_t)r * K + k0 + 8 * c) = o; }
    asm volatile("s_waitcnt lgkmcnt(0)" ::: "memory");
}
struct Ptrs { const float* x; const int* pos; const float* norm_w; const float* w_in; const float* lbl; const float* hnw; const float* wa; const float* wb; const float* wo; const float* fnw; float* out; unsigned char* ws; };

__device__ __forceinline__ void p0_prologue(const Ptrs& P, LAS unsigned char* lds, int vcu, int G) {
    const int tid = threadIdx.x, lane = tid & 63, wave = __builtin_amdgcn_readfirstlane(tid >> 6);
    LAS float* scr = (LAS float*)(lds + wave * 16384);
    const int gw = vcu * 8 + wave, NGW = G * 8;
    constexpr int I_IN = 16 * (NIN / 32), I_A = 16 * 32, I_B = 8 * 32, I_O = 16 * 32, NITEMS = I_IN + I_A + I_B + I_O;
    for (int it = gw; it < NITEMS; it += NGW) {
        int r = it;
        if (r < I_IN) { p0_transpose_item<true>(P.w_in, 1024, NIN, (u16*)(P.ws + WS_WT), scr, r, lane); continue; } r -= I_IN;
        if (r < I_A) { p0_transpose_item<false>(P.wa, 1024, 1024, (u16*)(P.ws + WS_WA), scr, r, lane); continue; } r -= I_A;
        if (r < I_B) { p0_transpose_item<false>(P.wb, 512, 1024, (u16*)(P.ws + WS_WB), scr, r, lane); continue; } r -= I_B;
        p0_transpose_item<false>(P.wo, 1024, 1024, (u16*)(P.ws + WS_WO), scr, r, lane);
    }
    u16* H = (u16*)(P.ws + WS_H);
    for (int m = gw; m < TT; m += 2 * NGW) {
        const int m2 = (m + NGW < TT) ? m + NGW : m;
        const f32x4* xr = (const f32x4*)(P.x + (size_t)m * DM) + lane; const f32x4* xr2 = (const f32x4*)(P.x + (size_t)m2 * DM) + lane; f32x4 v[4], v2[4]; float s = 0.f, s2 = 0.f;
#pragma unroll
        for (int j = 0; j < 4; ++j) { v[j] = xr[64 * j]; v2[j] = xr2[64 * j]; }
#pragma unroll
        for (int j = 0; j < 4; ++j) { s += (v[j].x * v[j].x + v[j].y * v[j].y) + (v[j].z * v[j].z + v[j].w * v[j].w); s2 += (v2[j].x * v2[j].x + v2[j].y * v2[j].y) + (v2[j].z * v2[j].z + v2[j].w * v2[j].w); }
        const float rstd = rsqrtf(wave_sum(s) * (1.0f / DM) + NORM_EPS), rstd2 = rsqrtf(wave_sum(s2) * (1.0f / DM) + NORM_EPS);
        u32x2* o8 = (u32x2*)(H + (size_t)m * DM) + lane; u32x2* o82 = (u32x2*)(H + (size_t)m2 * DM) + lane;
#pragma unroll
        for (int j = 0; j < 4; ++j) { const f32x4 w4 = ((const f32x4*)P.norm_w)[lane + 64 * j];
            o8[64 * j] = (u32x2){pk_bf16(v[j].x * rstd * w4.x, v[j].y * rstd * w4.y), pk_bf16(v[j].z * rstd * w4.z, v[j].w * rstd * w4.w)};
            o82[64 * j] = (u32x2){pk_bf16(v2[j].x * rstd2 * w4.x, v2[j].y * rstd2 * w4.y), pk_bf16(v2[j].z * rstd2 * w4.z, v2[j].w * rstd2 * w4.w)}; }
    }
    float* cosT = (float*)(P.ws + WS_COS); float* sinT = (float*)(P.ws + WS_SIN);
    for (int e = (vcu * 512 + tid); e < TT * 32; e += G * 512) {
        const int row = e >> 5, j = e & 31;
        const float inv = exp2f(-(float)j * (13.287712379549449f / 32.0f));
        const float ang = (float)P.pos[row] * inv;
        const double rev = (double)ang * 0.15915494309189535; const float fr = (float)(rev - __builtin_rint(rev));
        cosT[e] = __builtin_amdgcn_cosf(fr); sinT[e] = __builtin_amdgcn_sinf(fr);
    }
}

#define LBAR() asm volatile("s_waitcnt lgkmcnt(0)\n\ts_barrier" ::: "memory")
__device__ __forceinline__ void attn_phase(LAS unsigned char* lds, const u16* ZB, u16* OG, float* LSE, int bid, int G) {
    const int tid = threadIdx.x, lane = tid & 63, w = __builtin_amdgcn_readfirstlane(tid >> 6), l15 = lane & 15, q4 = lane >> 4, sb = w >> 2, wq = w & 3;
    constexpr int KP = 72;
    LAS u16* KI = (LAS u16*)lds; LAS u16* VI = (LAS u16*)(lds + 384 * KP * 2);
    u32x4 kr[6], vr[6]; bf16x8 qn[2][2];
#define AT_DEC(un_) const int b_ = (un_) / 192, rem_ = (un_) % 192, g_ = rem_ >> 6, h_ = (rem_ >> 3) & 7, su_ = rem_ & 7; \
        const int d_ = (g_ == 0) ? 1 : (g_ == 1 ? 4 : 16); const size_t tb_ = (size_t)b_ * SEQ; \
        const int r0_ = (g_ == 0) ? 0 : (g_ == 1 ? (su_ >> 1) : 2 * su_), c0_ = (g_ == 0) ? 2 * su_ : (g_ == 1 ? 2 * (su_ & 1) : 0); \
        const int rq_ = (g_ == 2) ? r0_ + sb : r0_, cq_ = (g_ == 2) ? 0 : c0_ + sb;
#define AT_LOAD(un_) do { AT_DEC(un_) \
        _Pragma("unroll") for (int i = 0; i < 6; ++i) { const int id = tid + 512 * i, j = id >> 3, ch = id & 7; \
            const int mp = (g_ == 2) ? (j & 127) : 128 * (c0_ - 1) + j, rr = (g_ == 2) ? r0_ + (j >> 7) : r0_; \
            kr[i] = (u32x4){0u, 0u, 0u, 0u}; vr[i] = (u32x4){0u, 0u, 0u, 0u}; \
            if (mp >= 0 && (g_ != 2 || j < 256)) { const size_t tk_ = tb_ + (size_t)mp * d_ + rr; kr[i] = *(const u32x4*)(ZB + ((size_t)(24 + g_ * 8 + h_) * TT + tk_) * 64 + 8 * ch); vr[i] = *(const u32x4*)(ZB + ((size_t)(48 + g_ * 8 + h_) * TT + tk_) * 64 + 8 * ch); } } \
        _Pragma("unroll") for (int qt = 0; qt < 2; ++qt) { const size_t tq_ = tb_ + (size_t)(128 * cq_ + 32 * wq + 16 * qt + l15) * d_ + rq_; \
            _Pragma("unroll") for (int ds = 0; ds < 2; ++ds) qn[qt][ds] = *(const bf16x8*)(ZB + ((size_t)(g_ * 8 + h_) * TT + tq_) * 64 + 32 * ds + 8 * q4); } } while (0)
    const bool xl = (G == 256); const int ustep = xl ? 32 : G, ubase = xl ? (bid & 7) * 192 : 0, ulim = xl ? ubase + 192 : 1536;
    { const int u0 = ubase + (xl ? (bid >> 3) : bid); AT_LOAD((u0 < ulim ? u0 : ulim - 1)); }
    for (int un = ubase + (xl ? (bid >> 3) : bid); un < ulim; un += ustep) {
        AT_DEC(un)
        const int g = g_, h = h_; const bool prev_ok = (g_ != 2) && (cq_ > 0); const int wbase = (g_ == 2) ? 128 * sb - 128 : 128 * sb;
        size_t tq[2];
#pragma unroll
        for (int qt = 0; qt < 2; ++qt) tq[qt] = tb_ + (size_t)(128 * cq_ + 32 * wq + 16 * qt + l15) * d_ + rq_;
#pragma unroll
        for (int i = 0; i < 6; ++i) { const int id = tid + 512 * i, j = id >> 3, ch = id & 7; *(LAS u32x4*)(KI + j * KP + 8 * ch) = kr[i]; *(LAS u32x4*)(VI + j * KP + 8 * ch) = vr[i]; }
        bf16x8 qf[2][2];
#pragma unroll
        for (int qt = 0; qt < 2; ++qt) { qf[qt][0] = qn[qt][0]; qf[qt][1] = qn[qt][1]; }
        LBAR();
        { const int nx = (un + ustep < ulim) ? un + ustep : un; AT_LOAD(nx); }
        f32x4 st[5][2][2]; float mx[2] = {-INFINITY, -INFINITY};
#pragma unroll
        for (int p = 0; p < 5; ++p) { const int a = wq + p; const bool on = prev_ok || a >= 4;
#pragma unroll
            for (int t = 0; t < 2; ++t) {
                if (on) { const int j0 = 32 * a + 16 * t, k = 2 * p + t; f32x4 s0 = (f32x4){0.f, 0.f, 0.f, 0.f}, s1 = (f32x4){0.f, 0.f, 0.f, 0.f};
#pragma unroll
                    for (int ds = 0; ds < 2; ++ds) { const bf16x8 kf = *(const LAS bf16x8*)(KI + (wbase + j0 + l15) * KP + 32 * ds + 8 * q4); if (k <= 8) s0 = mfma16(kf, qf[0][ds], s0); if (k >= 1) s1 = mfma16(kf, qf[1][ds], s1); }
#pragma unroll
                    for (int i = 0; i < 4; ++i) { const int kk = 4 * q4 + i;
                        if (k == 0) s0[i] = (kk >= l15) ? s0[i] : -INFINITY; if (k == 8) s0[i] = (kk <= l15) ? s0[i] : -INFINITY; if (k == 9) s0[i] = -INFINITY;
                        if (k == 1) s1[i] = (kk >= l15) ? s1[i] : -INFINITY; if (k == 9) s1[i] = (kk <= l15) ? s1[i] : -INFINITY; if (k == 0) s1[i] = -INFINITY;
                        mx[0] = fmaxf(mx[0], s0[i]); mx[1] = fmaxf(mx[1], s1[i]); }
                    st[p][t][0] = s0; st[p][t][1] = s1;
                } else { st[p][t][0] = (f32x4){-INFINITY, -INFINITY, -INFINITY, -INFINITY}; st[p][t][1] = st[p][t][0]; } } }
        float l[2] = {0.f, 0.f}; bf16x8 pf[5][2];
#pragma unroll
        for (int qt = 0; qt < 2; ++qt) { mx[qt] = fmaxf(mx[qt], __shfl_xor(mx[qt], 16)); mx[qt] = fmaxf(mx[qt], __shfl_xor(mx[qt], 32)); }
#pragma unroll
        for (int p = 0; p < 5; ++p)
#pragma unroll
            for (int qt = 0; qt < 2; ++qt) { float e[8];
#pragma unroll
                for (int t = 0; t < 2; ++t)
#pragma unroll
                    for (int i = 0; i < 4; ++i) { e[4 * t + i] = __builtin_amdgcn_exp2f(st[p][t][qt][i] - mx[qt]); l[qt] += e[4 * t + i]; }
                u32x4 pw; pw.x = pk_bf16(e[0], e[1]); pw.y = pk_bf16(e[2], e[3]); pw.z = pk_bf16(e[4], e[5]); pw.w = pk_bf16(e[6], e[7]); pf[p][qt] = __builtin_bit_cast(bf16x8, pw); }
#pragma unroll
        for (int qt = 0; qt < 2; ++qt) { l[qt] += __shfl_xor(l[qt], 16); l[qt] += __shfl_xor(l[qt], 32); }
        f32x4 o[4][2];
#pragma unroll
        for (int dt = 0; dt < 4; ++dt) { o[dt][0] = (f32x4){0.f, 0.f, 0.f, 0.f}; o[dt][1] = (f32x4){0.f, 0.f, 0.f, 0.f}; }
#pragma unroll
        for (int p = 0; p < 5; ++p) { const int a = wq + p; const bool on = prev_ok || a >= 4;
            if (on) {
#pragma unroll
                for (int dt = 0; dt < 4; ++dt) { const LAS u16* vp = VI + (wbase + 32 * a + 4 * q4 + (l15 >> 2)) * KP + 16 * dt + 4 * (l15 & 3);
                    const s16x4 lo = ds_tr(vp), hi = ds_tr(vp + 16 * KP); const bf16x8 vf = cat8(lo, hi); o[dt][0] = mfma16(vf, pf[p][0], o[dt][0]); o[dt][1] = mfma16(vf, pf[p][1], o[dt][1]); } } }
        LAS u16* stg = (LAS u16*)(lds + 2 * 384 * KP * 2 + w * 4608);
#pragma unroll
        for (int qt = 0; qt < 2; ++qt) { const float il = 1.0f / l[qt];
#pragma unroll
            for (int dt = 0; dt < 4; ++dt) *(LAS u32x2*)(stg + (16 * qt + l15) * 72 + 16 * dt + 4 * q4) = (u32x2){pk_bf16(o[dt][qt][0] * il, o[dt][qt][1] * il), pk_bf16(o[dt][qt][2] * il, o[dt][qt][3] * il)};
            if (q4 == 0) LSE[(size_t)g * TT * 8 + tq[qt] * 8 + h] = mx[qt] + __log2f(l[qt]); }
        asm volatile("s_waitcnt lgkmcnt(0)" ::: "memory");
#pragma unroll
        for (int i = 0; i < 4; ++i) { const int row = i * 8 + (lane >> 3), ch = lane & 7; const u32x4 v = *(const LAS u32x4*)(stg + row * 72 + 8 * ch);
            const size_t tr = tb_ + (size_t)(128 * cq_ + 32 * wq + row) * d_ + rq_;
            *(u32x4*)(OG + (size_t)g * TT * 512 + tr * 512 + h * 64 + 8 * ch) = v; }
        LBAR();
    }
#undef AT_DEC
#undef AT_LOAD
}
__device__ __forceinline__ void merge_phase(u16* OG, const float* LSE, const u16* AG, int bid, int nb) {
    for (int idx = bid * 512 + threadIdx.x; idx < TT * 64; idx += nb * 512) {
        const int tok = idx >> 6, h = (idx >> 3) & 7, ch = idx & 7; const size_t off = (size_t)tok * 512 + h * 64 + 8 * ch;
        const float l0 = LSE[(size_t)tok * 8 + h], l1 = LSE[(size_t)TT * 8 + (size_t)tok * 8 + h], l2 = LSE[(size_t)2 * TT * 8 + (size_t)tok * 8 + h];
        const float m = fmaxf(l0, fmaxf(l1, l2)); float w0 = __builtin_amdgcn_exp2f(l0 - m), w1 = __builtin_amdgcn_exp2f(l1 - m), w2 = __builtin_amdgcn_exp2f(l2 - m);
        const float inv = 1.0f / (w0 + w1 + w2); w0 *= inv; w1 *= inv; w2 *= inv;
        const u32x4 a = *(const u32x4*)(OG + off), bq = *(const u32x4*)(OG + (size_t)TT * 512 + off), cq = *(const u32x4*)(OG + (size_t)2 * TT * 512 + off), gq = *(const u32x4*)(AG + off);
        u32x4 o;
#define MRG(F) o.F = pk_bf16((w0 * bflo(a.F) + w1 * bflo(bq.F) + w2 * bflo(cq.F)) * bflo(gq.F), (w0 * bfhi(a.F) + w1 * bfhi(bq.F) + w2 * bfhi(cq.F)) * bfhi(gq.F))
        MRG(x); MRG(y); MRG(z); MRG(w);
#undef MRG
        store16_wt(OG + off, o);
    }
}

template <int MODE = 0> __device__ __forceinline__ void hgrn_unit(LAS unsigned char* lds, int b, int h, const u16* QA, const u16* GG, const u16* VA, const u16* HG, const float* nw, u16* OA, unsigned* dcnt) {
    const int tid = threadIdx.x, lane = tid & 63, w = __builtin_amdgcn_readfirstlane(tid >> 6), l15 = lane & 15, q4 = lane >> 4;
    constexpr int P = 136, IMGB = 52224;
    LAS u16* SB = (LAS u16*)(lds + 104448); LAS float* TOT = (LAS float*)(lds + 139264); LAS float* DFB = (LAS float*)(lds + 143360); LAS float* SSQ = (LAS float*)(lds + 146432);
    f32x4 S[8];
#pragma unroll
    for (int i = 0; i < 8; ++i) S[i] = (f32x4){0.f, 0.f, 0.f, 0.f};
    const int kp = lane, seg = w, tt = (w < 4) ? (w >> 1) : 3 - ((w - 4) >> 1), vh = w & 1;
    const size_t tok0 = (size_t)b * SEQ, hbase = (size_t)(b * 8 + h) * SEQ;
    unsigned gq0[8], qq0[8], gq1[8], qq1[8]; u32x4 vv0[2], vv1[2]; u32x2 hg0[4], hg1[4];
    f32x4 O[4]; float sqp = 0.f;
#pragma unroll
    for (int j = 0; j < 4; ++j) O[j] = (f32x4){0.f, 0.f, 0.f, 0.f};
#define HG_LOAD(c, gq, qq, vv) do { const size_t t0_ = tok0 + 64 * (c); \
        const size_t hb_ = hbase + 64 * (c); \
        _Pragma("unroll") for (int i = 0; i < 8; ++i) { const size_t o_ = (t0_ + 8 * seg + i) * 1024 + h * 128 + 2 * kp; gq[i] = *(const unsigned*)(GG + (hb_ + 8 * seg + i) * 128 + 2 * kp); qq[i] = *(const unsigned*)(QA + o_); } \
        _Pragma("unroll") for (int u_ = 0; u_ < 2; ++u_) { const int id_ = tid + 512 * u_; vv[u_] = *(const u32x4*)(VA + (hb_ + (id_ >> 4)) * 128 + 8 * (id_ & 15)); } } while (0)
#define HG_LOADG(c, hgv) do { const size_t tq_ = hbase + 64 * (c) + 16 * tt + l15; \
        _Pragma("unroll") for (int j = 0; j < 4; ++j) hgv[j] = *(const u32x2*)(HG + tq_ * 128 + 16 * (4 * vh + j) + 4 * q4); } while (0)
#define HG_PREP1(gq) do { float r0_ = 1.f, r1_ = 1.f; \
        _Pragma("unroll") for (int i = 0; i < 8; ++i) { r0_ *= f16lo(gq[i]); r1_ *= f16hi(gq[i]); } \
        *(LAS f32x2*)(TOT + seg * 128 + 2 * kp) = (f32x2){__log2f(r0_), __log2f(r1_)}; } while (0)
#define HG_PREP2(buf, gq, qq, vv) do { LAS u16* QM_ = (LAS u16*)(lds + (buf) * IMGB); LAS u16* KM_ = (LAS u16*)(lds + (buf) * IMGB + 17408); LAS u16* VI_ = (LAS u16*)(lds + (buf) * IMGB + 34816); LAS float* DF_ = DFB + (buf) * 384; \
        float off0 = 0.f, off1 = 0.f, br0 = 0.f, br1 = 0.f, bl0 = 0.f, bl1 = 0.f; \
        _Pragma("unroll") for (int s2 = 0; s2 < 8; ++s2) { const f32x2 t_ = *(const LAS f32x2*)(TOT + s2 * 128 + 2 * kp); \
            if (s2 < seg) { off0 += t_.x; off1 += t_.y; } if (s2 < 4) { br0 += t_.x; br1 += t_.y; } bl0 += t_.x; bl1 += t_.y; } \
        off0 -= br0; off1 -= br1; \
        float E0 = __builtin_amdgcn_exp2f(fminf(off0, 115.f)), E1 = __builtin_amdgcn_exp2f(fminf(off1, 115.f)), I0 = __builtin_amdgcn_exp2f(fminf(-off0, 115.f)), I1 = __builtin_amdgcn_exp2f(fminf(-off1, 115.f)); \
        _Pragma("unroll") for (int i = 0; i < 8; ++i) { const int s_ = 8 * seg + i; const float f0_ = f16lo(gq[i]), f1_ = f16hi(gq[i]); \
            E0 *= f0_; E1 *= f1_; I0 *= __builtin_amdgcn_rcpf(f0_); I1 *= __builtin_amdgcn_rcpf(f1_); \
            *(LAS unsigned*)(QM_ + s_ * P + 2 * kp) = pk_bf16(bflo(qq[i]) * E0, bfhi(qq[i]) * E1); \
            *(LAS unsigned*)(KM_ + s_ * P + 2 * kp) = pk_bf16((1.0f - f0_) * I0, (1.0f - f1_) * I1); } \
        if (seg == 0) { *(LAS f32x2*)(DF_ + 2 * kp) = (f32x2){__builtin_amdgcn_exp2f(bl0), __builtin_amdgcn_exp2f(bl1)}; *(LAS f32x2*)(DF_ + 128 + 2 * kp) = (f32x2){__builtin_amdgcn_exp2f(bl0 - br0), __builtin_amdgcn_exp2f(bl1 - br1)}; *(LAS f32x2*)(DF_ + 256 + 2 * kp) = (f32x2){__builtin_amdgcn_exp2f(br0), __builtin_amdgcn_exp2f(br1)}; } \
        _Pragma("unroll") for (int u_ = 0; u_ < 2; ++u_) { const int id_ = tid + 512 * u_; *(LAS u32x4*)(VI_ + (id_ >> 4) * P + 8 * (id_ & 15)) = vv[u_]; } } while (0)
#define HG_STAGE(hgv) do { \
        _Pragma("unroll") for (int j = 0; j < 4; ++j) { const f32x4 n4 = nwv[j]; const int row_ = 16 * tt + l15, c16_ = 2 * (4 * vh + j) + (q4 >> 1); \
            *(LAS u32x2*)(STG + row_ * 256 + ((c16_ ^ l15) << 4) + 8 * (q4 & 1)) = (u32x2){pk_bf16(O[j][0] * n4[0] * bflo(hgv[j].x), O[j][1] * n4[1] * bfhi(hgv[j].x)), \
                                                                                         pk_bf16(O[j][2] * n4[2] * bflo(hgv[j].y), O[j][3] * n4[3] * bfhi(hgv[j].y))}; } } while (0)
#define HG_COPY(c) do { \
        _Pragma("unroll") for (int u_ = 0; u_ < 2; ++u_) { const int id_ = tid + 512 * u_, row_ = id_ >> 4, ch_ = id_ & 15; \
            const float sc_ = rsqrtf((SSQ[((row_ >> 4) * 2) * 16 + (row_ & 15)] + SSQ[((row_ >> 4) * 2 + 1) * 16 + (row_ & 15)]) * (1.0f / 128.0f) + NORM_EPS); \
            const u32x4 v_ = *(const LAS u32x4*)(STG + row_ * 256 + ((ch_ ^ (row_ & 15)) << 4)); u32x4 o_; \
            o_.x = pk_bf16(bflo(v_.x) * sc_, bfhi(v_.x) * sc_); o_.y = pk_bf16(bflo(v_.y) * sc_, bfhi(v_.y) * sc_); o_.z = pk_bf16(bflo(v_.z) * sc_, bfhi(v_.z) * sc_); o_.w = pk_bf16(bflo(v_.w) * sc_, bfhi(v_.w) * sc_); \
            if (MODE & 8) { dacc_ ^= o_.x ^ o_.w; } else *(u32x4*)(OA + (tok0 + 64 * (c) + row_) * 1024 + h * 128 + 8 * ch_) = o_; } } while (0)
    unsigned dacc_ = 0u;
    LAS unsigned char* STG = lds + 146944;
    f32x4 nwv[4];
#pragma unroll
    for (int j = 0; j < 4; ++j) nwv[j] = *(const f32x4*)(nw + 16 * (4 * vh + j) + 4 * q4);
    HG_LOAD(0, gq0, qq0, vv0); HG_LOADG(0, hg0); HG_LOADG(0, hg1); if (tid < 128) SSQ[tid] = 1.0f; HG_PREP1(gq0); LBAR(); HG_PREP2(0, gq0, qq0, vv0);
    for (int i = tid; i < 128 * P / 2; i += 512) ((LAS unsigned*)SB)[i] = 0u;
    HG_LOAD(1, gq1, qq1, vv1); HG_LOAD(2, gq0, qq0, vv0); LBAR(); HG_PREP1(gq1); LBAR();
#ifdef PROBE_ACC
    unsigned tacc_ = 0u, tlast_ = (unsigned)__builtin_amdgcn_s_memrealtime();
#define HG_T(k) do { if (blockIdx.x == 0 && tid == 448) { const unsigned n_ = (unsigned)__builtin_amdgcn_s_memrealtime(); if ((k) == PROBE_ACC) tacc_ += n_ - tlast_; tlast_ = n_; } } while (0)
#else
#define HG_T(k) do {} while (0)
#endif
#define HG_STEP(c, G2, Q2, V2, G1, HGU, HGL) do { HG_T(2); \
        const int cur = (c) & 1, nxt = cur ^ 1; \
        const LAS u16* QM = (const LAS u16*)(lds + cur * IMGB); const LAS u16* KM = (const LAS u16*)(lds + cur * IMGB + 17408); const LAS u16* VI = (const LAS u16*)(lds + cur * IMGB + 34816); const LAS float* DF = DFB + cur * 384; \
        if (!(MODE & 4)) HG_COPY(((c) > 0 ? (c) - 1 : 0)); \
        if (!(MODE & 2)) HG_PREP2(nxt, G2, Q2, V2); HG_LOADG(((c) + 1 < 32 ? (c) + 1 : 31), HGL); \
        HG_LOAD(((c) + 3 < 32 ? (c) + 3 : 31), G2, Q2, V2); HG_T(0); \
        if (!(MODE & 1)) { \
        bf16x8 qm[4]; \
        _Pragma("unroll") for (int ks = 0; ks < 4; ++ks) qm[ks] = *(const LAS bf16x8*)(QM + (16 * tt + l15) * P + 32 * ks + 8 * q4); \
        f32x4 Dm[4]; \
        _Pragma("unroll") for (int st = 0; st < 4; ++st) { Dm[st] = (f32x4){0.f, 0.f, 0.f, 0.f}; \
            _Pragma("unroll") for (int ks = 0; ks < 4; ++ks) { const bf16x8 kf = *(const LAS bf16x8*)(KM + (16 * st + l15) * P + 32 * ks + 8 * q4); Dm[st] = mfma16(kf, qm[ks], Dm[st]); } \
            _Pragma("unroll") for (int i = 0; i < 4; ++i) { const bool keep_ = (st < tt) || (st == tt && 4 * q4 + i <= l15); Dm[st][i] = keep_ ? Dm[st][i] : 0.f; } } \
        bf16x8 pf[2]; \
        _Pragma("unroll") for (int a = 0; a < 2; ++a) { u32x4 pw; pw.x = pk_bf16(Dm[2 * a][0], Dm[2 * a][1]); pw.y = pk_bf16(Dm[2 * a][2], Dm[2 * a][3]); pw.z = pk_bf16(Dm[2 * a + 1][0], Dm[2 * a + 1][1]); pw.w = pk_bf16(Dm[2 * a + 1][2], Dm[2 * a + 1][3]); pf[a] = __builtin_bit_cast(bf16x8, pw); } \
        _Pragma("unroll") for (int j = 0; j < 4; ++j) { const int vt = 4 * vh + j; f32x4 o = (f32x4){0.f, 0.f, 0.f, 0.f}; \
            _Pragma("unroll") for (int a = 0; a < 2; ++a) { const LAS u16* vp = VI + (32 * a + 4 * q4 + (l15 >> 2)) * P + 16 * vt + 4 * (l15 & 3); \
                const s16x4 lo = ds_tr(vp), hi = ds_tr(vp + 16 * P); o = mfma16(cat8(lo, hi), pf[a], o); } \
            _Pragma("unroll") for (int ks = 0; ks < 4; ++ks) { const bf16x8 sf = *(const LAS bf16x8*)(SB + (16 * vt + l15) * P + 32 * ks + 8 * q4); o = mfma16(sf, qm[ks], o); } \
            O[j] = o; } \
        { bf16x8 ka[2]; \
            _Pragma("unroll") for (int a = 0; a < 2; ++a) { const LAS u16* kpp = KM + (32 * a + 8 * q4 + (l15 >> 2)) * P + 16 * w + 4 * (l15 & 3); const s16x4 lo = ds_tr(kpp), hi = ds_tr(kpp + 4 * P); ka[a] = cat8(lo, hi); } \
            const f32x4 d1 = *(const LAS f32x4*)(DF + 16 * w + 4 * q4), d2 = *(const LAS f32x4*)(DF + 128 + 16 * w + 4 * q4); \
            _Pragma("unroll") for (int vt = 0; vt < 8; ++vt) { f32x4 U = (f32x4){0.f, 0.f, 0.f, 0.f}; \
                _Pragma("unroll") for (int a = 0; a < 2; ++a) { const LAS u16* vp = VI + (32 * a + 8 * q4 + (l15 >> 2)) * P + 16 * vt + 4 * (l15 & 3); const s16x4 lo = ds_tr(vp), hi = ds_tr(vp + 4 * P); U = mfma16(ka[a], cat8(lo, hi), U); } \
                S[vt] = d1 * S[vt] + d2 * U; } } \
        { float sq = 0.f; \
            _Pragma("unroll") for (int j = 0; j < 4; ++j) sq += (O[j][0] * O[j][0] + O[j][1] * O[j][1]) + (O[j][2] * O[j][2] + O[j][3] * O[j][3]); \
            sq += __shfl_xor(sq, 16); sq += __shfl_xor(sq, 32); sqp = sq; } } \
        HG_T(1); \
        LBAR(); HG_T(2); \
        { const f32x4 eb = *(const LAS f32x4*)(DFB + nxt * 384 + 256 + 16 * w + 4 * q4); \
            _Pragma("unroll") for (int vt = 0; vt < 8; ++vt) *(LAS u32x2*)(SB + (16 * vt + l15) * P + 16 * w + 4 * q4) = (u32x2){pk_bf16(S[vt][0] * eb[0], S[vt][1] * eb[1]), pk_bf16(S[vt][2] * eb[2], S[vt][3] * eb[3])}; } \
        if (q4 == 0) SSQ[(tt * 2 + vh) * 16 + l15] = sqp; \
        if (!(MODE & 4)) HG_STAGE(HGU); \
        if (!(MODE & 2)) HG_PREP1(G1); HG_T(3); \
        LBAR(); } while (0)
    for (int c = 0; c < 32; c += 2) {
        if (c == 20 && dcnt) {
            if (tid == 0) { unsigned sp = 0u;
                while (__hip_atomic_load(dcnt + 64 * (8 * b + 6), __ATOMIC_RELAXED, __HIP_MEMORY_SCOPE_AGENT) < 16u || __hip_atomic_load(dcnt + 64 * (8 * b + 7), __ATOMIC_RELAXED, __HIP_MEMORY_SCOPE_AGENT) < 16u) { __builtin_amdgcn_s_sleep(2); if (++sp > (1u << 22)) break; }
                __builtin_amdgcn_fence(__ATOMIC_ACQUIRE, "agent"); asm volatile("s_waitcnt vmcnt(0)" ::: "memory"); }
            LBAR(); }
        HG_STEP(c, gq1, qq1, vv1, gq0, hg0, hg1);
        HG_STEP(c + 1, gq0, qq0, vv0, gq1, hg1, hg0);
    }
    HG_COPY(31);
    if (MODE & 8) { if (dacc_ == 0x12345678u) OA[tid] = (u16)dacc_; }
#ifdef PROBE_ACC
    if (blockIdx.x == 0 && tid == 448) ((LAS unsigned long long*)(lds + 163344))[10] = (unsigned long long)tacc_;
#endif
#undef HG_STEP
#undef HG_LOAD
#undef HG_LOADG
#undef HG_PREP1
#undef HG_PREP2
#undef HG_STAGE
#undef HG_COPY
    LBAR();
}

#define XB_TMO      128
#define XB_XCNT(j)  (256  + 64 * (j))
#define XB_XSUB(j)  (1280 + 64 * (j))
#define XB_XGEN(j)  (2304 + 64 * (j))
#define XB_TOP      3328
#define XB_TOPGEN   3392
#define XCD_BAR_WORDS 3456
#define XB_SPIN_CAP (1u << 18)

__device__ __forceinline__ unsigned xb_ld(unsigned* p)              { return __hip_atomic_load(p, __ATOMIC_RELAXED, __HIP_MEMORY_SCOPE_AGENT); }
__device__ __forceinline__ unsigned xb_add(unsigned* p, unsigned v) { return __hip_atomic_fetch_add(p, v, __ATOMIC_RELAXED, __HIP_MEMORY_SCOPE_AGENT); }
__device__ __forceinline__ unsigned xb_xcc_id() { return (unsigned)__builtin_amdgcn_s_getreg((3 << 11) | 20) & 0xFu; }
#define XB_SPIN(cond, bar) do { unsigned _sp = 0; while (cond) { __builtin_amdgcn_s_sleep(1); \
    if ((++_sp & 255u) == 0u) { if (xb_ld(&(bar)[XB_TMO])) break; if (_sp > XB_SPIN_CAP) { atomicAdd(&(bar)[XB_TMO], 1u); break; } } } } while (0)

struct XcdBarrier {
    unsigned* bar; unsigned x;
    volatile LAS unsigned* st;
};

__device__ __forceinline__ XcdBarrier xcd_barrier_post(unsigned* bar, volatile LAS unsigned* st) {
    XcdBarrier b; b.bar = bar; b.x = xb_xcc_id(); b.st = st;
    if (threadIdx.x == 0) (void)xb_add(&bar[XB_XCNT(b.x)], 1u);
    return b;
}
__device__ __forceinline__ void xcd_barrier_complete(unsigned* bar, unsigned x, unsigned& nloc, unsigned& nx) {
    const unsigned G = gridDim.x * gridDim.y * gridDim.z;
    unsigned sum, cnt, mine, sp = 0u;
    for (;;) {
        sum = 0u; cnt = 0u; mine = 0u;
#pragma unroll
        for (unsigned j = 0; j < 16; ++j) { const unsigned c = xb_ld(&bar[XB_XCNT(j)]); sum += c; cnt += (c > 0u) ? 1u : 0u; mine = (j == x) ? c : mine; }
        if (sum == G) break;
        __builtin_amdgcn_s_sleep(1);
        if ((++sp & 255u) == 0u) { if (xb_ld(&bar[XB_TMO])) break; if (sp > XB_SPIN_CAP) { atomicAdd(&bar[XB_TMO], 1u); break; } }
    }
    nloc = mine > 0u ? mine : 1u; nx = cnt > 0u ? cnt : 1u;
}

__device__ __forceinline__ void xcd_barrier(const XcdBarrier& b) {
    asm volatile("s_waitcnt vmcnt(0)" ::: "memory");
    __syncthreads();
    if (threadIdx.x == 0) {
        unsigned* bar = b.bar;
        __builtin_amdgcn_s_waitcnt(0);
        unsigned nloc = b.st[0], nx = b.st[1];
        if (nloc == 0u) { xcd_barrier_complete(bar, b.x, nloc, nx); b.st[0] = nloc; b.st[1] = nx; }
        const unsigned old = xb_add(&bar[XB_XSUB(b.x)], 1u);
        const unsigned gen = old / nloc;
        if (old + 1u == (gen + 1u) * nloc) {
            __builtin_amdgcn_fence(__ATOMIC_RELEASE, "agent");
            asm volatile("s_waitcnt vmcnt(0)" ::: "memory");
            const unsigned og = xb_add(&bar[XB_TOP], 1u);
            const unsigned tg = og / nx;
            if (og + 1u == (tg + 1u) * nx) xb_add(&bar[XB_TOPGEN], 1u);
            else XB_SPIN(xb_ld(&bar[XB_TOPGEN]) == tg, bar);
            __builtin_amdgcn_fence(__ATOMIC_ACQUIRE, "agent");
            xb_add(&bar[XB_XGEN(b.x)], 1u);
            asm volatile("s_waitcnt vmcnt(0)" ::: "memory");
        } else {
            XB_SPIN(xb_ld(&bar[XB_XGEN(b.x)]) == gen, bar);
            __builtin_amdgcn_fence(__ATOMIC_ACQUIRE, "agent");
            asm volatile("s_waitcnt vmcnt(0)" ::: "memory");
        }
    }
    __syncthreads();
}

struct Args { const float* in[10]; float* out; unsigned char* ws; int ph_lo, ph_hi; };
__global__ void __launch_bounds__(512, 2) fwd_megakernel(Args a) {
    extern __shared__ __attribute__((aligned(16))) unsigned char lds_raw[];
    LAS unsigned char* lds = (LAS unsigned char*)lds_raw;
    cg::grid_group grid = cg::this_grid();
    const int G = gridDim.x, bx = blockIdx.x, vcu = (G % 8 == 0) ? (bx % 8) * (G / 8) + bx / 8 : bx;
    const int tid = threadIdx.x, lane = tid & 63, wave = __builtin_amdgcn_readfirstlane(tid >> 6);
    Ptrs P; P.x = a.in[0]; P.pos = (const int*)a.in[1]; P.norm_w = a.in[2]; P.w_in = a.in[3]; P.lbl = a.in[4]; P.hnw = a.in[5]; P.wa = a.in[6]; P.wb = a.in[7]; P.wo = a.in[8]; P.fnw = a.in[9];
    P.out = a.out; P.ws = a.ws;
    unsigned char* ws = a.ws; unsigned char* dout = (unsigned char*)a.out;
    const int lo = a.ph_lo, hi = a.ph_hi;
#ifndef REP_MASK
#define REP_MASK 0
#endif
#define IN(k) (lo <= (k) && (k) < hi)
#define REPS(k) for (int rep_ = 0; rep_ < 1 + ((REP_MASK >> (k)) & 1); ++rep_)
#ifdef PROBE_K
#ifndef PROBE_A
#define PROBE_A PROBE_K
#define PROBE_B (PROBE_K + 1)
#endif
#define STAMP(k) do { if (bx == 0 && tid == 0) ((LAS unsigned long long*)(lds + 163344))[k] = __builtin_amdgcn_s_memrealtime(); } while (0)
#else
#define STAMP(k) do {} while (0)
#endif
#define SEAM(k) do { if (IN(k) && IN((k) + 1)) xcd_barrier(bar); STAMP((k) + 1); } while (0)
    if (tid < 4) ((LAS unsigned*)(lds + 163328))[tid] = 0u;
    __syncthreads();
    const XcdBarrier bar = xcd_barrier_post((unsigned*)(ws + WS_BAR), (volatile LAS unsigned*)(lds + 163328));
    if (a.ph_hi > 1000) grid.sync();
    STAMP(0);
    if (IN(0)) REPS(0) p0_prologue(P, lds, vcu, G);
    SEAM(0);
#ifdef EXTRA_SYNCS
    for (int i_ = 0; i_ < EXTRA_SYNCS; ++i_) xcd_barrier(bar);
#endif
    if (IN(1)) REPS(1) { pg8::Gemm g{(const u16*)(ws + WS_H), (const u16*)(ws + WS_WT) + (size_t)6144 * 1024, TT, 5120, 1024}; pg8::StaticOrder S; S.init(TT, 5120, G, bx);
        EpiZ E{0, ws, dout, P.lbl}; pg8::gemm_phase<EpiZ, pg8::StaticOrder, true, true>(lds, g, S, E); }
    SEAM(1);
    if (IN(2)) REPS(2) attn_phase(lds, (const u16*)(ws + WS_Z), (u16*)(dout + DO_OG), (float*)(ws + WS_COS), bx, G);
    SEAM(2);
    if (IN(3)) {
        pg8::Gemm g{(const u16*)(ws + WS_H), (const u16*)(ws + WS_WT), TT, 4096, 1024}; DefOrder S; S.base.init(48 * 256, 4096, G, bx);
        EpiZ E{1, ws, dout, P.lbl}; pg8::gemm_phase<EpiZ, DefOrder, true, true>(lds, g, S, E); }
    SEAM(3);
    if (IN(4)) {
        {
            if (bx < 64) { hgrn_unit(lds, bx >> 3, bx & 7, (const u16*)(ws + Z_QA), (const u16*)(ws + Z_G), (const u16*)(ws + Z_VA), (const u16*)(ws + Z_HG), P.hnw, (u16*)(ws + Z_QA), (unsigned*)(ws + WS_BAR + 36864)); STAMP(9);
            }
            else { const int x = bx & 7, r = (bx >> 3) - 8;
                const pg8::Gemm gG{(const u16*)(ws + WS_H), (const u16*)(ws + WS_WT) + (size_t)4096 * 1024, TT, 2048, 1024}; const pg8::Gemm gB{(const u16*)(dout + DO_OG), (const u16*)(ws + WS_WB), TT, 1024, 512};
                const EpiZ EG{2, ws, dout, P.lbl}; const EpiGateB EB{(const u16*)(ws + Z_GATES), (u16*)(dout + DO_TMPB)};
                unsigned lg, lb2;
                if (r < 8) { lg = lo_code(r, 4) | (lo_code(r + 24, 4) << 8) | 0xffff0000u; lb2 = lo_code(r, 0) | (lo_code(r + 24, 0) << 8) | 0xffff0000u; }
                else { lg = lo_code(r, 4) | (lo_code(2 * (r - 8), 0) << 8) | (lo_code(2 * (r - 8) + 1, 0) << 16) | 0xff000000u; lb2 = lo_code(r, 0) | 0xffffff00u; }
                unsigned* mcnt = (unsigned*)(ws + WS_BAR + 16384 + 64 * 64 * 4);
                unsigned* dcnt = (unsigned*)(ws + WS_BAR + 36864);
                { unsigned ld; if (r < 8) ld = (unsigned)(((2 * r) << 3) | 6) | ((unsigned)(((2 * r + 1) << 3) | 6) << 8) | 0xffff0000u; else ld = (unsigned)(((r - 8) << 3) | 7) | 0xffffff00u;
                  const pg8::Gemm gD{(const u16*)(ws + WS_H), (const u16*)(ws + WS_WT), TT, 4096, 1024}; const EpiZT<true> ED{1, ws, dout, P.lbl};
                  ListOrder S{8 * x, ld}; pg8::gemm_phase<EpiZT<true>, ListOrder, true, true>(lds, gD, S, ED);
                  asm volatile("s_waitcnt vmcnt(0)" ::: "memory"); __syncthreads();
                  if (tid == 0) __hip_atomic_fetch_add(dcnt + 64 * (8 * x + (r < 8 ? 6 : 7)), (r < 8 ? 2u : 1u), __ATOMIC_RELAXED, __HIP_MEMORY_SCOPE_AGENT); }
                merge_phase((u16*)(dout + DO_OG), (const float*)(ws + WS_COS), (const u16*)(dout + DO_AG), bx - 64, 192);
                asm volatile("s_waitcnt vmcnt(0)" ::: "memory"); __syncthreads();
                if (tid == 0) __hip_atomic_fetch_add(mcnt, 1u, __ATOMIC_RELAXED, __HIP_MEMORY_SCOPE_AGENT);
                { ListOrder S{8 * x, lg}; pg8::gemm_phase<EpiZ, ListOrder, true, true>(lds, gG, S, EG); }
                if (tid == 0) { unsigned sp = 0u; while (__hip_atomic_load(mcnt, __ATOMIC_RELAXED, __HIP_MEMORY_SCOPE_AGENT) < 192u) { __builtin_amdgcn_s_sleep(2); if (++sp > (1u << 22)) break; }
                    __builtin_amdgcn_fence(__ATOMIC_ACQUIRE, "agent"); asm volatile("s_waitcnt vmcnt(0)" ::: "memory"); }
                __syncthreads();
                { ListOrder S{8 * x, lb2}; pg8::gemm_phase<EpiGateB, ListOrder, true, true>(lds, gB, S, EB); } }
        }
    }
    SEAM(4);
    if (IN(5)) { pg8::Gemm g{(const u16*)(ws + Z_QA), (const u16*)(ws + WS_WA), TT, 1024, 1024}; pg8::StaticOrder S; S.init(TT, 1024, G, bx);
        EpiGateA E{(const u16*)(ws + Z_GATES), (const u16*)(dout + DO_TMPB), (u16*)(ws + Z_MERGED)}; pg8::gemm_phase<EpiGateA, pg8::StaticOrder, true, true>(lds, g, S, E); }
    SEAM(5);
    if (IN(6)) { pg8::Gemm g{(const u16*)(ws + Z_MERGED), (const u16*)(ws + WS_WO), TT, 1024, 1024}; pg8::StaticOrder S; S.init(TT, 1024, G, bx);
        EpiOutNorm E{P.x, P.out, P.fnw, (float*)(ws + WS_BAR + 65536), (unsigned*)(ws + WS_BAR + 16384)}; pg8::gemm_phase<EpiOutNorm, pg8::StaticOrder, false, true>(lds, g, S, E); }
#ifdef HG_PROBE_MODE
    if (bx < 64) hgrn_unit<HG_PROBE_MODE>(lds, bx >> 3, bx & 7, (const u16*)(ws + Z_QA), (const u16*)(ws + Z_G), (const u16*)(ws + Z_VA), (const u16*)(ws + Z_HG), P.hnw, (u16*)(ws + Z_HG), nullptr);
#endif
#ifdef PROBE_K
    STAMP(7);
    if (bx == 0 && tid == 0) { const LAS unsigned long long* ts = (const LAS unsigned long long*)(lds + 163344);
#ifdef PROBE_ACC
        const unsigned long long dt = ts[10], t0
#else
        const unsigned long long dt = ts[PROBE_B] - ts[PROBE_A], t0
#endif
 = __builtin_amdgcn_s_memrealtime();
        while (__builtin_amdgcn_s_memrealtime() - t0 < dt) __builtin_amdgcn_s_sleep(8); }
#endif
#undef IN
#undef SEAM
}

extern "C" void kernel_launch(void* const* d_in, const int* in_sizes, int n_in, void* d_out, int out_size, void* d_ws, size_t ws_size, hipStream_t stream) {
    static int grid = 0;
    if (grid == 0) {
        if (n_in != 10 || in_sizes[0] != TT * DM || out_size != TT * DM || ws_size < WS_END) { fprintf(stderr, "kernel_launch: unexpected shapes (n_in %d, in0 %d, out %d, ws %zu)\n", n_in, n_in > 0 ? in_sizes[0] : -1, out_size, ws_size); grid = -1; return; }
        int dev = 0, cus = 0, per_cu = 0;
        hipGetDevice(&dev); hipDeviceGetAttribute(&cus, hipDeviceAttributeMultiprocessorCount, dev);
        if (hipFuncSetAttribute((const void*)fwd_megakernel, hipFuncAttributeMaxDynamicSharedMemorySize, LDS_BYTES) != hipSuccess) { fprintf(stderr, "kernel_launch: hipFuncSetAttribute failed\n"); grid = -1; return; }
        if (hipOccupancyMaxActiveBlocksPerMultiprocessor(&per_cu, (const void*)fwd_megakernel, 512, LDS_BYTES) != hipSuccess || per_cu < 1) { fprintf(stderr, "kernel_launch: occupancy query says %d\n", per_cu); per_cu = 1; }
        (void)hipGetLastError();
        grid = cus * (per_cu > 1 ? 1 : per_cu);
        if (grid != 256) { fprintf(stderr, "kernel_launch: built for a 256-CU device (one workgroup per CU); got %d\n", grid); grid = -1; return; }
    }
    if (grid < 0) return;
    if (hipMemsetAsync((char*)d_ws + WS_BAR, 0, 36864 + 16384, stream) != hipSuccess) { fprintf(stderr, "kernel_launch: memset of the barrier words failed\n"); return; }
    Args a{};
    for (int i = 0; i < 10; ++i) a.in[i] = (const float*)d_in[i];
    a.out = (float*)d_out; a.ws = (unsigned char*)d_ws; a.ph_lo = 0; a.ph_hi = 7;
    void* args[] = {&a};
    hipError_t e = hipLaunchCooperativeKernel((const void*)fwd_megakernel, dim3(grid), dim3(512), args, LDS_BYTES, stream);
    if (e != hipSuccess) fprintf(stderr, "kernel_launch: cooperative launch failed: %s (grid %d)\n", hipGetErrorString(e), grid);
}
```

```cpp
#include <hip/hip_runtime.h>
#include <hip/hip_cooperative_groups.h>
#include <hip/hip_bf16.h>
#include <cstdio>
#include <cstdint>
#include <cmath>
namespace cg = cooperative_groups;
namespace pg8 {
#define PG8_LAS __attribute__((address_space(3)))
typedef unsigned short bf16_t;
typedef short bf16x8 __attribute__((ext_vector_type(8)));
typedef float f32x4 __attribute__((ext_vector_type(4)));
typedef unsigned u32x4 __attribute__((ext_vector_type(4)));
constexpr int BM = 256, BK = 64, HALF = 128, HTB = HALF * BK * 2  , STAGE_BYTES = 8 * HTB, NXCD = 8, WGM = 8;

__host__ __device__ __forceinline__ int lds_byte(int r, int c) { const int st = (r >> 4) * 2 + (c >> 5), rr = r & 15, cc = c & 31, ob = rr * 64 + cc * 2; return st * 1024 + (ob ^ (((ob >> 9) & 1) << 5)); }
__host__ __device__ __forceinline__ void stage_rc(int b, int& R, int& C) { const int st = b / 1024, sb = b % 1024, swz = sb ^ (((sb >> 9) & 1) << 5); R = (st >> 1) * 16 + swz / 64; C = (st & 1) * 32 + (swz % 64) / 2; }
__host__ __device__ __forceinline__ int perm32(int rho) { const int n = rho >> 4, i = rho & 15; return 8 * (i >> 2) + 4 * n + (i & 3); }

struct Unit { int pm, pn; };
struct Gemm { const bf16_t* A; const bf16_t* Bt; int M, N, K; };

struct StaticOrder {
    int nM, nN, nwg, G, c;
    __host__ __device__ void init(int M, int N, int G_, int c_) { nM = M / BM; nN = N / BM; nwg = nM * nN; G = G_; c = c_; }
    __host__ __device__ bool next(int i, Unit& u) const {
        const long L = (long)i * G + c; if (L >= nwg) return false;
        int wgid = (int)L; { const int q = nwg / NXCD, r = nwg % NXCD, xcd = wgid % NXCD, off = wgid / NXCD; wgid = (xcd < r ? xcd * (q + 1) : r * (q + 1) + (xcd - r) * q) + off; }
        const int nig = WGM * nN, gid = wgid / nig, fm = gid * WGM, gsz = (nM - fm) < WGM ? (nM - fm) : WGM;
        u.pm = fm + ((wgid % nig) % gsz); u.pn = (wgid % nig) / gsz; return true;
    }
    __device__ __forceinline__ void a_ready(const Unit&) const {}
    __device__ __forceinline__ void done(const Unit&) const {}
};

__device__ __forceinline__ unsigned cvt_pk_bf16(float lo, float hi) { unsigned r; asm volatile("v_cvt_pk_bf16_f32 %0, %1, %2" : "=v"(r) : "v"(lo), "v"(hi)); return r; }
typedef float f32x2 __attribute__((ext_vector_type(2)));
template <class Epi, class Sched, bool ALIGN_EPI = false, bool SP2 = false>
__device__ __forceinline__ void gemm_phase(PG8_LAS unsigned char* lds, const Gemm g, const Sched& S, const Epi& E) {
    const int tid = threadIdx.x, wid = __builtin_amdgcn_readfirstlane(tid >> 6), lane = tid & 63, wr = wid >> 2, wc = wid & 3, fr = lane & 15, fq = lane >> 4;
    const int K = g.K, nt = K / BK;
    unsigned voffA[2], voffB[2];
#pragma unroll
    for (int i = 0; i < 2; ++i) { int R, C; stage_rc(tid * 16 + i * 8192, R, C); const int Rb = Epi::PERM ? ((R & ~31) + perm32(R & 31)) : R;
        voffA[i] = (unsigned)(R * K + C) * 2u; voffB[i] = (unsigned)(Rb * K + C) * 2u; }
    const size_t kstep = (size_t)(BK * 2);
    const size_t hstep = (size_t)HALF * K * 2;
    const size_t tstep = 2 * hstep;
    const unsigned ldsw = (unsigned)wid * 1024u;
    const int aoff = lds_byte(wr * 64 + fr, fq * 8), boff = lds_byte(wc * 32 + fr, fq * 8);
#define PG8_SA(b, h) (((b) * 2 + (h)) * HTB)
#define PG8_SB(b, h) ((4 + (b) * 2 + (h)) * HTB)
#define PG8_STAGE(bufoff, gbase, voff) do { _Pragma("unroll") for (int _i = 0; _i < 2; ++_i) \
        __builtin_amdgcn_global_load_lds((const unsigned*)((const char*)(gbase) + (voff)[_i]), (PG8_LAS unsigned*)(lds + (bufoff) + ldsw + _i * 8192), 16, 0, 0); } while (0)
#define PG8_LDA(dst, b, h) do { _Pragma("unroll") for (int m = 0; m < 4; ++m) _Pragma("unroll") for (int k = 0; k < 2; ++k) dst[m][k] = *(const PG8_LAS bf16x8*)(lds + PG8_SA(b, h) + aoff + m * 2048 + k * 1024); } while (0)
#define PG8_LDB(dst, b, h) do { _Pragma("unroll") for (int n = 0; n < 2; ++n) _Pragma("unroll") for (int k = 0; k < 2; ++k) dst[n][k] = *(const PG8_LAS bf16x8*)(lds + PG8_SB(b, h) + boff + n * 2048 + k * 1024); } while (0)
#define PG8_MMA(ai, bj, At, Bt) do { __builtin_amdgcn_s_setprio(1); _Pragma("unroll") for (int m = 0; m < 4; ++m) _Pragma("unroll") for (int n = 0; n < 2; ++n) _Pragma("unroll") for (int k = 0; k < 2; ++k) \
        acc[ai][bj][m][n] = __builtin_amdgcn_mfma_f32_16x16x32_bf16(Bt[n][k], At[m][k], acc[ai][bj][m][n], 0, 0, 0); __builtin_amdgcn_s_setprio(0); } while (0)
#define PG8_WAIT_V(n) asm volatile("s_waitcnt vmcnt(" #n ")" ::: "memory")
#define PG8_WAIT_L(n) asm volatile("s_waitcnt lgkmcnt(" #n ")" ::: "memory")
#define PG8_BAR __builtin_amdgcn_s_barrier()
#define PG8_SCHED __builtin_amdgcn_sched_barrier(0)
    Unit cur, nxt; int ui = 0;
    if (!S.next(0, cur)) return;
    f32x4 acc[2][2][4][2];
#pragma unroll
    for (int a = 0; a < 2; ++a)
#pragma unroll
        for (int b = 0; b < 2; ++b)
#pragma unroll
            for (int m = 0; m < 4; ++m)
#pragma unroll
                for (int n = 0; n < 2; ++n) acc[a][b][m][n] = (f32x4){0.f, 0.f, 0.f, 0.f};
    bf16x8 At[4][2], B0[2][2], B1[2][2];
    const char* cA = (const char*)g.A + (size_t)cur.pm * tstep; const char* cB = (const char*)g.Bt + (size_t)cur.pn * tstep;
    S.a_ready(cur);
    if constexpr (SP2) {
        PG8_STAGE(PG8_SB(0, 0), cB, voffB); PG8_STAGE(PG8_SB(0, 1), cB + hstep, voffB); PG8_STAGE(PG8_SA(0, 0), cA, voffA); PG8_STAGE(PG8_SA(0, 1), cA + hstep, voffA);
        if (wr == 1) PG8_BAR;
        PG8_WAIT_V(2); PG8_BAR;
        PG8_STAGE(PG8_SB(1, 0), cB + kstep, voffB); PG8_STAGE(PG8_SA(1, 0), cA + kstep, voffA); PG8_STAGE(PG8_SB(1, 1), cB + hstep + kstep, voffB);
        PG8_WAIT_V(6); PG8_BAR;
    } else {
        PG8_STAGE(PG8_SB(0, 0), cB, voffB); PG8_STAGE(PG8_SA(0, 0), cA, voffA); PG8_STAGE(PG8_SB(0, 1), cB + hstep, voffB); PG8_STAGE(PG8_SA(0, 1), cA + hstep, voffA);
        if (wr == 1) PG8_BAR;
        PG8_WAIT_V(4); PG8_BAR;
        PG8_STAGE(PG8_SB(1, 0), cB + kstep, voffB); PG8_STAGE(PG8_SA(1, 0), cA + kstep, voffA); PG8_STAGE(PG8_SB(1, 1), cB + hstep + kstep, voffB);
        PG8_WAIT_V(6); PG8_BAR;
    }
    for (;;) {
        const bool has_next = S.next(ui + 1, nxt);
        const char* nA = has_next ? (const char*)g.A + (size_t)nxt.pm * tstep : cA; const char* nB = has_next ? (const char*)g.Bt + (size_t)nxt.pn * tstep : cB;
        for (int t = 0; t < nt; t += 2) {
            const bool last = (t == nt - 2);
            const char* a1 = cA + (size_t)(t + 1) * kstep;
            const char* a2 = last ? nA : cA + (size_t)(t + 2) * kstep; const char* b2 = last ? nB : cB + (size_t)(t + 2) * kstep;
            const char* a3 = a2 + kstep; const char* b3 = b2 + kstep;
            if (last && has_next) S.a_ready(nxt);
            if constexpr (SP2) {
            PG8_LDB(B0, 0, 0); PG8_LDB(B1, 0, 1); PG8_SCHED; PG8_LDA(At, 0, 0); PG8_STAGE(PG8_SA(1, 1), a1 + hstep, voffA);
            PG8_WAIT_V(8); PG8_WAIT_L(0); PG8_BAR; PG8_MMA(0, 0, At, B0); PG8_MMA(0, 1, At, B1); PG8_BAR; PG8_SCHED;
            PG8_LDA(At, 0, 1); PG8_STAGE(PG8_SB(0, 0), b2, voffB); PG8_STAGE(PG8_SB(0, 1), b2 + hstep, voffB); PG8_STAGE(PG8_SA(0, 0), a2, voffA);
            PG8_WAIT_V(8); PG8_WAIT_L(0); PG8_BAR; PG8_MMA(1, 0, At, B0); PG8_MMA(1, 1, At, B1); PG8_BAR; PG8_SCHED;
            PG8_LDB(B0, 1, 0); PG8_LDB(B1, 1, 1); PG8_SCHED; PG8_LDA(At, 1, 0); PG8_STAGE(PG8_SA(0, 1), a2 + hstep, voffA);
            PG8_WAIT_V(8); PG8_WAIT_L(0); PG8_BAR; PG8_MMA(0, 0, At, B0); PG8_MMA(0, 1, At, B1); PG8_BAR; PG8_SCHED;
            PG8_LDA(At, 1, 1); PG8_STAGE(PG8_SB(1, 0), b3, voffB); PG8_STAGE(PG8_SB(1, 1), b3 + hstep, voffB); PG8_STAGE(PG8_SA(1, 0), a3, voffA);
            PG8_WAIT_V(8); PG8_WAIT_L(0); PG8_BAR; PG8_MMA(1, 0, At, B0); PG8_MMA(1, 1, At, B1); PG8_BAR; PG8_SCHED;
            } else {
            PG8_LDB(B0, 0, 0); PG8_SCHED; PG8_LDA(At, 0, 0); PG8_STAGE(PG8_SA(1, 1), a1 + hstep, voffA);
            PG8_WAIT_L(8); PG8_BAR; PG8_WAIT_L(0); PG8_MMA(0, 0, At, B0); PG8_BAR; PG8_SCHED;
            PG8_LDB(B1, 0, 1); PG8_STAGE(PG8_SB(0, 0), b2, voffB);
            PG8_BAR; PG8_WAIT_L(0); PG8_MMA(0, 1, At, B1); PG8_BAR;
            PG8_LDA(At, 0, 1); PG8_STAGE(PG8_SA(0, 0), a2, voffA);
            PG8_BAR; PG8_WAIT_L(0); PG8_MMA(1, 0, At, B0); PG8_BAR; PG8_SCHED;
            PG8_STAGE(PG8_SB(0, 1), b2 + hstep, voffB);
            PG8_WAIT_V(6); PG8_BAR; PG8_MMA(1, 1, At, B1); PG8_BAR;
            PG8_LDB(B0, 1, 0); PG8_SCHED; PG8_LDA(At, 1, 0); PG8_STAGE(PG8_SA(0, 1), a2 + hstep, voffA);
            PG8_WAIT_L(8); PG8_BAR; PG8_WAIT_L(0); PG8_MMA(0, 0, At, B0); PG8_BAR; PG8_SCHED;
            PG8_LDB(B1, 1, 1); PG8_STAGE(PG8_SB(1, 0), b3, voffB);
            PG8_BAR; PG8_WAIT_L(0); PG8_MMA(0, 1, At, B1); PG8_BAR;
            PG8_LDA(At, 1, 1); PG8_STAGE(PG8_SA(1, 0), a3, voffA);
            PG8_BAR; PG8_WAIT_L(0); PG8_MMA(1, 0, At, B0); PG8_BAR; PG8_SCHED;
            PG8_STAGE(PG8_SB(1, 1), b3 + hstep, voffB);
            PG8_WAIT_V(6); PG8_BAR; PG8_MMA(1, 1, At, B1); PG8_BAR;
            }
        }
        if constexpr (ALIGN_EPI) { if (wr == 0) PG8_BAR; }
        if constexpr (!Epi::AFTER_DRAIN) { E(acc, cur, wr, wc, fr, fq); S.done(cur); }
        if (!has_next) break;
#pragma unroll
        for (int a = 0; a < 2; ++a)
#pragma unroll
            for (int b = 0; b < 2; ++b)
#pragma unroll
                for (int m = 0; m < 4; ++m)
#pragma unroll
                    for (int n = 0; n < 2; ++n) acc[a][b][m][n] = (f32x4){0.f, 0.f, 0.f, 0.f};
        cur = nxt; cA = nA; cB = nB; ++ui;
        if constexpr (ALIGN_EPI) { if (wr == 1) PG8_BAR; }
    }
    PG8_WAIT_V(0);
    if constexpr (!ALIGN_EPI) { if (wr == 0) PG8_BAR; }
    PG8_BAR;
    if constexpr (Epi::AFTER_DRAIN) { E.fused(acc, cur, wr, wc, fr, fq, lds, wid, lane); S.done(cur); }
#undef PG8_SA
#undef PG8_SB
#undef PG8_STAGE
#undef PG8_LDA
#undef PG8_LDB
#undef PG8_MMA
#undef PG8_WAIT_V
#undef PG8_WAIT_L
#undef PG8_BAR
#undef PG8_SCHED
}
}

#define LAS __attribute__((address_space(3)))
typedef unsigned short u16;
typedef short bf16x8 __attribute__((ext_vector_type(8)));
typedef short s16x4 __attribute__((ext_vector_type(4)));
typedef float f32x4 __attribute__((ext_vector_type(4)));
typedef float f32x2 __attribute__((ext_vector_type(2)));
typedef unsigned u32x4 __attribute__((ext_vector_type(4)));
typedef unsigned u32x2 __attribute__((ext_vector_type(2)));

constexpr int TT = 16384, DM = 1024, SEQ = 2048, NIN = 11264;
constexpr int ZBP = 4608;
constexpr size_t MiB = 1u << 20;
constexpr size_t WS_WT = 0;
constexpr size_t WS_WA = 22 * MiB, WS_WB = 24 * MiB, WS_WO = 25 * MiB;
constexpr size_t WS_COS = 27 * MiB, WS_SIN = 29 * MiB;
constexpr size_t WS_BAR = 31 * MiB;
constexpr size_t WS_H = 32 * MiB;
constexpr size_t WS_Z = 64 * MiB;
constexpr size_t Z_QA = WS_Z, Z_G = WS_Z + 32 * MiB, Z_VA = WS_Z + 64 * MiB, Z_HG = WS_Z + 96 * MiB, Z_GATES = WS_Z + 128 * MiB;
constexpr size_t Z_MERGED = WS_Z + 64 * MiB;
constexpr size_t WS_END = 256 * MiB;
constexpr size_t DO_OG = 0, DO_AG = 48 * MiB, DO_TMPB = 16 * MiB;
constexpr int LDS_BYTES = 163840;
constexpr float NORM_EPS = 1e-6f;

__device__ __forceinline__ unsigned pk_bf16(float lo, float hi) { typedef __bf16 b2 __attribute__((ext_vector_type(2))); f32x2 v = {lo, hi}; b2 b = __builtin_convertvector(v, b2); return __builtin_bit_cast(unsigned, b); }
__device__ __forceinline__ unsigned pk_f16(float lo, float hi) { typedef _Float16 h2 __attribute__((ext_vector_type(2))); h2 h = {(_Float16)lo, (_Float16)hi}; return __builtin_bit_cast(unsigned, h); }
__device__ __forceinline__ float bflo(unsigned u) { return __uint_as_float(u << 16); }
__device__ __forceinline__ float bfhi(unsigned u) { return __uint_as_float(u & 0xffff0000u); }
__device__ __forceinline__ float f16lo(unsigned u) { return (float)__builtin_bit_cast(_Float16, (unsigned short)(u & 0xffffu)); }
__device__ __forceinline__ float f16hi(unsigned u) { return (float)__builtin_bit_cast(_Float16, (unsigned short)(u >> 16)); }
__device__ __forceinline__ float sigm(float x) { return __builtin_amdgcn_rcpf(1.0f + __expf(-x)); }
__device__ __forceinline__ s16x4 ds_tr(const LAS u16* p) { typedef short v4 __attribute__((ext_vector_type(4))); return __builtin_bit_cast(s16x4, __builtin_amdgcn_ds_read_tr16_b64_v4i16((LAS v4*)p)); }
__device__ __forceinline__ bf16x8 cat8(s16x4 lo, s16x4 hi) { return (bf16x8){lo[0], lo[1], lo[2], lo[3], hi[0], hi[1], hi[2], hi[3]}; }
__device__ __forceinline__ f32x4 mfma16(bf16x8 a, bf16x8 b, f32x4 c) { return __builtin_amdgcn_mfma_f32_16x16x32_bf16(a, b, c, 0, 0, 0); }
__device__ __forceinline__ void store16_wt(void* p, u32x4 v) { asm volatile("global_store_dwordx4 %0, %1, off sc1\n\ts_nop 1" :: "v"(p), "v"(v) : "memory"); }
template <bool WT> __device__ __forceinline__ void store16(void* p, u32x4 v) { if (WT) store16_wt(p, v); else *(u32x4*)p = v; }
__device__ __forceinline__ float wave_sum(float v) {
#pragma unroll
    for (int o = 1; o < 64; o <<= 1) v += __shfl_xor(v, o);
    return v;
}

using pg8::Unit;
template <int ACT  > __device__ __forceinline__ float act1(float v) { if (ACT == 1) return v * sigm(v); if (ACT == 2) return sigm(v); return v; }
template <int ACT, bool WT = false> __device__ __forceinline__ void epi_store16(const f32x4 (&acc)[2][2][4][2], u16* base, int pitch, int row0, int col0) {
#pragma unroll
    for (int ai = 0; ai < 2; ++ai)
#pragma unroll
        for (int m = 0; m < 4; ++m) { u16* rowp = base + (size_t)(row0 + ai * 128 + m * 16) * pitch + col0;
#pragma unroll
            for (int bj = 0; bj < 2; ++bj) { const f32x4 v0 = acc[ai][bj][m][0], v1 = acc[ai][bj][m][1]; u32x4 w;
                w.x = pk_bf16(act1<ACT>(v0[0]), act1<ACT>(v0[1])); w.y = pk_bf16(act1<ACT>(v0[2]), act1<ACT>(v0[3]));
                w.z = pk_bf16(act1<ACT>(v1[0]), act1<ACT>(v1[1])); w.w = pk_bf16(act1<ACT>(v1[2]), act1<ACT>(v1[3]));
                store16<WT>(rowp + bj * 128, w); } }
}
template <int ACT, bool WT> __device__ __forceinline__ void epi_store16_hm(const f32x4 (&acc)[2][2][4][2], u16* base, int pnl, int row0, int lc) {
#pragma unroll
    for (int ai = 0; ai < 2; ++ai)
#pragma unroll
        for (int m = 0; m < 4; ++m) { const int row = row0 + ai * 128 + m * 16, b = row >> 11, t = row & 2047;
#pragma unroll
            for (int bj = 0; bj < 2; ++bj) { const f32x4 v0 = acc[ai][bj][m][0], v1 = acc[ai][bj][m][1]; u32x4 w;
                w.x = pk_bf16(act1<ACT>(v0[0]), act1<ACT>(v0[1])); w.y = pk_bf16(act1<ACT>(v0[2]), act1<ACT>(v0[3]));
                w.z = pk_bf16(act1<ACT>(v1[0]), act1<ACT>(v1[1])); w.w = pk_bf16(act1<ACT>(v1[2]), act1<ACT>(v1[3]));
                store16<WT>(base + ((size_t)(b * 8 + 2 * pnl + bj) * 2048 + t) * 128 + lc, w); } }
}
template <bool WT> struct EpiZT {
    static constexpr bool PERM = true, AFTER_DRAIN = false;
    int mode;
    unsigned char* ws; unsigned char* dout; const float* lbl;
    __device__ __forceinline__ void operator()(const f32x4 (&acc)[2][2][4][2], const Unit& u, int wr, int wc, int fr, int fq) const {
        const int pn = u.pn, row0 = u.pm * 256 + wr * 64 + fr, lc = wc * 32 + 8 * fq;
        if (mode == 2) { epi_store16<2>(acc, (u16*)(ws + Z_GATES), 2048, row0, pn * 256 + lc); return; }
        if (mode == 0) {
            u16* ZB = (u16*)(ws + WS_Z);
            if (pn < 12) {
                const float sc = (pn < 6) ? 0.125f * 1.4426950408889634f : 1.0f;
                const float* cosT = (const float*)(ws + WS_COS); const float* sinT = (const float*)(ws + WS_SIN);
                const int jb = 16 * (wc & 1) + 4 * fq;
#pragma unroll
                for (int ai = 0; ai < 2; ++ai) { f32x4 cc[4], ss[4];
#pragma unroll
                    for (int m = 0; m < 4; ++m) { const int row = row0 + ai * 128 + m * 16; cc[m] = *(const f32x4*)(cosT + (size_t)row * 32 + jb); ss[m] = *(const f32x4*)(sinT + (size_t)row * 32 + jb); }
#pragma unroll
                    for (int m = 0; m < 4; ++m) { const int row = row0 + ai * 128 + m * 16; const f32x4 c = cc[m], s = ss[m];
                        u16* rowp = ZB + ((size_t)(pn * 4 + (wc >> 1)) * TT + row) * 64 + (lc & 63);
#pragma unroll
                        for (int bj = 0; bj < 2; ++bj) { const f32x4 v0 = acc[ai][bj][m][0], v1 = acc[ai][bj][m][1]; u32x4 w;
                            w.x = pk_bf16((v0[0] * c[0] - v0[1] * s[0]) * sc, (v0[1] * c[0] + v0[0] * s[0]) * sc);
                            w.y = pk_bf16((v0[2] * c[1] - v0[3] * s[1]) * sc, (v0[3] * c[1] + v0[2] * s[1]) * sc);
                            w.z = pk_bf16((v1[0] * c[2] - v1[1] * s[2]) * sc, (v1[1] * c[2] + v1[0] * s[2]) * sc);
                            w.w = pk_bf16((v1[2] * c[3] - v1[3] * s[3]) * sc, (v1[3] * c[3] + v1[2] * s[3]) * sc);
                            *(u32x4*)(rowp + (size_t)bj * 2 * TT * 64) = w; } } }
            } else if (pn < 18) {
#pragma unroll
                for (int ai = 0; ai < 2; ++ai)
#pragma unroll
                    for (int m = 0; m < 4; ++m) { u16* rowp = ZB + ((size_t)(pn * 4 + (wc >> 1)) * TT + (row0 + ai * 128 + m * 16)) * 64 + (lc & 63);
#pragma unroll
                        for (int bj = 0; bj < 2; ++bj) { const f32x4 v0 = acc[ai][bj][m][0], v1 = acc[ai][bj][m][1]; u32x4 w;
                            w.x = pk_bf16(v0[0], v0[1]); w.y = pk_bf16(v0[2], v0[3]); w.z = pk_bf16(v1[0], v1[1]); w.w = pk_bf16(v1[2], v1[3]);
                            *(u32x4*)(rowp + (size_t)bj * 2 * TT * 64) = w; } }
            }
            else epi_store16<1>(acc, (u16*)(dout + DO_AG), 512, row0, (pn - 18) * 256 + lc);
        } else {
            if (pn < 4) epi_store16<1, WT>(acc, (u16*)(ws + Z_QA), 1024, row0, pn * 256 + lc);
            else if (pn < 8) {
                const int cb = (pn - 4) * 256 + lc; float lb[2][8];
#pragma unroll
                for (int bj = 0; bj < 2; ++bj)
#pragma unroll
                    for (int e = 0; e < 8; ++e) { const int idx = cb + bj * 128 + e; lb[bj][e] = 1.0f / (1.0f + __expf(lbl[1024 + idx] - lbl[idx])); }
                u16* G = (u16*)(ws + Z_G);
#pragma unroll
                for (int ai = 0; ai < 2; ++ai)
#pragma unroll
                    for (int m = 0; m < 4; ++m) { const int row = row0 + ai * 128 + m * 16; u16* rowp = G + ((size_t)((row >> 11) * 8 + 2 * (pn - 4)) * 2048 + (row & 2047)) * 128 + lc;
#pragma unroll
                        for (int bj = 0; bj < 2; ++bj) { const f32x4 v0 = acc[ai][bj][m][0], v1 = acc[ai][bj][m][1]; float g[8];
#pragma unroll
                            for (int e = 0; e < 8; ++e) { const float v = e < 4 ? v0[e & 3] : v1[e & 3]; g[e] = lb[bj][e] + (1.0f - lb[bj][e]) * sigm(v); }
                            u32x4 w; w.x = pk_f16(g[0], g[1]); w.y = pk_f16(g[2], g[3]); w.z = pk_f16(g[4], g[5]); w.w = pk_f16(g[6], g[7]);
                            store16<WT>(rowp + (size_t)bj * 2048 * 128, w); } }
            } else if (pn < 12) epi_store16_hm<0, WT>(acc, (u16*)(ws + Z_VA), pn - 8, row0, lc);
            else if (pn < 16) epi_store16_hm<1, WT>(acc, (u16*)(ws + Z_HG), pn - 12, row0, lc);
            else epi_store16<2>(acc, (u16*)(ws + Z_GATES), 2048, row0, (pn - 16) * 256 + lc);
        }
    }
};
typedef EpiZT<false> EpiZ;
struct EpiGateB {
    static constexpr bool PERM = true, AFTER_DRAIN = false;
    const u16* gates; u16* tmpb;
    __device__ __forceinline__ void operator()(const f32x4 (&acc)[2][2][4][2], const Unit& u, int wr, int wc, int fr, int fq) const {
        const int row0 = u.pm * 256 + wr * 64 + fr, col0 = u.pn * 256 + wc * 32 + 8 * fq;
#pragma unroll
        for (int ai = 0; ai < 2; ++ai) { u32x4 gg[4][2];
#pragma unroll
            for (int m = 0; m < 4; ++m)
#pragma unroll
                for (int bj = 0; bj < 2; ++bj) gg[m][bj] = *(const u32x4*)(gates + (size_t)(row0 + ai * 128 + m * 16) * 2048 + 1024 + col0 + bj * 128);
#pragma unroll
            for (int m = 0; m < 4; ++m) { const size_t row = row0 + ai * 128 + m * 16;
#pragma unroll
                for (int bj = 0; bj < 2; ++bj) { const int col = col0 + bj * 128; const u32x4 g = gg[m][bj];
                    const f32x4 v0 = acc[ai][bj][m][0], v1 = acc[ai][bj][m][1]; u32x4 w;
                    w.x = pk_bf16(v0[0] * bflo(g.x), v0[1] * bfhi(g.x)); w.y = pk_bf16(v0[2] * bflo(g.y), v0[3] * bfhi(g.y));
                    w.z = pk_bf16(v1[0] * bflo(g.z), v1[1] * bfhi(g.z)); w.w = pk_bf16(v1[2] * bflo(g.w), v1[3] * bfhi(g.w));
                    *(u32x4*)(tmpb + row * 1024 + col) = w; } } }
    }
};
struct EpiGateA {
    static constexpr bool PERM = true, AFTER_DRAIN = false;
    const u16* gates; const u16* tmpb; u16* merged;
    __device__ __forceinline__ void operator()(const f32x4 (&acc)[2][2][4][2], const Unit& u, int wr, int wc, int fr, int fq) const {
        const int row0 = u.pm * 256 + wr * 64 + fr, col0 = u.pn * 256 + wc * 32 + 8 * fq;
#pragma unroll
        for (int ai = 0; ai < 2; ++ai) { u32x4 gg[4][2], tb[4][2];
#pragma unroll
            for (int m = 0; m < 4; ++m)
#pragma unroll
                for (int bj = 0; bj < 2; ++bj) { const size_t row = row0 + ai * 128 + m * 16; gg[m][bj] = *(const u32x4*)(gates + row * 2048 + col0 + bj * 128); tb[m][bj] = *(const u32x4*)(tmpb + row * 1024 + col0 + bj * 128); }
#pragma unroll
            for (int m = 0; m < 4; ++m) { const size_t row = row0 + ai * 128 + m * 16;
#pragma unroll
                for (int bj = 0; bj < 2; ++bj) { const int col = col0 + bj * 128; const u32x4 g = gg[m][bj], t = tb[m][bj];
                    const f32x4 v0 = acc[ai][bj][m][0], v1 = acc[ai][bj][m][1]; u32x4 w;
                    w.x = pk_bf16(bflo(t.x) + v0[0] * bflo(g.x), bfhi(t.x) + v0[1] * bfhi(g.x)); w.y = pk_bf16(bflo(t.y) + v0[2] * bflo(g.y), bfhi(t.y) + v0[3] * bfhi(g.y));
                    w.z = pk_bf16(bflo(t.z) + v1[0] * bflo(g.z), bfhi(t.z) + v1[1] * bfhi(g.z)); w.w = pk_bf16(bflo(t.w) + v1[2] * bflo(g.w), bfhi(t.w) + v1[3] * bfhi(g.w));
                    *(u32x4*)(merged + row * 1024 + col) = w; } } }
    }
};
struct ListOrder { int pm0; unsigned list;
    __device__ __forceinline__ bool next(int i, Unit& u) const { const unsigned c = (i < 4) ? ((list >> (8 * i)) & 0xffu) : 0xffu; if (c == 0xffu) return false; u.pm = pm0 + (int)(c & 7u); u.pn = (int)(c >> 3); return true; }
    __device__ __forceinline__ void a_ready(const Unit&) const {} __device__ __forceinline__ void done(const Unit&) const {} };
struct DefOrder { pg8::StaticOrder base;
    __device__ __forceinline__ bool next(int i, Unit& u) const { if (!base.next(i, u)) return false; u.pm = (u.pm / 6) * 8 + (u.pm % 6); return true; }
    __device__ __forceinline__ void a_ready(const Unit&) const {} __device__ __forceinline__ void done(const Unit&) const {} };
__device__ __forceinline__ unsigned lo_code(int idx, int base) { return (unsigned)(((base + (idx >> 3)) << 3) | (idx & 7)); }
struct EpiOutNorm {
    static constexpr bool PERM = true, AFTER_DRAIN = true;
    const float* x; float* out; const float* fnw; float* xbuf; unsigned* cnt;
    __device__ __forceinline__ void operator()(const f32x4 (&)[2][2][4][2], const Unit&, int, int, int, int) const {}
    __device__ __forceinline__ void fused(f32x4 (&acc)[2][2][4][2], const Unit& u, int wr, int wc, int fr, int fq, PG8_LAS unsigned char* lds, int wid, int lane) const {
        const int row0 = u.pm * 256 + wr * 64 + fr, col0 = u.pn * 256 + wc * 32 + 8 * fq;
        LAS float* PS = (LAS float*)lds;
        LAS float* RS = (LAS float*)(lds + 4096);
#pragma unroll
        for (int ai = 0; ai < 2; ++ai)
#pragma unroll
            for (int mh = 0; mh < 2; ++mh) { f32x4 xv[2][2][2];
#pragma unroll
                for (int mm = 0; mm < 2; ++mm)
#pragma unroll
                    for (int bj = 0; bj < 2; ++bj) { const size_t o = (size_t)(row0 + ai * 128 + (2 * mh + mm) * 16) * 1024 + col0 + bj * 128; xv[mm][bj][0] = *(const f32x4*)(x + o); xv[mm][bj][1] = *(const f32x4*)(x + o + 4); }
#pragma unroll
                for (int mm = 0; mm < 2; ++mm) { const int m = 2 * mh + mm; float sq = 0.f;
#pragma unroll
                    for (int bj = 0; bj < 2; ++bj)
#pragma unroll
                        for (int n = 0; n < 2; ++n) { const f32x4 v = acc[ai][bj][m][n] + xv[mm][bj][n]; acc[ai][bj][m][n] = v; sq += (v[0] * v[0] + v[1] * v[1]) + (v[2] * v[2] + v[3] * v[3]); }
                    sq += __shfl_xor(sq, 16); sq += __shfl_xor(sq, 32);
                    if (fq == 0) PS[(ai * 128 + wr * 64 + m * 16 + fr) * 4 + wc] = sq; } }
        asm volatile("s_waitcnt lgkmcnt(0)" ::: "memory"); __builtin_amdgcn_s_barrier(); asm volatile("" ::: "memory");
        const int tid = wid * 64 + lane;
        if (tid < 256) { const f32x4 p = *(const LAS f32x4*)(PS + tid * 4);
            __hip_atomic_store(xbuf + (size_t)(u.pm * 256 + tid) * 4 + u.pn, (p[0] + p[1]) + (p[2] + p[3]), __ATOMIC_RELAXED, __HIP_MEMORY_SCOPE_AGENT); }
        asm volatile("s_waitcnt vmcnt(0)" ::: "memory"); __builtin_amdgcn_s_barrier(); asm volatile("" ::: "memory");
        if (tid == 0) {
            __hip_atomic_fetch_add(cnt + 64 * u.pm, 1u, __ATOMIC_RELAXED, __HIP_MEMORY_SCOPE_AGENT);
            unsigned sp = 0u; while (__hip_atomic_load(cnt + 64 * u.pm, __ATOMIC_RELAXED, __HIP_MEMORY_SCOPE_AGENT) < 4u) { __builtin_amdgcn_s_sleep(2); if (++sp > (1u << 22)) break; }
            __builtin_amdgcn_fence(__ATOMIC_ACQUIRE, "agent"); asm volatile("s_waitcnt vmcnt(0)" ::: "memory"); }
        __builtin_amdgcn_s_barrier(); asm volatile("" ::: "memory");
        if (tid < 256) { const float* sl = xbuf + (size_t)(u.pm * 256 + tid) * 4; float t = 0.f;
#pragma unroll
            for (int k = 0; k < 4; ++k) t += __hip_atomic_load(sl + k, __ATOMIC_RELAXED, __HIP_MEMORY_SCOPE_AGENT);
            RS[tid] = rsqrtf(t * (1.0f / 1024.0f) + NORM_EPS); }
        asm volatile("s_waitcnt vmcnt(0) lgkmcnt(0)" ::: "memory"); __builtin_amdgcn_s_barrier(); asm volatile("" ::: "memory");
        f32x4 wv[2][2];
#pragma unroll
        for (int bj = 0; bj < 2; ++bj) { wv[bj][0] = *(const f32x4*)(fnw + col0 + bj * 128); wv[bj][1] = *(const f32x4*)(fnw + col0 + bj * 128 + 4); }
#pragma unroll
        for (int ai = 0; ai < 2; ++ai)
#pragma unroll
            for (int m = 0; m < 4; ++m) { const int rl = ai * 128 + wr * 64 + m * 16 + fr; const float rs = RS[rl]; const size_t o = (size_t)(u.pm * 256 + rl) * 1024 + col0;
#pragma unroll
                for (int bj = 0; bj < 2; ++bj) { *(f32x4*)(out + o + bj * 128) = acc[ai][bj][m][0] * rs * wv[bj][0]; *(f32x4*)(out + o + bj * 128 + 4) = acc[ai][bj][m][1] * rs * wv[bj][1]; } }
    }
};

__device__ __forceinline__ int wt_row_of_col(int n) {
    if (n < 4096) return n;
    if (n >= 9216) return 4096 + (n - 9216);
    int a = n - 4096;
    if (a < 3072) { const int e = a & 63; a = (a - e) + (e < 32 ? 2 * e : 2 * (e - 32) + 1); }
    return 6144 + a;
}
template <bool MAP> __device__ __forceinline__ void p0_transpose_item(const float* W, int K, int N, u16* WT, LAS float* scr, int item, int lane) {
    const int nblk = N / 32, kb = item / nblk, nb = item % nblk, k0 = 64 * kb, n0 = 32 * nb;
    float tv[32];
#pragma unroll
    for (int i = 0; i < 32; ++i) tv[i] = W[(size_t)(k0 + 2 * i + (lane >> 5)) * N + n0 + (lane & 31)];
#pragma unroll
    for (int i = 0; i < 32; ++i) scr[(2 * i + (lane >> 5)) * 33 + (lane & 31)] = tv[i];
    asm volatile("s_waitcnt lgkmcnt(0)" ::: "memory");
    const int c = lane & 7;
#pragma unroll
    for (int j = 0; j < 4; ++j) { const int n = (lane >> 3) + 8 * j; const LAS float* s = scr + (8 * c) * 33 + n;
        u32x4 o; o.x = pk_bf16(s[0 * 33], s[1 * 33]); o.y = pk_bf16(s[2 * 33], s[3 * 33]); o.z = pk_bf16(s[4 * 33], s[5 * 33]); o.w = pk_bf16(s[6 * 33], s[7 * 33]);
        const int r = MAP ? wt_row_of_col(n0 + n) : (n0 + n);
        *(u32x4*)(WT + (size_t)r * K + k0 + 8 * c) = o; }
    asm volatile("s_waitcnt lgkmcnt(0)" ::: "memory");
}
struct Ptrs { const float* x; const int* pos; const float* norm_w; const float* w_in; const float* lbl; const float* hnw; const float* wa; const float* wb; const float* wo; const float* fnw; float* out; unsigned char* ws; };

__device__ __forceinline__ void p0_prologue(const Ptrs& P, LAS unsigned char* lds, int vcu, int G) {
    const int tid = threadIdx.x, lane = tid & 63, wave = __builtin_amdgcn_readfirstlane(tid >> 6);
    LAS float* scr = (LAS float*)(lds + wave * 16384);
    const int gw = vcu * 8 + wave, NGW = G * 8;
    constexpr int I_IN = 16 * (NIN / 32), I_A = 16 * 32, I_B = 8 * 32, I_O = 16 * 32, NITEMS = I_IN + I_A + I_B + I_O;
    for (int it = gw; it < NITEMS; it += NGW) {
        int r = it;
        if (r < I_IN) { p0_transpose_item<true>(P.w_in, 1024, NIN, (u16*)(P.ws + WS_WT), scr, r, lane); continue; } r -= I_IN;
        if (r < I_A) { p0_transpose_item<false>(P.wa, 1024, 1024, (u16*)(P.ws + WS_WA), scr, r, lane); continue; } r -= I_A;
        if (r < I_B) { p0_transpose_item<false>(P.wb, 512, 1024, (u16*)(P.ws + WS_WB), scr, r, lane); continue; } r -= I_B;
        p0_transpose_item<false>(P.wo, 1024, 1024, (u16*)(P.ws + WS_WO), scr, r, lane);
    }
    u16* H = (u16*)(P.ws + WS_H);
    for (int m = gw; m < TT; m += 2 * NGW) {
        const int m2 = (m + NGW < TT) ? m + NGW : m;
        const f32x4* xr = (const f32x4*)(P.x + (size_t)m * DM) + lane; const f32x4* xr2 = (const f32x4*)(P.x + (size_t)m2 * DM) + lane; f32x4 v[4], v2[4]; float s = 0.f, s2 = 0.f;
#pragma unroll
        for (int j = 0; j < 4; ++j) { v[j] = xr[64 * j]; v2[j] = xr2[64 * j]; }
#pragma unroll
        for (int j = 0; j < 4; ++j) { s += (v[j].x * v[j].x + v[j].y * v[j].y) + (v[j].z * v[j].z + v[j].w * v[j].w); s2 += (v2[j].x * v2[j].x + v2[j].y * v2[j].y) + (v2[j].z * v2[j].z + v2[j].w * v2[j].w); }
        const float rstd = rsqrtf(wave_sum(s) * (1.0f / DM) + NORM_EPS), rstd2 = rsqrtf(wave_sum(s2) * (1.0f / DM) + NORM_EPS);
        u32x2* o8 = (u32x2*)(H + (size_t)m * DM) + lane; u32x2* o82 = (u32x2*)(H + (size_t)m2 * DM) + lane;
#pragma unroll
        for (int j = 0; j < 4; ++j) { const f32x4 w4 = ((const f32x4*)P.norm_w)[lane + 64 * j];
            o8[64 * j] = (u32x2){pk_bf16(v[j].x * rstd * w4.x, v[j].y * rstd * w4.y), pk_bf16(v[j].z * rstd * w4.z, v[j].w * rstd * w4.w)};
            o82[64 * j] = (u32x2){pk_bf16(v2[j].x * rstd2 * w4.x, v2[j].y * rstd2 * w4.y), pk_bf16(v2[j].z * rstd2 * w4.z, v2[j].w * rstd2 * w4.w)}; }
    }
    float* cosT = (float*)(P.ws + WS_COS); float* sinT = (float*)(P.ws + WS_SIN);
    for (int e = (vcu * 512 + tid); e < TT * 32; e += G * 512) {
        const int row = e >> 5, j = e & 31;
        const float inv = exp2f(-(float)j * (13.287712379549449f / 32.0f));
        const float ang = (float)P.pos[row] * inv;
        const double rev = (double)ang * 0.15915494309189535; const float fr = (float)(rev - __builtin_rint(rev));
        cosT[e] = __builtin_amdgcn_cosf(fr); sinT[e] = __builtin_amdgcn_sinf(fr);
    }
}

#define LBAR() asm volatile("s_waitcnt lgkmcnt(0)\n\ts_barrier" ::: "memory")
__device__ __forceinline__ void attn_phase(LAS unsigned char* lds, const u16* ZB, u16* OG, float* LSE, int bid, int G) {
    const int tid = threadIdx.x, lane = tid & 63, w = __builtin_amdgcn_readfirstlane(tid >> 6), l15 = lane & 15, q4 = lane >> 4, sb = w >> 2, wq = w & 3;
    constexpr int KP = 72;
    LAS u16* KI = (LAS u16*)lds; LAS u16* VI = (LAS u16*)(lds + 384 * KP * 2);
    u32x4 kr[6], vr[6]; bf16x8 qn[2][2];
#define AT_DEC(un_) const int b_ = (un_) / 192, rem_ = (un_) % 192, g_ = rem_ >> 6, h_ = (rem_ >> 3) & 7, su_ = rem_ & 7; \
        const int d_ = (g_ == 0) ? 1 : (g_ == 1 ? 4 : 16); const size_t tb_ = (size_t)b_ * SEQ; \
        const int r0_ = (g_ == 0) ? 0 : (g_ == 1 ? (su_ >> 1) : 2 * su_), c0_ = (g_ == 0) ? 2 * su_ : (g_ == 1 ? 2 * (su_ & 1) : 0); \
        const int rq_ = (g_ == 2) ? r0_ + sb : r0_, cq_ = (g_ == 2) ? 0 : c0_ + sb;
#define AT_LOAD(un_) do { AT_DEC(un_) \
        _Pragma("unroll") for (int i = 0; i < 6; ++i) { const int id = tid + 512 * i, j = id >> 3, ch = id & 7; \
            const int mp = (g_ == 2) ? (j & 127) : 128 * (c0_ - 1) + j, rr = (g_ == 2) ? r0_ + (j >> 7) : r0_; \
            kr[i] = (u32x4){0u, 0u, 0u, 0u}; vr[i] = (u32x4){0u, 0u, 0u, 0u}; \
            if (mp >= 0 && (g_ != 2 || j < 256)) { const size_t tk_ = tb_ + (size_t)mp * d_ + rr; kr[i] = *(const u32x4*)(ZB + ((size_t)(24 + g_ * 8 + h_) * TT + tk_) * 64 + 8 * ch); vr[i] = *(const u32x4*)(ZB + ((size_t)(48 + g_ * 8 + h_) * TT + tk_) * 64 + 8 * ch); } } \
        _Pragma("unroll") for (int qt = 0; qt < 2; ++qt) { const size_t tq_ = tb_ + (size_t)(128 * cq_ + 32 * wq + 16 * qt + l15) * d_ + rq_; \
            _Pragma("unroll") for (int ds = 0; ds < 2; ++ds) qn[qt][ds] = *(const bf16x8*)(ZB + ((size_t)(g_ * 8 + h_) * TT + tq_) * 64 + 32 * ds + 8 * q4); } } while (0)
    const bool xl = (G == 256); const int ustep = xl ? 32 : G, ubase = xl ? (bid & 7) * 192 : 0, ulim = xl ? ubase + 192 : 1536;
    { const int u0 = ubase + (xl ? (bid >> 3) : bid); AT_LOAD((u0 < ulim ? u0 : ulim - 1)); }
    for (int un = ubase + (xl ? (bid >> 3) : bid); un < ulim; un += ustep) {
        AT_DEC(un)
        const int g = g_, h = h_; const bool prev_ok = (g_ != 2) && (cq_ > 0); const int wbase = (g_ == 2) ? 128 * sb - 128 : 128 * sb;
        size_t tq[2];
#pragma unroll
        for (int qt = 0; qt < 2; ++qt) tq[qt] = tb_ + (size_t)(128 * cq_ + 32 * wq + 16 * qt + l15) * d_ + rq_;
#pragma unroll
        for (int i = 0; i < 6; ++i) { const int id = tid + 512 * i, j = id >> 3, ch = id & 7; *(LAS u32x4*)(KI + j * KP + 8 * ch) = kr[i]; *(LAS u32x4*)(VI + j * KP + 8 * ch) = vr[i]; }
        bf16x8 qf[2][2];
#pragma unroll
        for (int qt = 0; qt < 2; ++qt) { qf[qt][0] = qn[qt][0]; qf[qt][1] = qn[qt][1]; }
        LBAR();
        { const int nx = (un + ustep < ulim) ? un + ustep : un; AT_LOAD(nx); }
        f32x4 st[5][2][2]; float mx[2] = {-INFINITY, -INFINITY};
#pragma unroll
        for (int p = 0; p < 5; ++p) { const int a = wq + p; const bool on = prev_ok || a >= 4;
#pragma unroll
            for (int t = 0; t < 2; ++t) {
                if (on) { const int j0 = 32 * a + 16 * t, k = 2 * p + t; f32x4 s0 = (f32x4){0.f, 0.f, 0.f, 0.f}, s1 = (f32x4){0.f, 0.f, 0.f, 0.f};
#pragma unroll
                    for (int ds = 0; ds < 2; ++ds) { const bf16x8 kf = *(const LAS bf16x8*)(KI + (wbase + j0 + l15) * KP + 32 * ds + 8 * q4); if (k <= 8) s0 = mfma16(kf, qf[0][ds], s0); if (k >= 1) s1 = mfma16(kf, qf[1][ds], s1); }
#pragma unroll
                    for (int i = 0; i < 4; ++i) { const int kk = 4 * q4 + i;
                        if (k == 0) s0[i] = (kk >= l15) ? s0[i] : -INFINITY; if (k == 8) s0[i] = (kk <= l15) ? s0[i] : -INFINITY; if (k == 9) s0[i] = -INFINITY;
                        if (k == 1) s1[i] = (kk >= l15) ? s1[i] : -INFINITY; if (k == 9) s1[i] = (kk <= l15) ? s1[i] : -INFINITY; if (k == 0) s1[i] = -INFINITY;
                        mx[0] = fmaxf(mx[0], s0[i]); mx[1] = fmaxf(mx[1], s1[i]); }
                    st[p][t][0] = s0; st[p][t][1] = s1;
                } else { st[p][t][0] = (f32x4){-INFINITY, -INFINITY, -INFINITY, -INFINITY}; st[p][t][1] = st[p][t][0]; } } }
        float l[2] = {0.f, 0.f}; bf16x8 pf[5][2];
#pragma unroll
        for (int qt = 0; qt < 2; ++qt) { mx[qt] = fmaxf(mx[qt], __shfl_xor(mx[qt], 16)); mx[qt] = fmaxf(mx[qt], __shfl_xor(mx[qt], 32)); }
#pragma unroll
        for (int p = 0; p < 5; ++p)
#pragma unroll
            for (int qt = 0; qt < 2; ++qt) { float e[8];
#pragma unroll
                for (int t = 0; t < 2; ++t)
#pragma unroll
                    for (int i = 0; i < 4; ++i) { e[4 * t + i] = __builtin_amdgcn_exp2f(st[p][t][qt][i] - mx[qt]); l[qt] += e[4 * t + i]; }
                u32x4 pw; pw.x = pk_bf16(e[0], e[1]); pw.y = pk_bf16(e[2], e[3]); pw.z = pk_bf16(e[4], e[5]); pw.w = pk_bf16(e[6], e[7]); pf[p][qt] = __builtin_bit_cast(bf16x8, pw); }
#pragma unroll
        for (int qt = 0; qt < 2; ++qt) { l[qt] += __shfl_xor(l[qt], 16); l[qt] += __shfl_xor(l[qt], 32); }
        f32x4 o[4][2];
#pragma unroll
        for (int dt = 0; dt < 4; ++dt) { o[dt][0] = (f32x4){0.f, 0.f, 0.f, 0.f}; o[dt][1] = (f32x4){0.f, 0.f, 0.f, 0.f}; }
#pragma unroll
        for (int p = 0; p < 5; ++p) { const int a = wq + p; const bool on = prev_ok || a >= 4;
            if (on) {
#pragma unroll
                for (int dt = 0; dt < 4; ++dt) { const LAS u16* vp = VI + (wbase + 32 * a + 4 * q4 + (l15 >> 2)) * KP + 16 * dt + 4 * (l15 & 3);
                    const s16x4 lo = ds_tr(vp), hi = ds_tr(vp + 16 * KP); const bf16x8 vf = cat8(lo, hi); o[dt][0] = mfma16(vf, pf[p][0], o[dt][0]); o[dt][1] = mfma16(vf, pf[p][1], o[dt][1]); } } }
        LAS u16* stg = (LAS u16*)(lds + 2 * 384 * KP * 2 + w * 4608);
#pragma unroll
        for (int qt = 0; qt < 2; ++qt) { const float il = 1.0f / l[qt];
#pragma unroll
            for (int dt = 0; dt < 4; ++dt) *(LAS u32x2*)(stg + (16 * qt + l15) * 72 + 16 * dt + 4 * q4) = (u32x2){pk_bf16(o[dt][qt][0] * il, o[dt][qt][1] * il), pk_bf16(o[dt][qt][2] * il, o[dt][qt][3] * il)};
            if (q4 == 0) LSE[(size_t)g * TT * 8 + tq[qt] * 8 + h] = mx[qt] + __log2f(l[qt]); }
        asm volatile("s_waitcnt lgkmcnt(0)" ::: "memory");
#pragma unroll
        for (int i = 0; i < 4; ++i) { const int row = i * 8 + (lane >> 3), ch = lane & 7; const u32x4 v = *(const LAS u32x4*)(stg + row * 72 + 8 * ch);
            const size_t tr = tb_ + (size_t)(128 * cq_ + 32 * wq + row) * d_ + rq_;
            *(u32x4*)(OG + (size_t)g * TT * 512 + tr * 512 + h * 64 + 8 * ch) = v; }
        LBAR();
    }
#undef AT_DEC
#undef AT_LOAD
}
__device__ __forceinline__ void merge_phase(u16* OG, const float* LSE, const u16* AG, int bid, int nb) {
    for (int idx = bid * 512 + threadIdx.x; idx < TT * 64; idx += nb * 512) {
        const int tok = idx >> 6, h = (idx >> 3) & 7, ch = idx & 7; const size_t off = (size_t)tok * 512 + h * 64 + 8 * ch;
        const float l0 = LSE[(size_t)tok * 8 + h], l1 = LSE[(size_t)TT * 8 + (size_t)tok * 8 + h], l2 = LSE[(size_t)2 * TT * 8 + (size_t)tok * 8 + h];
        const float m = fmaxf(l0, fmaxf(l1, l2)); float w0 = __builtin_amdgcn_exp2f(l0 - m), w1 = __builtin_amdgcn_exp2f(l1 - m), w2 = __builtin_amdgcn_exp2f(l2 - m);
        const float inv = 1.0f / (w0 + w1 + w2); w0 *= inv; w1 *= inv; w2 *= inv;
        const u32x4 a = *(const u32x4*)(OG + off), bq = *(const u32x4*)(OG + (size_t)TT * 512 + off), cq = *(const u32x4*)(OG + (size_t)2 * TT * 512 + off), gq = *(const u32x4*)(AG + off);
        u32x4 o;
#define MRG(F) o.F = pk_bf16((w0 * bflo(a.F) + w1 * bflo(bq.F) + w2 * bflo(cq.F)) * bflo(gq.F), (w0 * bfhi(a.F) + w1 * bfhi(bq.F) + w2 * bfhi(cq.F)) * bfhi(gq.F))
        MRG(x); MRG(y); MRG(z); MRG(w);
#undef MRG
        store16_wt(OG + off, o);
    }
}

template <int MODE = 0> __device__ __forceinline__ void hgrn_unit(LAS unsigned char* lds, int b, int h, const u16* QA, const u16* GG, const u16* VA, const u16* HG, const float* nw, u16* OA, unsigned* dcnt) {
    const int tid = threadIdx.x, lane = tid & 63, w = __builtin_amdgcn_readfirstlane(tid >> 6), l15 = lane & 15, q4 = lane >> 4;
    constexpr int P = 136, IMGB = 52224;
    LAS u16* SB = (LAS u16*)(lds + 104448); LAS float* TOT = (LAS float*)(lds + 139264); LAS float* DFB = (LAS float*)(lds + 143360); LAS float* SSQ = (LAS float*)(lds + 146432);
    f32x4 S[8];
#pragma unroll
    for (int i = 0; i < 8; ++i) S[i] = (f32x4){0.f, 0.f, 0.f, 0.f};
    const int kp = lane, seg = w, tt = (w < 4) ? (w >> 1) : 3 - ((w - 4) >> 1), vh = w & 1;
    const size_t tok0 = (size_t)b * SEQ, hbase = (size_t)(b * 8 + h) * SEQ;
    unsigned gq0[8], qq0[8], gq1[8], qq1[8]; u32x4 vv0[2], vv1[2]; u32x2 hg0[4], hg1[4];
    f32x4 O[4]; float sqp = 0.f;
#pragma unroll
    for (int j = 0; j < 4; ++j) O[j] = (f32x4){0.f, 0.f, 0.f, 0.f};
#define HG_LOAD(c, gq, qq, vv) do { const size_t t0_ = tok0 + 64 * (c); \
        const size_t hb_ = hbase + 64 * (c); \
        _Pragma("unroll") for (int i = 0; i < 8; ++i) { const size_t o_ = (t0_ + 8 * seg + i) * 1024 + h * 128 + 2 * kp; gq[i] = *(const unsigned*)(GG + (hb_ + 8 * seg + i) * 128 + 2 * kp); qq[i] = *(const unsigned*)(QA + o_); } \
        _Pragma("unroll") for (int u_ = 0; u_ < 2; ++u_) { const int id_ = tid + 512 * u_; vv[u_] = *(const u32x4*)(VA + (hb_ + (id_ >> 4)) * 128 + 8 * (id_ & 15)); } } while (0)
#define HG_LOADG(c, hgv) do { const size_t tq_ = hbase + 64 * (c) + 16 * tt + l15; \
        _Pragma("unroll") for (int j = 0; j < 4; ++j) hgv[j] = *(const u32x2*)(HG + tq_ * 128 + 16 * (4 * vh + j) + 4 * q4); } while (0)
#define HG_PREP1(gq) do { float r0_ = 1.f, r1_ = 1.f; \
        _Pragma("unroll") for (int i = 0; i < 8; ++i) { r0_ *= f16lo(gq[i]); r1_ *= f16hi(gq[i]); } \
        *(LAS f32x2*)(TOT + seg * 128 + 2 * kp) = (f32x2){__log2f(r0_), __log2f(r1_)}; } while (0)
#define HG_PREP2(buf, gq, qq, vv) do { LAS u16* QM_ = (LAS u16*)(lds + (buf) * IMGB); LAS u16* KM_ = (LAS u16*)(lds + (buf) * IMGB + 17408); LAS u16* VI_ = (LAS u16*)(lds + (buf) * IMGB + 34816); LAS float* DF_ = DFB + (buf) * 384; \
        float off0 = 0.f, off1 = 0.f, br0 = 0.f, br1 = 0.f, bl0 = 0.f, bl1 = 0.f; \
        _Pragma("unroll") for (int s2 = 0; s2 < 8; ++s2) { const f32x2 t_ = *(const LAS f32x2*)(TOT + s2 * 128 + 2 * kp); \
            if (s2 < seg) { off0 += t_.x; off1 += t_.y; } if (s2 < 4) { br0 += t_.x; br1 += t_.y; } bl0 += t_.x; bl1 += t_.y; } \
        off0 -= br0; off1 -= br1; \
        float E0 = __builtin_amdgcn_exp2f(fminf(off0, 115.f)), E1 = __builtin_amdgcn_exp2f(fminf(off1, 115.f)), I0 = __builtin_amdgcn_exp2f(fminf(-off0, 115.f)), I1 = __builtin_amdgcn_exp2f(fminf(-off1, 115.f)); \
        _Pragma("unroll") for (int i = 0; i < 8; ++i) { const int s_ = 8 * seg + i; const float f0_ = f16lo(gq[i]), f1_ = f16hi(gq[i]); \
            E0 *= f0_; E1 *= f1_; I0 *= __builtin_amdgcn_rcpf(f0_); I1 *= __builtin_amdgcn_rcpf(f1_); \
            *(LAS unsigned*)(QM_ + s_ * P + 2 * kp) = pk_bf16(bflo(qq[i]) * E0, bfhi(qq[i]) * E1); \
            *(LAS unsigned*)(KM_ + s_ * P + 2 * kp) = pk_bf16((1.0f - f0_) * I0, (1.0f - f1_) * I1); } \
        if (seg == 0) { *(LAS f32x2*)(DF_ + 2 * kp) = (f32x2){__builtin_amdgcn_exp2f(bl0), __builtin_amdgcn_exp2f(bl1)}; *(LAS f32x2*)(DF_ + 128 + 2 * kp) = (f32x2){__builtin_amdgcn_exp2f(bl0 - br0), __builtin_amdgcn_exp2f(bl1 - br1)}; *(LAS f32x2*)(DF_ + 256 + 2 * kp) = (f32x2){__builtin_amdgcn_exp2f(br0), __builtin_amdgcn_exp2f(br1)}; } \
        _Pragma("unroll") for (int u_ = 0; u_ < 2; ++u_) { const int id_ = tid + 512 * u_; *(LAS u32x4*)(VI_ + (id_ >> 4) * P + 8 * (id_ & 15)) = vv[u_]; } } while (0)
#define HG_STAGE(hgv) do { \
        _Pragma("unroll") for (int j = 0; j < 4; ++j) { const f32x4 n4 = nwv[j]; const int row_ = 16 * tt + l15, c16_ = 2 * (4 * vh + j) + (q4 >> 1); \
            *(LAS u32x2*)(STG + row_ * 256 + ((c16_ ^ l15) << 4) + 8 * (q4 & 1)) = (u32x2){pk_bf16(O[j][0] * n4[0] * bflo(hgv[j].x), O[j][1] * n4[1] * bfhi(hgv[j].x)), \
                                                                                         pk_bf16(O[j][2] * n4[2] * bflo(hgv[j].y), O[j][3] * n4[3] * bfhi(hgv[j].y))}; } } while (0)
#define HG_COPY(c) do { \
        _Pragma("unroll") for (int u_ = 0; u_ < 2; ++u_) { const int id_ = tid + 512 * u_, row_ = id_ >> 4, ch_ = id_ & 15; \
            const float sc_ = rsqrtf((SSQ[((row_ >> 4) * 2) * 16 + (row_ & 15)] + SSQ[((row_ >> 4) * 2 + 1) * 16 + (row_ & 15)]) * (1.0f / 128.0f) + NORM_EPS); \
            const u32x4 v_ = *(const LAS u32x4*)(STG + row_ * 256 + ((ch_ ^ (row_ & 15)) << 4)); u32x4 o_; \
            o_.x = pk_bf16(bflo(v_.x) * sc_, bfhi(v_.x) * sc_); o_.y = pk_bf16(bflo(v_.y) * sc_, bfhi(v_.y) * sc_); o_.z = pk_bf16(bflo(v_.z) * sc_, bfhi(v_.z) * sc_); o_.w = pk_bf16(bflo(v_.w) * sc_, bfhi(v_.w) * sc_); \
            if (MODE & 8) { dacc_ ^= o_.x ^ o_.w; } else *(u32x4*)(OA + (tok0 + 64 * (c) + row_) * 1024 + h * 128 + 8 * ch_) = o_; } } while (0)
    unsigned dacc_ = 0u;
    LAS unsigned char* STG = lds + 146944;
    f32x4 nwv[4];
#pragma unroll
    for (int j = 0; j < 4; ++j) nwv[j] = *(const f32x4*)(nw + 16 * (4 * vh + j) + 4 * q4);
    HG_LOAD(0, gq0, qq0, vv0); HG_LOADG(0, hg0); HG_LOADG(0, hg1); if (tid < 128) SSQ[tid] = 1.0f; HG_PREP1(gq0); LBAR(); HG_PREP2(0, gq0, qq0, vv0);
    for (int i = tid; i < 128 * P / 2; i += 512) ((LAS unsigned*)SB)[i] = 0u;
    HG_LOAD(1, gq1, qq1, vv1); HG_LOAD(2, gq0, qq0, vv0); LBAR(); HG_PREP1(gq1); LBAR();
#ifdef PROBE_ACC
    unsigned tacc_ = 0u, tlast_ = (unsigned)__builtin_amdgcn_s_memrealtime();
#define HG_T(k) do { if (blockIdx.x == 0 && tid == 448) { const unsigned n_ = (unsigned)__builtin_amdgcn_s_memrealtime(); if ((k) == PROBE_ACC) tacc_ += n_ - tlast_; tlast_ = n_; } } while (0)
#else
#define HG_T(k) do {} while (0)
#endif
#define HG_STEP(c, G2, Q2, V2, G1, HGU, HGL) do { HG_T(2); \
        const int cur = (c) & 1, nxt = cur ^ 1; \
        const LAS u16* QM = (const LAS u16*)(lds + cur * IMGB); const LAS u16* KM = (const LAS u16*)(lds + cur * IMGB + 17408); const LAS u16* VI = (const LAS u16*)(lds + cur * IMGB + 34816); const LAS float* DF = DFB + cur * 384; \
        if (!(MODE & 4)) HG_COPY(((c) > 0 ? (c) - 1 : 0)); \
        if (!(MODE & 2)) HG_PREP2(nxt, G2, Q2, V2); HG_LOADG(((c) + 1 < 32 ? (c) + 1 : 31), HGL); \
        HG_LOAD(((c) + 3 < 32 ? (c) + 3 : 31), G2, Q2, V2); HG_T(0); \
        if (!(MODE & 1)) { \
        bf16x8 qm[4]; \
        _Pragma("unroll") for (int ks = 0; ks < 4; ++ks) qm[ks] = *(const LAS bf16x8*)(QM + (16 * tt + l15) * P + 32 * ks + 8 * q4); \
        f32x4 Dm[4]; \
        _Pragma("unroll") for (int st = 0; st < 4; ++st) { Dm[st] = (f32x4){0.f, 0.f, 0.f, 0.f}; \
            _Pragma("unroll") for (int ks = 0; ks < 4; ++ks) { const bf16x8 kf = *(const LAS bf16x8*)(KM + (16 * st + l15) * P + 32 * ks + 8 * q4); Dm[st] = mfma16(kf, qm[ks], Dm[st]); } \
            _Pragma("unroll") for (int i = 0; i < 4; ++i) { const bool keep_ = (st < tt) || (st == tt && 4 * q4 + i <= l15); Dm[st][i] = keep_ ? Dm[st][i] : 0.f; } } \
        bf16x8 pf[2]; \
        _Pragma("unroll") for (int a = 0; a < 2; ++a) { u32x4 pw; pw.x = pk_bf16(Dm[2 * a][0], Dm[2 * a][1]); pw.y = pk_bf16(Dm[2 * a][2], Dm[2 * a][3]); pw.z = pk_bf16(Dm[2 * a + 1][0], Dm[2 * a + 1][1]); pw.w = pk_bf16(Dm[2 * a + 1][2], Dm[2 * a + 1][3]); pf[a] = __builtin_bit_cast(bf16x8, pw); } \
        _Pragma("unroll") for (int j = 0; j < 4; ++j) { const int vt = 4 * vh + j; f32x4 o = (f32x4){0.f, 0.f, 0.f, 0.f}; \
            _Pragma("unroll") for (int a = 0; a < 2; ++a) { const LAS u16* vp = VI + (32 * a + 4 * q4 + (l15 >> 2)) * P + 16 * vt + 4 * (l15 & 3); \
                const s16x4 lo = ds_tr(vp), hi = ds_tr(vp + 16 * P); o = mfma16(cat8(lo, hi), pf[a], o); } \
            _Pragma("unroll") for (int ks = 0; ks < 4; ++ks) { const bf16x8 sf = *(const LAS bf16x8*)(SB + (16 * vt + l15) * P + 32 * ks + 8 * q4); o = mfma16(sf, qm[ks], o); } \
            O[j] = o; } \
        { bf16x8 ka[2]; \
            _Pragma("unroll") for (int a = 0; a < 2; ++a) { const LAS u16* kpp = KM + (32 * a + 8 * q4 + (l15 >> 2)) * P + 16 * w + 4 * (l15 & 3); const s16x4 lo = ds_tr(kpp), hi = ds_tr(kpp + 4 * P); ka[a] = cat8(lo, hi); } \
            const f32x4 d1 = *(const LAS f32x4*)(DF + 16 * w + 4 * q4), d2 = *(const LAS f32x4*)(DF + 128 + 16 * w + 4 * q4); \
            _Pragma("unroll") for (int vt = 0; vt < 8; ++vt) { f32x4 U = (f32x4){0.f, 0.f, 0.f, 0.f}; \
                _Pragma("unroll") for (int a = 0; a < 2; ++a) { const LAS u16* vp = VI + (32 * a + 8 * q4 + (l15 >> 2)) * P + 16 * vt + 4 * (l15 & 3); const s16x4 lo = ds_tr(vp), hi = ds_tr(vp + 4 * P); U = mfma16(ka[a], cat8(lo, hi), U); } \
                S[vt] = d1 * S[vt] + d2 * U; } } \
        { float sq = 0.f; \
            _Pragma("unroll") for (int j = 0; j < 4; ++j) sq += (O[j][0] * O[j][0] + O[j][1] * O[j][1]) + (O[j][2] * O[j][2] + O[j][3] * O[j][3]); \
            sq += __shfl_xor(sq, 16); sq += __shfl_xor(sq, 32); sqp = sq; } } \
        HG_T(1); \
        LBAR(); HG_T(2); \
        { const f32x4 eb = *(const LAS f32x4*)(DFB + nxt * 384 + 256 + 16 * w + 4 * q4); \
            _Pragma("unroll") for (int vt = 0; vt < 8; ++vt) *(LAS u32x2*)(SB + (16 * vt + l15) * P + 16 * w + 4 * q4) = (u32x2){pk_bf16(S[vt][0] * eb[0], S[vt][1] * eb[1]), pk_bf16(S[vt][2] * eb[2], S[vt][3] * eb[3])}; } \
        if (q4 == 0) SSQ[(tt * 2 + vh) * 16 + l15] = sqp; \
        if (!(MODE & 4)) HG_STAGE(HGU); \
        if (!(MODE & 2)) HG_PREP1(G1); HG_T(3); \
        LBAR(); } while (0)
    for (int c = 0; c < 32; c += 2) {
        if (c == 20 && dcnt) {
            if (tid == 0) { unsigned sp = 0u;
                while (__hip_atomic_load(dcnt + 64 * (8 * b + 6), __ATOMIC_RELAXED, __HIP_MEMORY_SCOPE_AGENT) < 16u || __hip_atomic_load(dcnt + 64 * (8 * b + 7), __ATOMIC_RELAXED, __HIP_MEMORY_SCOPE_AGENT) < 16u) { __builtin_amdgcn_s_sleep(2); if (++sp > (1u << 22)) break; }
                __builtin_amdgcn_fence(__ATOMIC_ACQUIRE, "agent"); asm volatile("s_waitcnt vmcnt(0)" ::: "memory"); }
            LBAR(); }
        HG_STEP(c, gq1, qq1, vv1, gq0, hg0, hg1);
        HG_STEP(c + 1, gq0, qq0, vv0, gq1, hg1, hg0);
    }
    HG_COPY(31);
    if (MODE & 8) { if (dacc_ == 0x12345678u) OA[tid] = (u16)dacc_; }
#ifdef PROBE_ACC
    if (blockIdx.x == 0 && tid == 448) ((LAS unsigned long long*)(lds + 163344))[10] = (unsigned long long)tacc_;
#endif
#undef HG_STEP
#undef HG_LOAD
#undef HG_LOADG
#undef HG_PREP1
#undef HG_PREP2
#undef HG_STAGE
#undef HG_COPY
    LBAR();
}

#define XB_TMO      128
#define XB_XCNT(j)  (256  + 64 * (j))
#define XB_XSUB(j)  (1280 + 64 * (j))
#define XB_XGEN(j)  (2304 + 64 * (j))
#define XB_TOP      3328
#define XB_TOPGEN   3392
#define XCD_BAR_WORDS 3456
#define XB_SPIN_CAP (1u << 18)

__device__ __forceinline__ unsigned xb_ld(unsigned* p)              { return __hip_atomic_load(p, __ATOMIC_RELAXED, __HIP_MEMORY_SCOPE_AGENT); }
__device__ __forceinline__ unsigned xb_add(unsigned* p, unsigned v) { return __hip_atomic_fetch_add(p, v, __ATOMIC_RELAXED, __HIP_MEMORY_SCOPE_AGENT); }
__device__ __forceinline__ unsigned xb_xcc_id() { return (unsigned)__builtin_amdgcn_s_getreg((3 << 11) | 20) & 0xFu; }
#define XB_SPIN(cond, bar) do { unsigned _sp = 0; while (cond) { __builtin_amdgcn_s_sleep(1); \
    if ((++_sp & 255u) == 0u) { if (xb_ld(&(bar)[XB_TMO])) break; if (_sp > XB_SPIN_CAP) { atomicAdd(&(bar)[XB_TMO], 1u); break; } } } } while (0)

struct XcdBarrier {
    unsigned* bar; unsigned x;
    volatile LAS unsigned* st;
};

__device__ __forceinline__ XcdBarrier xcd_barrier_post(unsigned* bar, volatile LAS unsigned* st) {
    XcdBarrier b; b.bar = bar; b.x = xb_xcc_id(); b.st = st;
    if (threadIdx.x == 0) (void)xb_add(&bar[XB_XCNT(b.x)], 1u);
    return b;
}
__device__ __forceinline__ void xcd_barrier_complete(unsigned* bar, unsigned x, unsigned& nloc, unsigned& nx) {
    const unsigned G = gridDim.x * gridDim.y * gridDim.z;
    unsigned sum, cnt, mine, sp = 0u;
    for (;;) {
        sum = 0u; cnt = 0u; mine = 0u;
#pragma unroll
        for (unsigned j = 0; j < 16; ++j) { const unsigned c = xb_ld(&bar[XB_XCNT(j)]); sum += c; cnt += (c > 0u) ? 1u : 0u; mine = (j == x) ? c : mine; }
        if (sum == G) break;
        __builtin_amdgcn_s_sleep(1);
        if ((++sp & 255u) == 0u) { if (xb_ld(&bar[XB_TMO])) break; if (sp > XB_SPIN_CAP) { atomicAdd(&bar[XB_TMO], 1u); break; } }
    }
    nloc = mine > 0u ? mine : 1u; nx = cnt > 0u ? cnt : 1u;
}

__device__ __forceinline__ void xcd_barrier(const XcdBarrier& b) {
    asm volatile("s_waitcnt vmcnt(0)" ::: "memory");
    __syncthreads();
    if (threadIdx.x == 0) {
        unsigned* bar = b.bar;
        __builtin_amdgcn_s_waitcnt(0);
        unsigned nloc = b.st[0], nx = b.st[1];
        if (nloc == 0u) { xcd_barrier_complete(bar, b.x, nloc, nx); b.st[0] = nloc; b.st[1] = nx; }
        const unsigned old = xb_add(&bar[XB_XSUB(b.x)], 1u);
        const unsigned gen = old / nloc;
        if (old + 1u == (gen + 1u) * nloc) {
            __builtin_amdgcn_fence(__ATOMIC_RELEASE, "agent");
            asm volatile("s_waitcnt vmcnt(0)" ::: "memory");
            const unsigned og = xb_add(&bar[XB_TOP], 1u);
            const unsigned tg = og / nx;
            if (og + 1u == (tg + 1u) * nx) xb_add(&bar[XB_TOPGEN], 1u);
            else XB_SPIN(xb_ld(&bar[XB_TOPGEN]) == tg, bar);
            __builtin_amdgcn_fence(__ATOMIC_ACQUIRE, "agent");
            xb_add(&bar[XB_XGEN(b.x)], 1u);
            asm volatile("s_waitcnt vmcnt(0)" ::: "memory");
        } else {
            XB_SPIN(xb_ld(&bar[XB_XGEN(b.x)]) == gen, bar);
            __builtin_amdgcn_fence(__ATOMIC_ACQUIRE, "agent");
            asm volatile("s_waitcnt vmcnt(0)" ::: "memory");
        }
    }
    __syncthreads();
}

struct Args { const float* in[10]; float* out; unsigned char* ws; int ph_lo, ph_hi; };
__global__ void __launch_bounds__(512, 2) fwd_megakernel(Args a) {
    extern __shared__ __attribute__((aligned(16))) unsigned char lds_raw[];
    LAS unsigned char* lds = (LAS unsigned char*)lds_raw;
    cg::grid_group grid = cg::this_grid();
    const int G = gridDim.x, bx = blockIdx.x, vcu = (G % 8 == 0) ? (bx % 8) * (G / 8) + bx / 8 : bx;
    const int tid = threadIdx.x, lane = tid & 63, wave = __builtin_amdgcn_readfirstlane(tid >> 6);
    Ptrs P; P.x = a.in[0]; P.pos = (const int*)a.in[1]; P.norm_w = a.in[2]; P.w_in = a.in[3]; P.lbl = a.in[4]; P.hnw = a.in[5]; P.wa = a.in[6]; P.wb = a.in[7]; P.wo = a.in[8]; P.fnw = a.in[9];
    P.out = a.out; P.ws = a.ws;
    unsigned char* ws = a.ws; unsigned char* dout = (unsigned char*)a.out;
    const int lo = a.ph_lo, hi = a.ph_hi;
#ifndef REP_MASK
#define REP_MASK 0
#endif
#define IN(k) (lo <= (k) && (k) < hi)
#define REPS(k) for (int rep_ = 0; rep_ < 1 + ((REP_MASK >> (k)) & 1); ++rep_)
#ifdef PROBE_K
#ifndef PROBE_A
#define PROBE_A PROBE_K
#define PROBE_B (PROBE_K + 1)
#endif
#define STAMP(k) do { if (bx == 0 && tid == 0) ((LAS unsigned long long*)(lds + 163344))[k] = __builtin_amdgcn_s_memrealtime(); } while (0)
#else
#define STAMP(k) do {} while (0)
#endif
#define SEAM(k) do { if (IN(k) && IN((k) + 1)) xcd_barrier(bar); STAMP((k) + 1); } while (0)
    if (tid < 4) ((LAS unsigned*)(lds + 163328))[tid] = 0u;
    __syncthreads();
    const XcdBarrier bar = xcd_barrier_post((unsigned*)(ws + WS_BAR), (volatile LAS unsigned*)(lds + 163328));
    if (a.ph_hi > 1000) grid.sync();
    STAMP(0);
    if (IN(0)) REPS(0) p0_prologue(P, lds, vcu, G);
    SEAM(0);
#ifdef EXTRA_SYNCS
    for (int i_ = 0; i_ < EXTRA_SYNCS; ++i_) xcd_barrier(bar);
#endif
    if (IN(1)) REPS(1) { pg8::Gemm g{(const u16*)(ws + WS_H), (const u16*)(ws + WS_WT) + (size_t)6144 * 1024, TT, 5120, 1024}; pg8::StaticOrder S; S.init(TT, 5120, G, bx);
        EpiZ E{0, ws, dout, P.lbl}; pg8::gemm_phase<EpiZ, pg8::StaticOrder, true, true>(lds, g, S, E); }
    SEAM(1);
    if (IN(2)) REPS(2) attn_phase(lds, (const u16*)(ws + WS_Z), (u16*)(dout + DO_OG), (float*)(ws + WS_COS), bx, G);
    SEAM(2);
    if (IN(3)) {
        pg8::Gemm g{(const u16*)(ws + WS_H), (const u16*)(ws + WS_WT), TT, 4096, 1024}; DefOrder S; S.base.init(48 * 256, 4096, G, bx);
        EpiZ E{1, ws, dout, P.lbl}; pg8::gemm_phase<EpiZ, DefOrder, true, true>(lds, g, S, E); }
    SEAM(3);
    if (IN(4)) {
        {
            if (bx < 64) { hgrn_unit(lds, bx & 7, bx >> 3, (const u16*)(ws + Z_QA), (const u16*)(ws + Z_G), (const u16*)(ws + Z_VA), (const u16*)(ws + Z_HG), P.hnw, (u16*)(ws + Z_QA), (unsigned*)(ws + WS_BAR + 36864)); STAMP(9);
            }
            else { const int x = bx & 7, r = (bx >> 3) - 8;
                const pg8::Gemm gG{(const u16*)(ws + WS_H), (const u16*)(ws + WS_WT) + (size_t)4096 * 1024, TT, 2048, 1024}; const pg8::Gemm gB{(const u16*)(dout + DO_OG), (const u16*)(ws + WS_WB), TT, 1024, 512};
                const EpiZ EG{2, ws, dout, P.lbl}; const EpiGateB EB{(const u16*)(ws + Z_GATES), (u16*)(dout + DO_TMPB)};
                unsigned lg, lb2;
                if (r < 8) { lg = lo_code(r, 4) | (lo_code(r + 24, 4) << 8) | 0xffff0000u; lb2 = lo_code(r, 0) | (lo_code(r + 24, 0) << 8) | 0xffff0000u; }
                else { lg = lo_code(r, 4) | (lo_code(2 * (r - 8), 0) << 8) | (lo_code(2 * (r - 8) + 1, 0) << 16) | 0xff000000u; lb2 = lo_code(r, 0) | 0xffffff00u; }
                unsigned* mcnt = (unsigned*)(ws + WS_BAR + 16384 + 64 * 64 * 4);
                unsigned* dcnt = (unsigned*)(ws + WS_BAR + 36864);
                { unsigned ld; if (r < 8) ld = (unsigned)(((2 * r) << 3) | 6) | ((unsigned)(((2 * r + 1) << 3) | 6) << 8) | 0xffff0000u; else ld = (unsigned)(((r - 8) << 3) | 7) | 0xffffff00u;
                  const pg8::Gemm gD{(const u16*)(ws + WS_H), (const u16*)(ws + WS_WT), TT, 4096, 1024}; const EpiZT<true> ED{1, ws, dout, P.lbl};
                  ListOrder S{8 * x, ld}; pg8::gemm_phase<EpiZT<true>, ListOrder, true, true>(lds, gD, S, ED);
                  asm volatile("s_waitcnt vmcnt(0)" ::: "memory"); __syncthreads();
                  if (tid == 0) __hip_atomic_fetch_add(dcnt + 64 * (8 * x + (r < 8 ? 6 : 7)), (r < 8 ? 2u : 1u), __ATOMIC_RELAXED, __HIP_MEMORY_SCOPE_AGENT); }
                merge_phase((u16*)(dout + DO_OG), (const float*)(ws + WS_COS), (const u16*)(dout + DO_AG), bx - 64, 192);
                asm volatile("s_waitcnt vmcnt(0)" ::: "memory"); __syncthreads();
                if (tid == 0) __hip_atomic_fetch_add(mcnt, 1u, __ATOMIC_RELAXED, __HIP_MEMORY_SCOPE_AGENT);
                { ListOrder S{8 * x, lg}; pg8::gemm_phase<EpiZ, ListOrder, true, true>(lds, gG, S, EG); }
                if (tid == 0) { unsigned sp = 0u; while (__hip_atomic_load(mcnt, __ATOMIC_RELAXED, __HIP_MEMORY_SCOPE_AGENT) < 192u) { __builtin_amdgcn_s_sleep(2); if (++sp > (1u << 22)) break; }
                    __builtin_amdgcn_fence(__ATOMIC_ACQUIRE, "agent"); asm volatile("s_waitcnt vmcnt(0)" ::: "memory"); }
                __syncthreads();
                { ListOrder S{8 * x, lb2}; pg8::gemm_phase<EpiGateB, ListOrder, true, true>(lds, gB, S, EB); } }
        }
    }
    SEAM(4);
    if (IN(5)) { pg8::Gemm g{(const u16*)(ws + Z_QA), (const u16*)(ws + WS_WA), TT, 1024, 1024}; pg8::StaticOrder S; S.init(TT, 1024, G, bx);
        EpiGateA E{(const u16*)(ws + Z_GATES), (const u16*)(dout + DO_TMPB), (u16*)(ws + Z_MERGED)}; pg8::gemm_phase<EpiGateA, pg8::StaticOrder, true, true>(lds, g, S, E); }
    SEAM(5);
    if (IN(6)) { pg8::Gemm g{(const u16*)(ws + Z_MERGED), (const u16*)(ws + WS_WO), TT, 1024, 1024}; pg8::StaticOrder S; S.init(TT, 1024, G, bx);
        EpiOutNorm E{P.x, P.out, P.fnw, (float*)(ws + WS_BAR + 65536), (unsigned*)(ws + WS_BAR + 16384)}; pg8::gemm_phase<EpiOutNorm, pg8::StaticOrder, false, true>(lds, g, S, E); }
#ifdef HG_PROBE_MODE
    if (bx < 64) hgrn_unit<HG_PROBE_MODE>(lds, bx >> 3, bx & 7, (const u16*)(ws + Z_QA), (const u16*)(ws + Z_G), (const u16*)(ws + Z_VA), (const u16*)(ws + Z_HG), P.hnw, (u16*)(ws + Z_HG), nullptr);
#endif
#ifdef PROBE_K
    STAMP(7);
    if (bx == 0 && tid == 0) { const LAS unsigned long long* ts = (const LAS unsigned long long*)(lds + 163344);
#ifdef PROBE_ACC
        const unsigned long long dt = ts[10], t0
#else
        const unsigned long long dt = ts[PROBE_B] - ts[PROBE_A], t0
#endif
 = __builtin_amdgcn_s_memrealtime();
        while (__builtin_amdgcn_s_memrealtime() - t0 < dt) __builtin_amdgcn_s_sleep(8); }
#endif
#undef IN
#undef SEAM
}

extern "C" void kernel_launch(void* const* d_in, const int* in_sizes, int n_in, void* d_out, int out_size, void* d_ws, size_t ws_size, hipStream_t stream) {
    static int grid = 0;
    if (grid == 0) {
        if (n_in != 10 || in_sizes[0] != TT * DM || out_size != TT * DM || ws_size < WS_END) { fprintf(stderr, "kernel_launch: unexpected shapes (n_in %d, in0 %d, out %d, ws %zu)\n", n_in, n_in > 0 ? in_sizes[0] : -1, out_size, ws_size); grid = -1; return; }
        int dev = 0, cus = 0, per_cu = 0;
        hipGetDevice(&dev); hipDeviceGetAttribute(&cus, hipDeviceAttributeMultiprocessorCount, dev);
        if (hipFuncSetAttribute((const void*)fwd_megakernel, hipFuncAttributeMaxDynamicSharedMemorySize, LDS_BYTES) != hipSuccess) { fprintf(stderr, "kernel_launch: hipFuncSetAttribute failed\n"); grid = -1; return; }
        if (hipOccupancyMaxActiveBlocksPerMultiprocessor(&per_cu, (const void*)fwd_megakernel, 512, LDS_BYTES) != hipSuccess || per_cu < 1) { fprintf(stderr, "kernel_launch: occupancy query says %d\n", per_cu); per_cu = 1; }
        (void)hipGetLastError();
        grid = cus * (per_cu > 1 ? 1 : per_cu);
        if (grid != 256) { fprintf(stderr, "kernel_launch: built for a 256-CU device (one workgroup per CU); got %d\n", grid); grid = -1; return; }
    }
    if (grid < 0) return;
    if (hipMemsetAsync((char*)d_ws + WS_BAR, 0, 36864 + 16384, stream) != hipSuccess) { fprintf(stderr, "kernel_launch: memset of the barrier words failed\n"); return; }
    Args a{};
    for (int i = 0; i < 10; ++i) a.in[i] = (const float*)d_in[i];
    a.out = (float*)d_out; a.ws = (unsigned char*)d_ws; a.ph_lo = 0; a.ph_hi = 7;
    void* args[] = {&a};
    hipError_t e = hipLaunchCooperativeKernel((const void*)fwd_megakernel, dim3(grid), dim3(512), args, LDS_BYTES, stream);
    if (e != hipSuccess) fprintf(stderr, "kernel_launch: cooperative launch failed: %s (grid %d)\n", hipGetErrorString(e), grid);
}
```

```cpp
#include <hip/hip_runtime.h>
#include <hip/hip_cooperative_groups.h>
#include <hip/hip_bf16.h>
#include <cstdio>
#include <cstdint>
#include <cmath>
namespace cg = cooperative_groups;
namespace pg8 {
#define PG8_LAS __attribute__((address_space(3)))
typedef unsigned short bf16_t;
typedef short bf16x8 __attribute__((ext_vector_type(8)));
typedef float f32x4 __attribute__((ext_vector_type(4)));
typedef unsigned u32x4 __attribute__((ext_vector_type(4)));
constexpr int BM = 256, BK = 64, HALF = 128, HTB = HALF * BK * 2  , STAGE_BYTES = 8 * HTB, NXCD = 8, WGM = 8;

__host__ __device__ __forceinline__ int lds_byte(int r, int c) { const int st = (r >> 4) * 2 + (c >> 5), rr = r & 15, cc = c & 31, ob = rr * 64 + cc * 2; return st * 1024 + (ob ^ (((ob >> 9) & 1) << 5)); }
__host__ __device__ __forceinline__ void stage_rc(int b, int& R, int& C) { const int st = b / 1024, sb = b % 1024, swz = sb ^ (((sb >> 9) & 1) << 5); R = (st >> 1) * 16 + swz / 64; C = (st & 1) * 32 + (swz % 64) / 2; }
__host__ __device__ __forceinline__ int perm32(int rho) { const int n = rho >> 4, i = rho & 15; return 8 * (i >> 2) + 4 * n + (i & 3); }

struct Unit { int pm, pn; };
struct Gemm { const bf16_t* A; const bf16_t* Bt; int M, N, K; };

struct StaticOrder {
    int nM, nN, nwg, G, c;
    __host__ __device__ void init(int M, int N, int G_, int c_) { nM = M / BM; nN = N / BM; nwg = nM * nN; G = G_; c = c_; }
    __host__ __device__ bool next(int i, Unit& u) const {
        const long L = (long)i * G + c; if (L >= nwg) return false;
        int wgid = (int)L; { const int q = nwg / NXCD, r = nwg % NXCD, xcd = wgid % NXCD, off = wgid / NXCD; wgid = (xcd < r ? xcd * (q + 1) : r * (q + 1) + (xcd - r) * q) + off; }
        const int nig = WGM * nN, gid = wgid / nig, fm = gid * WGM, gsz = (nM - fm) < WGM ? (nM - fm) : WGM;
        u.pm = fm + ((wgid % nig) % gsz); u.pn = (wgid % nig) / gsz; return true;
    }
    __device__ __forceinline__ void a_ready(const Unit&) const {}
    __device__ __forceinline__ void done(const Unit&) const {}
};

__device__ __forceinline__ unsigned cvt_pk_bf16(float lo, float hi) { unsigned r; asm volatile("v_cvt_pk_bf16_f32 %0, %1, %2" : "=v"(r) : "v"(lo), "v"(hi)); return r; }
typedef float f32x2 __attribute__((ext_vector_type(2)));
template <class Epi, class Sched, bool ALIGN_EPI = false, bool SP2 = false>
__device__ __forceinline__ void gemm_phase(PG8_LAS unsigned char* lds, const Gemm g, const Sched& S, const Epi& E) {
    const int tid = threadIdx.x, wid = __builtin_amdgcn_readfirstlane(tid >> 6), lane = tid & 63, wr = wid >> 2, wc = wid & 3, fr = lane & 15, fq = lane >> 4;
    const int K = g.K, nt = K / BK;
    unsigned voffA[2], voffB[2];
#pragma unroll
    for (int i = 0; i < 2; ++i) { int R, C; stage_rc(tid * 16 + i * 8192, R, C); const int Rb = Epi::PERM ? ((R & ~31) + perm32(R & 31)) : R;
        voffA[i] = (unsigned)(R * K + C) * 2u; voffB[i] = (unsigned)(Rb * K + C) * 2u; }
    const size_t kstep = (size_t)(BK * 2);
    const size_t hstep = (size_t)HALF * K * 2;
    const size_t tstep = 2 * hstep;
    const unsigned ldsw = (unsigned)wid * 1024u;
    const int aoff = lds_byte(wr * 64 + fr, fq * 8), boff = lds_byte(wc * 32 + fr, fq * 8);
#define PG8_SA(b, h) (((b) * 2 + (h)) * HTB)
#define PG8_SB(b, h) ((4 + (b) * 2 + (h)) * HTB)
#define PG8_STAGE(bufoff, gbase, voff) do { _Pragma("unroll") for (int _i = 0; _i < 2; ++_i) \
        __builtin_amdgcn_global_load_lds((const unsigned*)((const char*)(gbase) + (voff)[_i]), (PG8_LAS unsigned*)(lds + (bufoff) + ldsw + _i * 8192), 16, 0, 0); } while (0)
#define PG8_LDA(dst, b, h) do { _Pragma("unroll") for (int m = 0; m < 4; ++m) _Pragma("unroll") for (int k = 0; k < 2; ++k) dst[m][k] = *(const PG8_LAS bf16x8*)(lds + PG8_SA(b, h) + aoff + m * 2048 + k * 1024); } while (0)
#define PG8_LDB(dst, b, h) do { _Pragma("unroll") for (int n = 0; n < 2; ++n) _Pragma("unroll") for (int k = 0; k < 2; ++k) dst[n][k] = *(const PG8_LAS bf16x8*)(lds + PG8_SB(b, h) + boff + n * 2048 + k * 1024); } while (0)
#define PG8_MMA(ai, bj, At, Bt) do { __builtin_amdgcn_s_setprio(1); _Pragma("unroll") for (int m = 0; m < 4; ++m) _Pragma("unroll") for (int n = 0; n < 2; ++n) _Pragma("unroll") for (int k = 0; k < 2; ++k) \
        acc[ai][bj][m][n] = __builtin_amdgcn_mfma_f32_16x16x32_bf16(Bt[n][k], At[m][k], acc[ai][bj][m][n], 0, 0, 0); __builtin_amdgcn_s_setprio(0); } while (0)
#define PG8_WAIT_V(n) asm volatile("s_waitcnt vmcnt(" #n ")" ::: "memory")
#define PG8_WAIT_L(n) asm volatile("s_waitcnt lgkmcnt(" #n ")" ::: "memory")
#define PG8_BAR __builtin_amdgcn_s_barrier()
#define PG8_SCHED __builtin_amdgcn_sched_barrier(0)
    Unit cur, nxt; int ui = 0;
    if (!S.next(0, cur)) return;
    f32x4 acc[2][2][4][2];
#pragma unroll
    for (int a = 0; a < 2; ++a)
#pragma unroll
        for (int b = 0; b < 2; ++b)
#pragma unroll
            for (int m = 0; m < 4; ++m)
#pragma unroll
                for (int n = 0; n < 2; ++n) acc[a][b][m][n] = (f32x4){0.f, 0.f, 0.f, 0.f};
    bf16x8 At[4][2], B0[2][2], B1[2][2];
    const char* cA = (const char*)g.A + (size_t)cur.pm * tstep; const char* cB = (const char*)g.Bt + (size_t)cur.pn * tstep;
    S.a_ready(cur);
    if constexpr (SP2) {
        PG8_STAGE(PG8_SB(0, 0), cB, voffB); PG8_STAGE(PG8_SB(0, 1), cB + hstep, voffB); PG8_STAGE(PG8_SA(0, 0), cA, voffA); PG8_STAGE(PG8_SA(0, 1), cA + hstep, voffA);
        if (wr == 1) PG8_BAR;
        PG8_WAIT_V(2); PG8_BAR;
        PG8_STAGE(PG8_SB(1, 0), cB + kstep, voffB); PG8_STAGE(PG8_SA(1, 0), cA + kstep, voffA); PG8_STAGE(PG8_SB(1, 1), cB + hstep + kstep, voffB);
        PG8_WAIT_V(6); PG8_BAR;
    } else {
        PG8_STAGE(PG8_SB(0, 0), cB, voffB); PG8_STAGE(PG8_SA(0, 0), cA, voffA); PG8_STAGE(PG8_SB(0, 1), cB + hstep, voffB); PG8_STAGE(PG8_SA(0, 1), cA + hstep, voffA);
        if (wr == 1) PG8_BAR;
        PG8_WAIT_V(4); PG8_BAR;
        PG8_STAGE(PG8_SB(1, 0), cB + kstep, voffB); PG8_STAGE(PG8_SA(1, 0), cA + kstep, voffA); PG8_STAGE(PG8_SB(1, 1), cB + hstep + kstep, voffB);
        PG8_WAIT_V(6); PG8_BAR;
    }
    for (;;) {
        const bool has_next = S.next(ui + 1, nxt);
        const char* nA = has_next ? (const char*)g.A + (size_t)nxt.pm * tstep : cA; const char* nB = has_next ? (const char*)g.Bt + (size_t)nxt.pn * tstep : cB;
        for (int t = 0; t < nt; t += 2) {
            const bool last = (t == nt - 2);
            const char* a1 = cA + (size_t)(t + 1) * kstep;
            const char* a2 = last ? nA : cA + (size_t)(t + 2) * kstep; const char* b2 = last ? nB : cB + (size_t)(t + 2) * kstep;
            const char* a3 = a2 + kstep; const char* b3 = b2 + kstep;
            if (last && has_next) S.a_ready(nxt);
            if constexpr (SP2) {
            PG8_LDB(B0, 0, 0); PG8_LDB(B1, 0, 1); PG8_SCHED; PG8_LDA(At, 0, 0); PG8_STAGE(PG8_SA(1, 1), a1 + hstep, voffA);
            PG8_WAIT_V(8); PG8_WAIT_L(0); PG8_BAR; PG8_MMA(0, 0, At, B0); PG8_MMA(0, 1, At, B1); PG8_BAR; PG8_SCHED;
            PG8_LDA(At, 0, 1); PG8_STAGE(PG8_SB(0, 0), b2, voffB); PG8_STAGE(PG8_SB(0, 1), b2 + hstep, voffB); PG8_STAGE(PG8_SA(0, 0), a2, voffA);
            PG8_WAIT_V(8); PG8_WAIT_L(0); PG8_BAR; PG8_MMA(1, 0, At, B0); PG8_MMA(1, 1, At, B1); PG8_BAR; PG8_SCHED;
            PG8_LDB(B0, 1, 0); PG8_LDB(B1, 1, 1); PG8_SCHED; PG8_LDA(At, 1, 0); PG8_STAGE(PG8_SA(0, 1), a2 + hstep, voffA);
            PG8_WAIT_V(8); PG8_WAIT_L(0); PG8_BAR; PG8_MMA(0, 0, At, B0); PG8_MMA(0, 1, At, B1); PG8_BAR; PG8_SCHED;
            PG8_LDA(At, 1, 1); PG8_STAGE(PG8_SB(1, 0), b3, voffB); PG8_STAGE(PG8_SB(1, 1), b3 + hstep, voffB); PG8_STAGE(PG8_SA(1, 0), a3, voffA);
            PG8_WAIT_V(8); PG8_WAIT_L(0); PG8_BAR; PG8_MMA(1, 0, At, B0); PG8_MMA(1, 1, At, B1); PG8_BAR; PG8_SCHED;
            } else {
            PG8_LDB(B0, 0, 0); PG8_SCHED; PG8_LDA(At, 0, 0); PG8_STAGE(PG8_SA(1, 1), a1 + hstep, voffA);
            PG8_WAIT_L(8); PG8_BAR; PG8_WAIT_L(0); PG8_MMA(0, 0, At, B0); PG8_BAR; PG8_SCHED;
            PG8_LDB(B1, 0, 1); PG8_STAGE(PG8_SB(0, 0), b2, voffB);
            PG8_BAR; PG8_WAIT_L(0); PG8_MMA(0, 1, At, B1); PG8_BAR;
            PG8_LDA(At, 0, 1); PG8_STAGE(PG8_SA(0, 0), a2, voffA);
            PG8_BAR; PG8_WAIT_L(0); PG8_MMA(1, 0, At, B0); PG8_BAR; PG8_SCHED;
            PG8_STAGE(PG8_SB(0, 1), b2 + hstep, voffB);
            PG8_WAIT_V(6); PG8_BAR; PG8_MMA(1, 1, At, B1); PG8_BAR;
            PG8_LDB(B0, 1, 0); PG8_SCHED; PG8_LDA(At, 1, 0); PG8_STAGE(PG8_SA(0, 1), a2 + hstep, voffA);
            PG8_WAIT_L(8); PG8_BAR; PG8_WAIT_L(0); PG8_MMA(0, 0, At, B0); PG8_BAR; PG8_SCHED;
            PG8_LDB(B1, 1, 1); PG8_STAGE(PG8_SB(1, 0), b3, voffB);
            PG8_BAR; PG8_WAIT_L(0); PG8_MMA(0, 1, At, B1); PG8_BAR;
            PG8_LDA(At, 1, 1); PG8_STAGE(PG8_SA(1, 0), a3, voffA);
            PG8_BAR; PG8_WAIT_L(0); PG8_MMA(1, 0, At, B0); PG8_BAR; PG8_SCHED;
            PG8_STAGE(PG8_SB(1, 1), b3 + hstep, voffB);
            PG8_WAIT_V(6); PG8_BAR; PG8_MMA(1, 1, At, B1); PG8_BAR;
            }
        }
        if constexpr (ALIGN_EPI) { if (wr == 0) PG8_BAR; }
        if constexpr (!Epi::AFTER_DRAIN) { E(acc, cur, wr, wc, fr, fq); S.done(cur); }
        if (!has_next) break;
#pragma unroll
        for (int a = 0; a < 2; ++a)
#pragma unroll
            for (int b = 0; b < 2; ++b)
#pragma unroll
                for (int m = 0; m < 4; ++m)
#pragma unroll
                    for (int n = 0; n < 2; ++n) acc[a][b][m][n] = (f32x4){0.f, 0.f, 0.f, 0.f};
        cur = nxt; cA = nA; cB = nB; ++ui;
        if constexpr (ALIGN_EPI) { if (wr == 1) PG8_BAR; }
    }
    PG8_WAIT_V(0);
    if constexpr (!ALIGN_EPI) { if (wr == 0) PG8_BAR; }
    PG8_BAR;
    if constexpr (Epi::AFTER_DRAIN) { E.fused(acc, cur, wr, wc, fr, fq, lds, wid, lane); S.done(cur); }
#undef PG8_SA
#undef PG8_SB
#undef PG8_STAGE
#undef PG8_LDA
#undef PG8_LDB
#undef PG8_MMA
#undef PG8_WAIT_V
#undef PG8_WAIT_L
#undef PG8_BAR
#undef PG8_SCHED
}
}

#define LAS __attribute__((address_space(3)))
typedef unsigned short u16;
typedef short bf16x8 __attribute__((ext_vector_type(8)));
typedef short s16x4 __attribute__((ext_vector_type(4)));
typedef float f32x4 __attribute__((ext_vector_type(4)));
typedef float f32x2 __attribute__((ext_vector_type(2)));
typedef unsigned u32x4 __attribute__((ext_vector_type(4)));
typedef unsigned u32x2 __attribute__((ext_vector_type(2)));

constexpr int TT = 16384, DM = 1024, SEQ = 2048, NIN = 11264;
constexpr int ZBP = 4608;
constexpr size_t MiB = 1u << 20;
constexpr size_t WS_WT = 0;
constexpr size_t WS_WA = 22 * MiB, WS_WB = 24 * MiB, WS_WO = 25 * MiB;
constexpr size_t WS_COS = 27 * MiB, WS_SIN = 29 * MiB;
constexpr size_t WS_BAR = 31 * MiB;
constexpr size_t WS_H = 32 * MiB;
constexpr size_t WS_Z = 64 * MiB;
constexpr size_t Z_QA = WS_Z, Z_G = WS_Z + 32 * MiB, Z_VA = WS_Z + 64 * MiB, Z_HG = WS_Z + 96 * MiB, Z_GATES = WS_Z + 128 * MiB;
constexpr size_t Z_MERGED = WS_Z + 64 * MiB;
constexpr size_t WS_END = 256 * MiB;
constexpr size_t DO_OG = 0, DO_AG = 48 * MiB, DO_TMPB = 16 * MiB;
constexpr int LDS_BYTES = 163840;
constexpr float NORM_EPS = 1e-6f;

__device__ __forceinline__ unsigned pk_bf16(float lo, float hi) { typedef __bf16 b2 __attribute__((ext_vector_type(2))); f32x2 v = {lo, hi}; b2 b = __builtin_convertvector(v, b2); return __builtin_bit_cast(unsigned, b); }
__device__ __forceinline__ unsigned pk_f16(float lo, float hi) { typedef _Float16 h2 __attribute__((ext_vector_type(2))); h2 h = {(_Float16)lo, (_Float16)hi}; return __builtin_bit_cast(unsigned, h); }
__device__ __forceinline__ float bflo(unsigned u) { return __uint_as_float(u << 16); }
__device__ __forceinline__ float bfhi(unsigned u) { return __uint_as_float(u & 0xffff0000u); }
__device__ __forceinline__ float f16lo(unsigned u) { return (float)__builtin_bit_cast(_Float16, (unsigned short)(u & 0xffffu)); }
__device__ __forceinline__ float f16hi(unsigned u) { return (float)__builtin_bit_cast(_Float16, (unsigned short)(u >> 16)); }
__device__ __forceinline__ float sigm(float x) { return __builtin_amdgcn_rcpf(1.0f + __expf(-x)); }
__device__ __forceinline__ s16x4 ds_tr(const LAS u16* p) { typedef short v4 __attribute__((ext_vector_type(4))); return __builtin_bit_cast(s16x4, __builtin_amdgcn_ds_read_tr16_b64_v4i16((LAS v4*)p)); }
__device__ __forceinline__ bf16x8 cat8(s16x4 lo, s16x4 hi) { return (bf16x8){lo[0], lo[1], lo[2], lo[3], hi[0], hi[1], hi[2], hi[3]}; }
__device__ __forceinline__ f32x4 mfma16(bf16x8 a, bf16x8 b, f32x4 c) { return __builtin_amdgcn_mfma_f32_16x16x32_bf16(a, b, c, 0, 0, 0); }
__device__ __forceinline__ void store16_wt(void* p, u32x4 v) { asm volatile("global_store_dwordx4 %0, %1, off sc1\n\ts_nop 1" :: "v"(p), "v"(v) : "memory"); }
template <bool WT> __device__ __forceinline__ void store16(void* p, u32x4 v) { if (WT) store16_wt(p, v); else *(u32x4*)p = v; }
__device__ __forceinline__ float wave_sum(float v) {
#pragma unroll
    for (int o = 1; o < 64; o <<= 1) v += __shfl_xor(v, o);
    return v;
}

using pg8::Unit;
template <int ACT  > __device__ __forceinline__ float act1(float v) { if (ACT == 1) return v * sigm(v); if (ACT == 2) return sigm(v); return v; }
template <int ACT, bool WT = false> __device__ __forceinline__ void epi_store16(const f32x4 (&acc)[2][2][4][2], u16* base, int pitch, int row0, int col0) {
#pragma unroll
    for (int ai = 0; ai < 2; ++ai)
#pragma unroll
        for (int m = 0; m < 4; ++m) { u16* rowp = base + (size_t)(row0 + ai * 128 + m * 16) * pitch + col0;
#pragma unroll
            for (int bj = 0; bj < 2; ++bj) { const f32x4 v0 = acc[ai][bj][m][0], v1 = acc[ai][bj][m][1]; u32x4 w;
                w.x = pk_bf16(act1<ACT>(v0[0]), act1<ACT>(v0[1])); w.y = pk_bf16(act1<ACT>(v0[2]), act1<ACT>(v0[3]));
                w.z = pk_bf16(act1<ACT>(v1[0]), act1<ACT>(v1[1])); w.w = pk_bf16(act1<ACT>(v1[2]), act1<ACT>(v1[3]));
                store16<WT>(rowp + bj * 128, w); } }
}
__device__ __forceinline__ size_t frag_off(size_t tile, int ai, int m, int bj, int tidx) { return (((tile * 16 + (size_t)((ai * 4 + m) * 2 + bj)) * 512) + (size_t)tidx) * 8; }
template <int ACT, bool WT> __device__ __forceinline__ void epi_store_frag(const f32x4 (&acc)[2][2][4][2], u16* base, size_t tile, int tidx) {
#pragma unroll
    for (int ai = 0; ai < 2; ++ai)
#pragma unroll
        for (int m = 0; m < 4; ++m)
#pragma unroll
            for (int bj = 0; bj < 2; ++bj) { const f32x4 v0 = acc[ai][bj][m][0], v1 = acc[ai][bj][m][1]; u32x4 w;
                w.x = pk_bf16(act1<ACT>(v0[0]), act1<ACT>(v0[1])); w.y = pk_bf16(act1<ACT>(v0[2]), act1<ACT>(v0[3]));
                w.z = pk_bf16(act1<ACT>(v1[0]), act1<ACT>(v1[1])); w.w = pk_bf16(act1<ACT>(v1[2]), act1<ACT>(v1[3]));
                store16<WT>(base + frag_off(tile, ai, m, bj, tidx), w); }
}
template <int ACT, bool WT> __device__ __forceinline__ void epi_store16_hm(const f32x4 (&acc)[2][2][4][2], u16* base, int pnl, int row0, int lc) {
#pragma unroll
    for (int ai = 0; ai < 2; ++ai)
#pragma unroll
        for (int m = 0; m < 4; ++m) { const int row = row0 + ai * 128 + m * 16, b = row >> 11, t = row & 2047;
#pragma unroll
            for (int bj = 0; bj < 2; ++bj) { const f32x4 v0 = acc[ai][bj][m][0], v1 = acc[ai][bj][m][1]; u32x4 w;
                w.x = pk_bf16(act1<ACT>(v0[0]), act1<ACT>(v0[1])); w.y = pk_bf16(act1<ACT>(v0[2]), act1<ACT>(v0[3]));
                w.z = pk_bf16(act1<ACT>(v1[0]), act1<ACT>(v1[1])); w.w = pk_bf16(act1<ACT>(v1[2]), act1<ACT>(v1[3]));
                store16<WT>(base + ((size_t)(b * 8 + 2 * pnl + bj) * 2048 + t) * 128 + lc, w); } }
}
template <bool WT> struct EpiZT {
    static constexpr bool PERM = true, AFTER_DRAIN = false;
    int mode;
    unsigned char* ws; unsigned char* dout; const float* lbl;
    __device__ __forceinline__ void operator()(const f32x4 (&acc)[2][2][4][2], const Unit& u, int wr, int wc, int fr, int fq) const {
        const int pn = u.pn, row0 = u.pm * 256 + wr * 64 + fr, lc = wc * 32 + 8 * fq;
        if (mode == 2) { epi_store_frag<2, WT>(acc, (u16*)(ws + Z_GATES), (size_t)u.pm * 8 + pn, (wr * 4 + wc) * 64 + fq * 16 + fr); return; }
        if (mode == 0) {
            u16* ZB = (u16*)(ws + WS_Z);
            if (pn < 12) {
                const float sc = (pn < 6) ? 0.125f * 1.4426950408889634f : 1.0f;
                const float* cosT = (const float*)(ws + WS_COS); const float* sinT = (const float*)(ws + WS_SIN);
                const int jb = 16 * (wc & 1) + 4 * fq;
#pragma unroll
                for (int ai = 0; ai < 2; ++ai) { f32x4 cc[4], ss[4];
#pragma unroll
                    for (int m = 0; m < 4; ++m) { const int row = row0 + ai * 128 + m * 16; cc[m] = *(const f32x4*)(cosT + (size_t)row * 32 + jb); ss[m] = *(const f32x4*)(sinT + (size_t)row * 32 + jb); }
#pragma unroll
                    for (int m = 0; m < 4; ++m) { const int row = row0 + ai * 128 + m * 16; const f32x4 c = cc[m], s = ss[m];
                        u16* rowp = ZB + ((size_t)(pn * 4 + (wc >> 1)) * TT + row) * 64 + (lc & 63);
#pragma unroll
                        for (int bj = 0; bj < 2; ++bj) { const f32x4 v0 = acc[ai][bj][m][0], v1 = acc[ai][bj][m][1]; u32x4 w;
                            w.x = pk_bf16((v0[0] * c[0] - v0[1] * s[0]) * sc, (v0[1] * c[0] + v0[0] * s[0]) * sc);
                            w.y = pk_bf16((v0[2] * c[1] - v0[3] * s[1]) * sc, (v0[3] * c[1] + v0[2] * s[1]) * sc);
                            w.z = pk_bf16((v1[0] * c[2] - v1[1] * s[2]) * sc, (v1[1] * c[2] + v1[0] * s[2]) * sc);
                            w.w = pk_bf16((v1[2] * c[3] - v1[3] * s[3]) * sc, (v1[3] * c[3] + v1[2] * s[3]) * sc);
                            *(u32x4*)(rowp + (size_t)bj * 2 * TT * 64) = w; } } }
            } else if (pn < 18) {
#pragma unroll
                for (int ai = 0; ai < 2; ++ai)
#pragma unroll
                    for (int m = 0; m < 4; ++m) { u16* rowp = ZB + ((size_t)(pn * 4 + (wc >> 1)) * TT + (row0 + ai * 128 + m * 16)) * 64 + (lc & 63);
#pragma unroll
                        for (int bj = 0; bj < 2; ++bj) { const f32x4 v0 = acc[ai][bj][m][0], v1 = acc[ai][bj][m][1]; u32x4 w;
                            w.x = pk_bf16(v0[0], v0[1]); w.y = pk_bf16(v0[2], v0[3]); w.z = pk_bf16(v1[0], v1[1]); w.w = pk_bf16(v1[2], v1[3]);
                            *(u32x4*)(rowp + (size_t)bj * 2 * TT * 64) = w; } }
            }
            else epi_store16<1>(acc, (u16*)(dout + DO_AG), 512, row0, (pn - 18) * 256 + lc);
        } else {
            if (pn < 4) epi_store16<1, WT>(acc, (u16*)(ws + Z_QA), 1024, row0, pn * 256 + lc);
            else if (pn < 8) {
                const int cb = (pn - 4) * 256 + lc; float lb[2][8];
#pragma unroll
                for (int bj = 0; bj < 2; ++bj)
#pragma unroll
                    for (int e = 0; e < 8; ++e) { const int idx = cb + bj * 128 + e; lb[bj][e] = 1.0f / (1.0f + __expf(lbl[1024 + idx] - lbl[idx])); }
                u16* G = (u16*)(ws + Z_G);
#pragma unroll
                for (int ai = 0; ai < 2; ++ai)
#pragma unroll
                    for (int m = 0; m < 4; ++m) { const int row = row0 + ai * 128 + m * 16; u16* rowp = G + ((size_t)((row >> 11) * 8 + 2 * (pn - 4)) * 2048 + (row & 2047)) * 128 + lc;
#pragma unroll
                        for (int bj = 0; bj < 2; ++bj) { const f32x4 v0 = acc[ai][bj][m][0], v1 = acc[ai][bj][m][1]; float g[8];
#pragma unroll
                            for (int e = 0; e < 8; ++e) { const float v = e < 4 ? v0[e & 3] : v1[e & 3]; g[e] = lb[bj][e] + (1.0f - lb[bj][e]) * sigm(v); }
                            u32x4 w; w.x = pk_f16(g[0], g[1]); w.y = pk_f16(g[2], g[3]); w.z = pk_f16(g[4], g[5]); w.w = pk_f16(g[6], g[7]);
                            store16<WT>(rowp + (size_t)bj * 2048 * 128, w); } }
            } else if (pn < 12) epi_store16_hm<0, WT>(acc, (u16*)(ws + Z_VA), pn - 8, row0, lc);
            else if (pn < 16) epi_store16_hm<1, WT>(acc, (u16*)(ws + Z_HG), pn - 12, row0, lc);
            else epi_store16<2>(acc, (u16*)(ws + Z_GATES), 2048, row0, (pn - 16) * 256 + lc);
        }
    }
};
typedef EpiZT<false> EpiZ;
struct EpiGateB {
    static constexpr bool PERM = true, AFTER_DRAIN = false;
    const u16* gates; u16* tmpb;
    __device__ __forceinline__ void operator()(const f32x4 (&acc)[2][2][4][2], const Unit& u, int wr, int wc, int fr, int fq) const {
        const int row0 = u.pm * 256 + wr * 64 + fr, col0 = u.pn * 256 + wc * 32 + 8 * fq, tidx = (wr * 4 + wc) * 64 + fq * 16 + fr;
#pragma unroll
        for (int ai = 0; ai < 2; ++ai) { u32x4 gg[4][2];
#pragma unroll
            for (int m = 0; m < 4; ++m)
#pragma unroll
                for (int bj = 0; bj < 2; ++bj) gg[m][bj] = *(const u32x4*)(gates + frag_off((size_t)u.pm * 8 + 4 + u.pn, ai, m, bj, tidx));
#pragma unroll
            for (int m = 0; m < 4; ++m) { const size_t row = row0 + ai * 128 + m * 16;
#pragma unroll
                for (int bj = 0; bj < 2; ++bj) { const int col = col0 + bj * 128; const u32x4 g = gg[m][bj];
                    const f32x4 v0 = acc[ai][bj][m][0], v1 = acc[ai][bj][m][1]; u32x4 w;
                    w.x = pk_bf16(v0[0] * bflo(g.x), v0[1] * bfhi(g.x)); w.y = pk_bf16(v0[2] * bflo(g.y), v0[3] * bfhi(g.y));
                    w.z = pk_bf16(v1[0] * bflo(g.z), v1[1] * bfhi(g.z)); w.w = pk_bf16(v1[2] * bflo(g.w), v1[3] * bfhi(g.w));
                    *(u32x4*)(tmpb + frag_off((size_t)u.pm * 4 + u.pn, ai, m, bj, tidx)) = w; } } }
    }
};
struct EpiGateA {
    static constexpr bool PERM = true, AFTER_DRAIN = false;
    const u16* gates; const u16* tmpb; u16* merged;
    __device__ __forceinline__ void operator()(const f32x4 (&acc)[2][2][4][2], const Unit& u, int wr, int wc, int fr, int fq) const {
        const int row0 = u.pm * 256 + wr * 64 + fr, col0 = u.pn * 256 + wc * 32 + 8 * fq, tidx = (wr * 4 + wc) * 64 + fq * 16 + fr;
#pragma unroll
        for (int ai = 0; ai < 2; ++ai) { u32x4 gg[4][2], tb[4][2];
#pragma unroll
            for (int m = 0; m < 4; ++m)
#pragma unroll
                for (int bj = 0; bj < 2; ++bj) { const size_t row = row0 + ai * 128 + m * 16; gg[m][bj] = *(const u32x4*)(gates + frag_off((size_t)u.pm * 8 + u.pn, ai, m, bj, tidx)); tb[m][bj] = *(const u32x4*)(tmpb + frag_off((size_t)u.pm * 4 + u.pn, ai, m, bj, tidx)); }
#pragma unroll
            for (int m = 0; m < 4; ++m) { const size_t row = row0 + ai * 128 + m * 16;
#pragma unroll
                for (int bj = 0; bj < 2; ++bj) { const int col = col0 + bj * 128; const u32x4 g = gg[m][bj], t = tb[m][bj];
                    const f32x4 v0 = acc[ai][bj][m][0], v1 = acc[ai][bj][m][1]; u32x4 w;
                    w.x = pk_bf16(bflo(t.x) + v0[0] * bflo(g.x), bfhi(t.x) + v0[1] * bfhi(g.x)); w.y = pk_bf16(bflo(t.y) + v0[2] * bflo(g.y), bfhi(t.y) + v0[3] * bfhi(g.y));
                    w.z = pk_bf16(bflo(t.z) + v1[0] * bflo(g.z), bfhi(t.z) + v1[1] * bfhi(g.z)); w.w = pk_bf16(bflo(t.w) + v1[2] * bflo(g.w), bfhi(t.w) + v1[3] * bfhi(g.w));
                    *(u32x4*)(merged + row * 1024 + col) = w; } } }
    }
};
struct ListOrder { int pm0; unsigned list;
    __device__ __forceinline__ bool next(int i, Unit& u) const { const unsigned c = (i < 4) ? ((list >> (8 * i)) & 0xffu) : 0xffu; if (c == 0xffu) return false; u.pm = pm0 + (int)(c & 7u); u.pn = (int)(c >> 3); return true; }
    __device__ __forceinline__ void a_ready(const Unit&) const {} __device__ __forceinline__ void done(const Unit&) const {} };
struct DefOrder { pg8::StaticOrder base;
    __device__ __forceinline__ bool next(int i, Unit& u) const { if (!base.next(i, u)) return false; u.pm = (u.pm / 6) * 8 + (u.pm % 6); return true; }
    __device__ __forceinline__ void a_ready(const Unit&) const {} __device__ __forceinline__ void done(const Unit&) const {} };
__device__ __forceinline__ unsigned lo_code(int idx, int base) { return (unsigned)(((base + (idx >> 3)) << 3) | (idx & 7)); }
struct EpiOutNorm {
    static constexpr bool PERM = true, AFTER_DRAIN = true;
    const float* x; float* out; const float* fnw; float* xbuf; unsigned* cnt;
    __device__ __forceinline__ void operator()(const f32x4 (&)[2][2][4][2], const Unit&, int, int, int, int) const {}
    __device__ __forceinline__ void fused(f32x4 (&acc)[2][2][4][2], const Unit& u, int wr, int wc, int fr, int fq, PG8_LAS unsigned char* lds, int wid, int lane) const {
        const int row0 = u.pm * 256 + wr * 64 + fr, col0 = u.pn * 256 + wc * 32 + 8 * fq;
        LAS float* PS = (LAS float*)lds;
        LAS float* RS = (LAS float*)(lds + 4096);
#pragma unroll
        for (int ai = 0; ai < 2; ++ai)
#pragma unroll
            for (int mh = 0; mh < 2; ++mh) { f32x4 xv[2][2][2];
#pragma unroll
                for (int mm = 0; mm < 2; ++mm)
#pragma unroll
                    for (int bj = 0; bj < 2; ++bj) { const size_t o = (size_t)(row0 + ai * 128 + (2 * mh + mm) * 16) * 1024 + col0 + bj * 128; xv[mm][bj][0] = *(const f32x4*)(x + o); xv[mm][bj][1] = *(const f32x4*)(x + o + 4); }
#pragma unroll
                for (int mm = 0; mm < 2; ++mm) { const int m = 2 * mh + mm; float sq = 0.f;
#pragma unroll
                    for (int bj = 0; bj < 2; ++bj)
#pragma unroll
                        for (int n = 0; n < 2; ++n) { const f32x4 v = acc[ai][bj][m][n] + xv[mm][bj][n]; acc[ai][bj][m][n] = v; sq += (v[0] * v[0] + v[1] * v[1]) + (v[2] * v[2] + v[3] * v[3]); }
                    sq += __shfl_xor(sq, 16); sq += __shfl_xor(sq, 32);
                    if (fq == 0) PS[(ai * 128 + wr * 64 + m * 16 + fr) * 4 + wc] = sq; } }
        asm volatile("s_waitcnt lgkmcnt(0)" ::: "memory"); __builtin_amdgcn_s_barrier(); asm volatile("" ::: "memory");
        const int tid = wid * 64 + lane;
        if (tid < 256) { const f32x4 p = *(const LAS f32x4*)(PS + tid * 4);
            __hip_atomic_store(xbuf + (size_t)(u.pm * 256 + tid) * 4 + u.pn, (p[0] + p[1]) + (p[2] + p[3]), __ATOMIC_RELAXED, __HIP_MEMORY_SCOPE_AGENT); }
        asm volatile("s_waitcnt vmcnt(0)" ::: "memory"); __builtin_amdgcn_s_barrier(); asm volatile("" ::: "memory");
        if (tid == 0) {
            __hip_atomic_fetch_add(cnt + 64 * u.pm, 1u, __ATOMIC_RELAXED, __HIP_MEMORY_SCOPE_AGENT);
            unsigned sp = 0u; while (__hip_atomic_load(cnt + 64 * u.pm, __ATOMIC_RELAXED, __HIP_MEMORY_SCOPE_AGENT) < 4u) { __builtin_amdgcn_s_sleep(2); if (++sp > (1u << 22)) break; }
            __builtin_amdgcn_fence(__ATOMIC_ACQUIRE, "agent"); asm volatile("s_waitcnt vmcnt(0)" ::: "memory"); }
        __builtin_amdgcn_s_barrier(); asm volatile("" ::: "memory");
        if (tid < 256) { const float* sl = xbuf + (size_t)(u.pm * 256 + tid) * 4; float t = 0.f;
#pragma unroll
            for (int k = 0; k < 4; ++k) t += __hip_atomic_load(sl + k, __ATOMIC_RELAXED, __HIP_MEMORY_SCOPE_AGENT);
            RS[tid] = rsqrtf(t * (1.0f / 1024.0f) + NORM_EPS); }
        asm volatile("s_waitcnt vmcnt(0) lgkmcnt(0)" ::: "memory"); __builtin_amdgcn_s_barrier(); asm volatile("" ::: "memory");
        f32x4 wv[2][2];
#pragma unroll
        for (int bj = 0; bj < 2; ++bj) { wv[bj][0] = *(const f32x4*)(fnw + col0 + bj * 128); wv[bj][1] = *(const f32x4*)(fnw + col0 + bj * 128 + 4); }
#pragma unroll
        for (int ai = 0; ai < 2; ++ai)
#pragma unroll
            for (int m = 0; m < 4; ++m) { const int rl = ai * 128 + wr * 64 + m * 16 + fr; const float rs = RS[rl]; const size_t o = (size_t)(u.pm * 256 + rl) * 1024 + col0;
#pragma unroll
                for (int bj = 0; bj < 2; ++bj) { *(f32x4*)(out + o + bj * 128) = acc[ai][bj][m][0] * rs * wv[bj][0]; *(f32x4*)(out + o + bj * 128 + 4) = acc[ai][bj][m][1] * rs * wv[bj][1]; } }
    }
};

__device__ __forceinline__ int wt_row_of_col(int n) {
    if (n < 4096) return n;
    if (n >= 9216) return 4096 + (n - 9216);
    int a = n - 4096;
    if (a < 3072) { const int e = a & 63; a = (a - e) + (e < 32 ? 2 * e : 2 * (e - 32) + 1); }
    return 6144 + a;
}
template <bool MAP> __device__ __forceinline__ void p0_transpose_item(const float* W, int K, int N, u16* WT, LAS float* scr, int item, int lane) {
    const int nblk = N / 32, kb = item / nblk, nb = item % nblk, k0 = 64 * kb, n0 = 32 * nb;
    float tv[32];
#pragma unroll
    for (int i = 0; i < 32; ++i) tv[i] = W[(size_t)(k0 + 2 * i + (lane >> 5)) * N + n0 + (lane & 31)];
#pragma unroll
    for (int i = 0; i < 32; ++i) scr[(2 * i + (lane >> 5)) * 33 + (lane & 31)] = tv[i];
    asm volatile("s_waitcnt lgkmcnt(0)" ::: "memory");
    const int c = lane & 7;
#pragma unroll
    for (int j = 0; j < 4; ++j) { const int n = (lane >> 3) + 8 * j; const LAS float* s = scr + (8 * c) * 33 + n;
        u32x4 o; o.x = pk_bf16(s[0 * 33], s[1 * 33]); o.y = pk_bf16(s[2 * 33], s[3 * 33]); o.z = pk_bf16(s[4 * 33], s[5 * 33]); o.w = pk_bf16(s[6 * 33], s[7 * 33]);
        const int r = MAP ? wt_row_of_col(n0 + n) : (n0 + n);
        *(u32x4*)(WT + (size_t)r * K + k0 + 8 * c) = o; }
    asm volatile("s_waitcnt lgkmcnt(0)" ::: "memory");
}
struct Ptrs { const float* x; const int* pos; const float* norm_w; const float* w_in; const float* lbl; const float* hnw; const float* wa; const float* wb; const float* wo; const float* fnw; float* out; unsigned char* ws; };

__device__ __forceinline__ void p0_prologue(const Ptrs& P, LAS unsigned char* lds, int vcu, int G) {
    const int tid = threadIdx.x, lane = tid & 63, wave = __builtin_amdgcn_readfirstlane(tid >> 6);
    LAS float* scr = (LAS float*)(lds + wave * 16384);
    const int gw = vcu * 8 + wave, NGW = G * 8;
    constexpr int I_IN = 16 * (NIN / 32), I_A = 16 * 32, I_B = 8 * 32, I_O = 16 * 32, NITEMS = I_IN + I_A + I_B + I_O;
    for (int it = gw; it < NITEMS; it += NGW) {
        int r = it;
        if (r < I_IN) { p0_transpose_item<true>(P.w_in, 1024, NIN, (u16*)(P.ws + WS_WT), scr, r, lane); continue; } r -= I_IN;
        if (r < I_A) { p0_transpose_item<false>(P.wa, 1024, 1024, (u16*)(P.ws + WS_WA), scr, r, lane); continue; } r -= I_A;
        if (r < I_B) { p0_transpose_item<false>(P.wb, 512, 1024, (u16*)(P.ws + WS_WB), scr, r, lane); continue; } r -= I_B;
        p0_transpose_item<false>(P.wo, 1024, 1024, (u16*)(P.ws + WS_WO), scr, r, lane);
    }
    u16* H = (u16*)(P.ws + WS_H);
    for (int m = gw; m < TT; m += 2 * NGW) {
        const int m2 = (m + NGW < TT) ? m + NGW : m;
        const f32x4* xr = (const f32x4*)(P.x + (size_t)m * DM) + lane; const f32x4* xr2 = (const f32x4*)(P.x + (size_t)m2 * DM) + lane; f32x4 v[4], v2[4]; float s = 0.f, s2 = 0.f;
#pragma unroll
        for (int j = 0; j < 4; ++j) { v[j] = xr[64 * j]; v2[j] = xr2[64 * j]; }
#pragma unroll
        for (int j = 0; j < 4; ++j) { s += (v[j].x * v[j].x + v[j].y * v[j].y) + (v[j].z * v[j].z + v[j].w * v[j].w); s2 += (v2[j].x * v2[j].x + v2[j].y * v2[j].y) + (v2[j].z * v2[j].z + v2[j].w * v2[j].w); }
        const float rstd = rsqrtf(wave_sum(s) * (1.0f / DM) + NORM_EPS), rstd2 = rsqrtf(wave_sum(s2) * (1.0f / DM) + NORM_EPS);
        u32x2* o8 = (u32x2*)(H + (size_t)m * DM) + lane; u32x2* o82 = (u32x2*)(H + (size_t)m2 * DM) + lane;
#pragma unroll
        for (int j = 0; j < 4; ++j) { const f32x4 w4 = ((const f32x4*)P.norm_w)[lane + 64 * j];
            o8[64 * j] = (u32x2){pk_bf16(v[j].x * rstd * w4.x, v[j].y * rstd * w4.y), pk_bf16(v[j].z * rstd * w4.z, v[j].w * rstd * w4.w)};
            o82[64 * j] = (u32x2){pk_bf16(v2[j].x * rstd2 * w4.x, v2[j].y * rstd2 * w4.y), pk_bf16(v2[j].z * rstd2 * w4.z, v2[j].w * rstd2 * w4.w)}; }
    }
    float* cosT = (float*)(P.ws + WS_COS); float* sinT = (float*)(P.ws + WS_SIN);
    for (int e = (vcu * 512 + tid); e < TT * 32; e += G * 512) {
        const int row = e >> 5, j = e & 31;
        const float inv = exp2f(-(float)j * (13.287712379549449f / 32.0f));
        const float ang = (float)P.pos[row] * inv;
        const double rev = (double)ang * 0.15915494309189535; const float fr = (float)(rev - __builtin_rint(rev));
        cosT[e] = __builtin_amdgcn_cosf(fr); sinT[e] = __builtin_amdgcn_sinf(fr);
    }
}

#define LBAR() asm volatile("s_waitcnt lgkmcnt(0)\n\ts_barrier" ::: "memory")
__device__ __forceinline__ void attn_phase(LAS unsigned char* lds, const u16* ZB, u16* OG, float* LSE, int bid, int G) {
    const int tid = threadIdx.x, lane = tid & 63, w = __builtin_amdgcn_readfirstlane(tid >> 6), l15 = lane & 15, q4 = lane >> 4, sb = w >> 2, wq = w & 3;
    constexpr int KP = 72;
    LAS u16* KI = (LAS u16*)lds; LAS u16* VI = (LAS u16*)(lds + 384 * KP * 2);
    u32x4 kr[6], vr[6]; bf16x8 qn[2][2];
#define AT_DEC(un_) const int b_ = (un_) / 192, rem_ = (un_) % 192, g_ = rem_ >> 6, h_ = (rem_ >> 3) & 7, su_ = rem_ & 7; \
        const int d_ = (g_ == 0) ? 1 : (g_ == 1 ? 4 : 16); const size_t tb_ = (size_t)b_ * SEQ; \
        const int r0_ = (g_ == 0) ? 0 : (g_ == 1 ? (su_ >> 1) : 2 * su_), c0_ = (g_ == 0) ? 2 * su_ : (g_ == 1 ? 2 * (su_ & 1) : 0); \
        const int rq_ = (g_ == 2) ? r0_ + sb : r0_, cq_ = (g_ == 2) ? 0 : c0_ + sb;
#define AT_LOAD(un_) do { AT_DEC(un_) \
        _Pragma("unroll") for (int i = 0; i < 6; ++i) { const int id = tid + 512 * i, j = id >> 3, ch = id & 7; \
            const int mp = (g_ == 2) ? (j & 127) : 128 * (c0_ - 1) + j, rr = (g_ == 2) ? r0_ + (j >> 7) : r0_; \
            kr[i] = (u32x4){0u, 0u, 0u, 0u}; vr[i] = (u32x4){0u, 0u, 0u, 0u}; \
            if (mp >= 0 && (g_ != 2 || j < 256)) { const size_t tk_ = tb_ + (size_t)mp * d_ + rr; kr[i] = *(const u32x4*)(ZB + ((size_t)(24 + g_ * 8 + h_) * TT + tk_) * 64 + 8 * ch); vr[i] = *(const u32x4*)(ZB + ((size_t)(48 + g_ * 8 + h_) * TT + tk_) * 64 + 8 * ch); } } \
        _Pragma("unroll") for (int qt = 0; qt < 2; ++qt) { const size_t tq_ = tb_ + (size_t)(128 * cq_ + 32 * wq + 16 * qt + l15) * d_ + rq_; \
            _Pragma("unroll") for (int ds = 0; ds < 2; ++ds) qn[qt][ds] = *(const bf16x8*)(ZB + ((size_t)(g_ * 8 + h_) * TT + tq_) * 64 + 32 * ds + 8 * q4); } } while (0)
    const bool xl = (G == 256); const int ustep = xl ? 32 : G, ubase = xl ? (bid & 7) * 192 : 0, ulim = xl ? ubase + 192 : 1536;
    { const int u0 = ubase + (xl ? (bid >> 3) : bid); AT_LOAD((u0 < ulim ? u0 : ulim - 1)); }
    for (int un = ubase + (xl ? (bid >> 3) : bid); un < ulim; un += ustep) {
        AT_DEC(un)
        const int g = g_, h = h_; const bool prev_ok = (g_ != 2) && (cq_ > 0); const int wbase = (g_ == 2) ? 128 * sb - 128 : 128 * sb;
        size_t tq[2];
#pragma unroll
        for (int qt = 0; qt < 2; ++qt) tq[qt] = tb_ + (size_t)(128 * cq_ + 32 * wq + 16 * qt + l15) * d_ + rq_;
#pragma unroll
        for (int i = 0; i < 6; ++i) { const int id = tid + 512 * i, j = id >> 3, ch = id & 7; *(LAS u32x4*)(KI + j * KP + 8 * ch) = kr[i]; *(LAS u32x4*)(VI + j * KP + 8 * ch) = vr[i]; }
        bf16x8 qf[2][2];
#pragma unroll
        for (int qt = 0; qt < 2; ++qt) { qf[qt][0] = qn[qt][0]; qf[qt][1] = qn[qt][1]; }
        LBAR();
        { const int nx = (un + ustep < ulim) ? un + ustep : un; AT_LOAD(nx); }
        f32x4 st[5][2][2]; float mx[2] = {-INFINITY, -INFINITY};
#pragma unroll
        for (int p = 0; p < 5; ++p) { const int a = wq + p; const bool on = prev_ok || a >= 4;
#pragma unroll
            for (int t = 0; t < 2; ++t) {
                if (on) { const int j0 = 32 * a + 16 * t, k = 2 * p + t; f32x4 s0 = (f32x4){0.f, 0.f, 0.f, 0.f}, s1 = (f32x4){0.f, 0.f, 0.f, 0.f};
#pragma unroll
                    for (int ds = 0; ds < 2; ++ds) { const bf16x8 kf = *(const LAS bf16x8*)(KI + (wbase + j0 + l15) * KP + 32 * ds + 8 * q4); if (k <= 8) s0 = mfma16(kf, qf[0][ds], s0); if (k >= 1) s1 = mfma16(kf, qf[1][ds], s1); }
#pragma unroll
                    for (int i = 0; i < 4; ++i) { const int kk = 4 * q4 + i;
                        if (k == 0) s0[i] = (kk >= l15) ? s0[i] : -INFINITY; if (k == 8) s0[i] = (kk <= l15) ? s0[i] : -INFINITY; if (k == 9) s0[i] = -INFINITY;
                        if (k == 1) s1[i] = (kk >= l15) ? s1[i] : -INFINITY; if (k == 9) s1[i] = (kk <= l15) ? s1[i] : -INFINITY; if (k == 0) s1[i] = -INFINITY;
                        mx[0] = fmaxf(mx[0], s0[i]); mx[1] = fmaxf(mx[1], s1[i]); }
                    st[p][t][0] = s0; st[p][t][1] = s1;
                } else { st[p][t][0] = (f32x4){-INFINITY, -INFINITY, -INFINITY, -INFINITY}; st[p][t][1] = st[p][t][0]; } } }
        float l[2] = {0.f, 0.f}; bf16x8 pf[5][2];
#pragma unroll
        for (int qt = 0; qt < 2; ++qt) { mx[qt] = fmaxf(mx[qt], __shfl_xor(mx[qt], 16)); mx[qt] = fmaxf(mx[qt], __shfl_xor(mx[qt], 32)); }
#pragma unroll
        for (int p = 0; p < 5; ++p)
#pragma unroll
            for (int qt = 0; qt < 2; ++qt) { float e[8];
#pragma unroll
                for (int t = 0; t < 2; ++t)
#pragma unroll
                    for (int i = 0; i < 4; ++i) { e[4 * t + i] = __builtin_amdgcn_exp2f(st[p][t][qt][i] - mx[qt]); l[qt] += e[4 * t + i]; }
                u32x4 pw; pw.x = pk_bf16(e[0], e[1]); pw.y = pk_bf16(e[2], e[3]); pw.z = pk_bf16(e[4], e[5]); pw.w = pk_bf16(e[6], e[7]); pf[p][qt] = __builtin_bit_cast(bf16x8, pw); }
#pragma unroll
        for (int qt = 0; qt < 2; ++qt) { l[qt] += __shfl_xor(l[qt], 16); l[qt] += __shfl_xor(l[qt], 32); }
        f32x4 o[4][2];
#pragma unroll
        for (int dt = 0; dt < 4; ++dt) { o[dt][0] = (f32x4){0.f, 0.f, 0.f, 0.f}; o[dt][1] = (f32x4){0.f, 0.f, 0.f, 0.f}; }
#pragma unroll
        for (int p = 0; p < 5; ++p) { const int a = wq + p; const bool on = prev_ok || a >= 4;
            if (on) {
#pragma unroll
                for (int dt = 0; dt < 4; ++dt) { const LAS u16* vp = VI + (wbase + 32 * a + 4 * q4 + (l15 >> 2)) * KP + 16 * dt + 4 * (l15 & 3);
                    const s16x4 lo = ds_tr(vp), hi = ds_tr(vp + 16 * KP); const bf16x8 vf = cat8(lo, hi); o[dt][0] = mfma16(vf, pf[p][0], o[dt][0]); o[dt][1] = mfma16(vf, pf[p][1], o[dt][1]); } } }
        LAS u16* stg = (LAS u16*)(lds + 2 * 384 * KP * 2 + w * 4608);
#pragma unroll
        for (int qt = 0; qt < 2; ++qt) { const float il = 1.0f / l[qt];
#pragma unroll
            for (int dt = 0; dt < 4; ++dt) *(LAS u32x2*)(stg + (16 * qt + l15) * 72 + 16 * dt + 4 * q4) = (u32x2){pk_bf16(o[dt][qt][0] * il, o[dt][qt][1] * il), pk_bf16(o[dt][qt][2] * il, o[dt][qt][3] * il)};
            if (q4 == 0) LSE[(size_t)g * TT * 8 + tq[qt] * 8 + h] = mx[qt] + __log2f(l[qt]); }
        asm volatile("s_waitcnt lgkmcnt(0)" ::: "memory");
#pragma unroll
        for (int i = 0; i < 4; ++i) { const int row = i * 8 + (lane >> 3), ch = lane & 7; const u32x4 v = *(const LAS u32x4*)(stg + row * 72 + 8 * ch);
            const size_t tr = tb_ + (size_t)(128 * cq_ + 32 * wq + row) * d_ + rq_;
            *(u32x4*)(OG + (size_t)g * TT * 512 + tr * 512 + h * 64 + 8 * ch) = v; }
        LBAR();
    }
#undef AT_DEC
#undef AT_LOAD
}
__device__ __forceinline__ void merge_phase(u16* OG, const float* LSE, const u16* AG, int bid, int nb) {
    for (int idx = bid * 512 + threadIdx.x; idx < TT * 64; idx += nb * 512) {
        const int tok = idx >> 6, h = (idx >> 3) & 7, ch = idx & 7; const size_t off = (size_t)tok * 512 + h * 64 + 8 * ch;
        const float l0 = LSE[(size_t)tok * 8 + h], l1 = LSE[(size_t)TT * 8 + (size_t)tok * 8 + h], l2 = LSE[(size_t)2 * TT * 8 + (size_t)tok * 8 + h];
        const float m = fmaxf(l0, fmaxf(l1, l2)); float w0 = __builtin_amdgcn_exp2f(l0 - m), w1 = __builtin_amdgcn_exp2f(l1 - m), w2 = __builtin_amdgcn_exp2f(l2 - m);
        const float inv = 1.0f / (w0 + w1 + w2); w0 *= inv; w1 *= inv; w2 *= inv;
        const u32x4 a = *(const u32x4*)(OG + off), bq = *(const u32x4*)(OG + (size_t)TT * 512 + off), cq = *(const u32x4*)(OG + (size_t)2 * TT * 512 + off), gq = *(const u32x4*)(AG + off);
        u32x4 o;
#define MRG(F) o.F = pk_bf16((w0 * bflo(a.F) + w1 * bflo(bq.F) + w2 * bflo(cq.F)) * bflo(gq.F), (w0 * bfhi(a.F) + w1 * bfhi(bq.F) + w2 * bfhi(cq.F)) * bfhi(gq.F))
        MRG(x); MRG(y); MRG(z); MRG(w);
#undef MRG
        store16_wt(OG + off, o);
    }
}

template <int MODE = 0> __device__ __forceinline__ void hgrn_unit(LAS unsigned char* lds, int b, int h, const u16* QA, const u16* GG, const u16* VA, const u16* HG, const float* nw, u16* OA, unsigned* dcnt) {
    const int tid = threadIdx.x, lane = tid & 63, w = __builtin_amdgcn_readfirstlane(tid >> 6), l15 = lane & 15, q4 = lane >> 4;
    constexpr int P = 136, IMGB = 52224;
    LAS u16* SB = (LAS u16*)(lds + 104448); LAS float* TOT = (LAS float*)(lds + 139264); LAS float* DFB = (LAS float*)(lds + 143360); LAS float* SSQ = (LAS float*)(lds + 146432);
    f32x4 S[8];
#pragma unroll
    for (int i = 0; i < 8; ++i) S[i] = (f32x4){0.f, 0.f, 0.f, 0.f};
    const int kp = lane, seg = w, tt = (w < 4) ? (w >> 1) : 3 - ((w - 4) >> 1), vh = w & 1;
    const size_t tok0 = (size_t)b * SEQ, hbase = (size_t)(b * 8 + h) * SEQ;
    unsigned gq0[8], qq0[8], gq1[8], qq1[8]; u32x4 vv0[2], vv1[2]; u32x2 hg0[4], hg1[4];
    f32x4 O[4]; float sqp = 0.f;
#pragma unroll
    for (int j = 0; j < 4; ++j) O[j] = (f32x4){0.f, 0.f, 0.f, 0.f};
#define HG_LOAD(c, gq, qq, vv) do { const size_t t0_ = tok0 + 64 * (c); \
        const size_t hb_ = hbase + 64 * (c); \
        _Pragma("unroll") for (int i = 0; i < 8; ++i) { const size_t o_ = (t0_ + 8 * seg + i) * 1024 + h * 128 + 2 * kp; gq[i] = *(const unsigned*)(GG + (hb_ + 8 * seg + i) * 128 + 2 * kp); qq[i] = *(const unsigned*)(QA + o_); } \
        _Pragma("unroll") for (int u_ = 0; u_ < 2; ++u_) { const int id_ = tid + 512 * u_; vv[u_] = *(const u32x4*)(VA + (hb_ + (id_ >> 4)) * 128 + 8 * (id_ & 15)); } } while (0)
#define HG_LOADG(c, hgv) do { const size_t tq_ = hbase + 64 * (c) + 16 * tt + l15; \
        _Pragma("unroll") for (int j = 0; j < 4; ++j) hgv[j] = *(const u32x2*)(HG + tq_ * 128 + 16 * (4 * vh + j) + 4 * q4); } while (0)
#define HG_PREP1(gq) do { float r0_ = 1.f, r1_ = 1.f; \
        _Pragma("unroll") for (int i = 0; i < 8; ++i) { r0_ *= f16lo(gq[i]); r1_ *= f16hi(gq[i]); } \
        *(LAS f32x2*)(TOT + seg * 128 + 2 * kp) = (f32x2){__log2f(r0_), __log2f(r1_)}; } while (0)
#define HG_PREP2(buf, gq, qq, vv) do { LAS u16* QM_ = (LAS u16*)(lds + (buf) * IMGB); LAS u16* KM_ = (LAS u16*)(lds + (buf) * IMGB + 17408); LAS u16* VI_ = (LAS u16*)(lds + (buf) * IMGB + 34816); LAS float* DF_ = DFB + (buf) * 384; \
        float off0 = 0.f, off1 = 0.f, br0 = 0.f, br1 = 0.f, bl0 = 0.f, bl1 = 0.f; \
        _Pragma("unroll") for (int s2 = 0; s2 < 8; ++s2) { const f32x2 t_ = *(const LAS f32x2*)(TOT + s2 * 128 + 2 * kp); \
            if (s2 < seg) { off0 += t_.x; off1 += t_.y; } if (s2 < 4) { br0 += t_.x; br1 += t_.y; } bl0 += t_.x; bl1 += t_.y; } \
        off0 -= br0; off1 -= br1; \
        float E0 = __builtin_amdgcn_exp2f(fminf(off0, 115.f)), E1 = __builtin_amdgcn_exp2f(fminf(off1, 115.f)), I0 = __builtin_amdgcn_exp2f(fminf(-off0, 115.f)), I1 = __builtin_amdgcn_exp2f(fminf(-off1, 115.f)); \
        _Pragma("unroll") for (int i = 0; i < 8; ++i) { const int s_ = 8 * seg + i; const float f0_ = f16lo(gq[i]), f1_ = f16hi(gq[i]); \
            E0 *= f0_; E1 *= f1_; I0 *= __builtin_amdgcn_rcpf(f0_); I1 *= __builtin_amdgcn_rcpf(f1_); \
            *(LAS unsigned*)(QM_ + s_ * P + 2 * kp) = pk_bf16(bflo(qq[i]) * E0, bfhi(qq[i]) * E1); \
            *(LAS unsigned*)(KM_ + s_ * P + 2 * kp) = pk_bf16((1.0f - f0_) * I0, (1.0f - f1_) * I1); } \
        if (seg == 0) { *(LAS f32x2*)(DF_ + 2 * kp) = (f32x2){__builtin_amdgcn_exp2f(bl0), __builtin_amdgcn_exp2f(bl1)}; *(LAS f32x2*)(DF_ + 128 + 2 * kp) = (f32x2){__builtin_amdgcn_exp2f(bl0 - br0), __builtin_amdgcn_exp2f(bl1 - br1)}; *(LAS f32x2*)(DF_ + 256 + 2 * kp) = (f32x2){__builtin_amdgcn_exp2f(br0), __builtin_amdgcn_exp2f(br1)}; } \
        _Pragma("unroll") for (int u_ = 0; u_ < 2; ++u_) { const int id_ = tid + 512 * u_; *(LAS u32x4*)(VI_ + (id_ >> 4) * P + 8 * (id_ & 15)) = vv[u_]; } } while (0)
#define HG_STAGE(hgv) do { \
        _Pragma("unroll") for (int j = 0; j < 4; ++j) { const f32x4 n4 = nwv[j]; const int row_ = 16 * tt + l15, c16_ = 2 * (4 * vh + j) + (q4 >> 1); \
            *(LAS u32x2*)(STG + row_ * 256 + ((c16_ ^ l15) << 4) + 8 * (q4 & 1)) = (u32x2){pk_bf16(O[j][0] * n4[0] * bflo(hgv[j].x), O[j][1] * n4[1] * bfhi(hgv[j].x)), \
                                                                                         pk_bf16(O[j][2] * n4[2] * bflo(hgv[j].y), O[j][3] * n4[3] * bfhi(hgv[j].y))}; } } while (0)
#define HG_COPY(c) do { \
        _Pragma("unroll") for (int u_ = 0; u_ < 2; ++u_) { const int id_ = tid + 512 * u_, row_ = id_ >> 4, ch_ = id_ & 15; \
            const float sc_ = rsqrtf((SSQ[((row_ >> 4) * 2) * 16 + (row_ & 15)] + SSQ[((row_ >> 4) * 2 + 1) * 16 + (row_ & 15)]) * (1.0f / 128.0f) + NORM_EPS); \
            const u32x4 v_ = *(const LAS u32x4*)(STG + row_ * 256 + ((ch_ ^ (row_ & 15)) << 4)); u32x4 o_; \
            o_.x = pk_bf16(bflo(v_.x) * sc_, bfhi(v_.x) * sc_); o_.y = pk_bf16(bflo(v_.y) * sc_, bfhi(v_.y) * sc_); o_.z = pk_bf16(bflo(v_.z) * sc_, bfhi(v_.z) * sc_); o_.w = pk_bf16(bflo(v_.w) * sc_, bfhi(v_.w) * sc_); \
            if (MODE & 8) { dacc_ ^= o_.x ^ o_.w; } else *(u32x4*)(OA + (tok0 + 64 * (c) + row_) * 1024 + h * 128 + 8 * ch_) = o_; } } while (0)
    unsigned dacc_ = 0u;
    LAS unsigned char* STG = lds + 146944;
    f32x4 nwv[4];
#pragma unroll
    for (int j = 0; j < 4; ++j) nwv[j] = *(const f32x4*)(nw + 16 * (4 * vh + j) + 4 * q4);
    HG_LOAD(0, gq0, qq0, vv0); HG_LOADG(0, hg0); HG_LOADG(0, hg1); if (tid < 128) SSQ[tid] = 1.0f; HG_PREP1(gq0); LBAR(); HG_PREP2(0, gq0, qq0, vv0);
    for (int i = tid; i < 128 * P / 2; i += 512) ((LAS unsigned*)SB)[i] = 0u;
    HG_LOAD(1, gq1, qq1, vv1); HG_LOAD(2, gq0, qq0, vv0); LBAR(); HG_PREP1(gq1); LBAR();
#ifdef PROBE_ACC
    unsigned tacc_ = 0u, tlast_ = (unsigned)__builtin_amdgcn_s_memrealtime();
#define HG_T(k) do { if (blockIdx.x == 0 && tid == 448) { const unsigned n_ = (unsigned)__builtin_amdgcn_s_memrealtime(); if ((k) == PROBE_ACC) tacc_ += n_ - tlast_; tlast_ = n_; } } while (0)
#else
#define HG_T(k) do {} while (0)
#endif
#define HG_STEP(c, G2, Q2, V2, G1, HGU, HGL) do { HG_T(2); \
        const int cur = (c) & 1, nxt = cur ^ 1; \
        const LAS u16* QM = (const LAS u16*)(lds + cur * IMGB); const LAS u16* KM = (const LAS u16*)(lds + cur * IMGB + 17408); const LAS u16* VI = (const LAS u16*)(lds + cur * IMGB + 34816); const LAS float* DF = DFB + cur * 384; \
        if (!(MODE & 4)) HG_COPY(((c) > 0 ? (c) - 1 : 0)); \
        if (!(MODE & 2)) HG_PREP2(nxt, G2, Q2, V2); HG_LOADG(((c) + 1 < 32 ? (c) + 1 : 31), HGL); \
        HG_LOAD(((c) + 3 < 32 ? (c) + 3 : 31), G2, Q2, V2); HG_T(0); \
        if (!(MODE & 1)) { \
        bf16x8 qm[4]; \
        _Pragma("unroll") for (int ks = 0; ks < 4; ++ks) qm[ks] = *(const LAS bf16x8*)(QM + (16 * tt + l15) * P + 32 * ks + 8 * q4); \
        f32x4 Dm[4]; \
        _Pragma("unroll") for (int st = 0; st < 4; ++st) { Dm[st] = (f32x4){0.f, 0.f, 0.f, 0.f}; \
            _Pragma("unroll") for (int ks = 0; ks < 4; ++ks) { const bf16x8 kf = *(const LAS bf16x8*)(KM + (16 * st + l15) * P + 32 * ks + 8 * q4); Dm[st] = mfma16(kf, qm[ks], Dm[st]); } \
            _Pragma("unroll") for (int i = 0; i < 4; ++i) { const bool keep_ = (st < tt) || (st == tt && 4 * q4 + i <= l15); Dm[st][i] = keep_ ? Dm[st][i] : 0.f; } } \
        bf16x8 pf[2]; \
        _Pragma("unroll") for (int a = 0; a < 2; ++a) { u32x4 pw; pw.x = pk_bf16(Dm[2 * a][0], Dm[2 * a][1]); pw.y = pk_bf16(Dm[2 * a][2], Dm[2 * a][3]); pw.z = pk_bf16(Dm[2 * a + 1][0], Dm[2 * a + 1][1]); pw.w = pk_bf16(Dm[2 * a + 1][2], Dm[2 * a + 1][3]); pf[a] = __builtin_bit_cast(bf16x8, pw); } \
        _Pragma("unroll") for (int j = 0; j < 4; ++j) { const int vt = 4 * vh + j; f32x4 o = (f32x4){0.f, 0.f, 0.f, 0.f}; \
            _Pragma("unroll") for (int a = 0; a < 2; ++a) { const LAS u16* vp = VI + (32 * a + 4 * q4 + (l15 >> 2)) * P + 16 * vt + 4 * (l15 & 3); \
                const s16x4 lo = ds_tr(vp), hi = ds_tr(vp + 16 * P); o = mfma16(cat8(lo, hi), pf[a], o); } \
            _Pragma("unroll") for (int ks = 0; ks < 4; ++ks) { const bf16x8 sf = *(const LAS bf16x8*)(SB + (16 * vt + l15) * P + 32 * ks + 8 * q4); o = mfma16(sf, qm[ks], o); } \
            O[j] = o; } \
        { bf16x8 ka[2]; \
            _Pragma("unroll") for (int a = 0; a < 2; ++a) { const LAS u16* kpp = KM + (32 * a + 8 * q4 + (l15 >> 2)) * P + 16 * w + 4 * (l15 & 3); const s16x4 lo = ds_tr(kpp), hi = ds_tr(kpp + 4 * P); ka[a] = cat8(lo, hi); } \
            const f32x4 d1 = *(const LAS f32x4*)(DF + 16 * w + 4 * q4), d2 = *(const LAS f32x4*)(DF + 128 + 16 * w + 4 * q4); \
            _Pragma("unroll") for (int vt = 0; vt < 8; ++vt) { f32x4 U = (f32x4){0.f, 0.f, 0.f, 0.f}; \
                _Pragma("unroll") for (int a = 0; a < 2; ++a) { const LAS u16* vp = VI + (32 * a + 8 * q4 + (l15 >> 2)) * P + 16 * vt + 4 * (l15 & 3); const s16x4 lo = ds_tr(vp), hi = ds_tr(vp + 4 * P); U = mfma16(ka[a], cat8(lo, hi), U); } \
                S[vt] = d1 * S[vt] + d2 * U; } } \
        { float sq = 0.f; \
            _Pragma("unroll") for (int j = 0; j < 4; ++j) sq += (O[j][0] * O[j][0] + O[j][1] * O[j][1]) + (O[j][2] * O[j][2] + O[j][3] * O[j][3]); \
            sq += __shfl_xor(sq, 16); sq += __shfl_xor(sq, 32); sqp = sq; } } \
        HG_T(1); \
        LBAR(); HG_T(2); \
        { const f32x4 eb = *(const LAS f32x4*)(DFB + nxt * 384 + 256 + 16 * w + 4 * q4); \
            _Pragma("unroll") for (int vt = 0; vt < 8; ++vt) *(LAS u32x2*)(SB + (16 * vt + l15) * P + 16 * w + 4 * q4) = (u32x2){pk_bf16(S[vt][0] * eb[0], S[vt][1] * eb[1]), pk_bf16(S[vt][2] * eb[2], S[vt][3] * eb[3])}; } \
        if (q4 == 0) SSQ[(tt * 2 + vh) * 16 + l15] = sqp; \
        if (!(MODE & 4)) HG_STAGE(HGU); \
        if (!(MODE & 2)) HG_PREP1(G1); HG_T(3); \
        LBAR(); } while (0)
    for (int c = 0; c < 32; c += 2) {
        if (c == 20 && dcnt) {
            if (tid == 0) { unsigned sp = 0u;
                while (__hip_atomic_load(dcnt + 64 * (8 * b + 6), __ATOMIC_RELAXED, __HIP_MEMORY_SCOPE_AGENT) < 16u || __hip_atomic_load(dcnt + 64 * (8 * b + 7), __ATOMIC_RELAXED, __HIP_MEMORY_SCOPE_AGENT) < 16u) { __builtin_amdgcn_s_sleep(2); if (++sp > (1u << 22)) break; }
                __builtin_amdgcn_fence(__ATOMIC_ACQUIRE, "agent"); asm volatile("s_waitcnt vmcnt(0)" ::: "memory"); }
            LBAR(); }
        HG_STEP(c, gq1, qq1, vv1, gq0, hg0, hg1);
        HG_STEP(c + 1, gq0, qq0, vv0, gq1, hg1, hg0);
    }
    HG_COPY(31);
    if (MODE & 8) { if (dacc_ == 0x12345678u) OA[tid] = (u16)dacc_; }
#ifdef PROBE_ACC
    if (blockIdx.x == 0 && tid == 448) ((LAS unsigned long long*)(lds + 163344))[10] = (unsigned long long)tacc_;
#endif
#undef HG_STEP
#undef HG_LOAD
#undef HG_LOADG
#undef HG_PREP1
#undef HG_PREP2
#undef HG_STAGE
#undef HG_COPY
    LBAR();
}

#define XB_TMO      128
#define XB_XCNT(j)  (256  + 64 * (j))
#define XB_XSUB(j)  (1280 + 64 * (j))
#define XB_XGEN(j)  (2304 + 64 * (j))
#define XB_TOP      3328
#define XB_TOPGEN   3392
#define XCD_BAR_WORDS 3456
#define XB_SPIN_CAP (1u << 18)

__device__ __forceinline__ unsigned xb_ld(unsigned* p)              { return __hip_atomic_load(p, __ATOMIC_RELAXED, __HIP_MEMORY_SCOPE_AGENT); }
__device__ __forceinline__ unsigned xb_add(unsigned* p, unsigned v) { return __hip_atomic_fetch_add(p, v, __ATOMIC_RELAXED, __HIP_MEMORY_SCOPE_AGENT); }
__device__ __forceinline__ unsigned xb_xcc_id() { return (unsigned)__builtin_amdgcn_s_getreg((3 << 11) | 20) & 0xFu; }
#define XB_SPIN(cond, bar) do { unsigned _sp = 0; while (cond) { __builtin_amdgcn_s_sleep(1); \
    if ((++_sp & 255u) == 0u) { if (xb_ld(&(bar)[XB_TMO])) break; if (_sp > XB_SPIN_CAP) { atomicAdd(&(bar)[XB_TMO], 1u); break; } } } } while (0)

struct XcdBarrier {
    unsigned* bar; unsigned x;
    volatile LAS unsigned* st;
};

__device__ __forceinline__ XcdBarrier xcd_barrier_post(unsigned* bar, volatile LAS unsigned* st) {
    XcdBarrier b; b.bar = bar; b.x = xb_xcc_id(); b.st = st;
    if (threadIdx.x == 0) (void)xb_add(&bar[XB_XCNT(b.x)], 1u);
    return b;
}
__device__ __forceinline__ void xcd_barrier_complete(unsigned* bar, unsigned x, unsigned& nloc, unsigned& nx) {
    const unsigned G = gridDim.x * gridDim.y * gridDim.z;
    unsigned sum, cnt, mine, sp = 0u;
    for (;;) {
        sum = 0u; cnt = 0u; mine = 0u;
#pragma unroll
        for (unsigned j = 0; j < 16; ++j) { const unsigned c = xb_ld(&bar[XB_XCNT(j)]); sum += c; cnt += (c > 0u) ? 1u : 0u; mine = (j == x) ? c : mine; }
        if (sum == G) break;
        __builtin_amdgcn_s_sleep(1);
        if ((++sp & 255u) == 0u) { if (xb_ld(&bar[XB_TMO])) break; if (sp > XB_SPIN_CAP) { atomicAdd(&bar[XB_TMO], 1u); break; } }
    }
    nloc = mine > 0u ? mine : 1u; nx = cnt > 0u ? cnt : 1u;
}

__device__ __forceinline__ void xcd_barrier(const XcdBarrier& b) {
    asm volatile("s_waitcnt vmcnt(0)" ::: "memory");
    __syncthreads();
    if (threadIdx.x == 0) {
        unsigned* bar = b.bar;
        __builtin_amdgcn_s_waitcnt(0);
        unsigned nloc = b.st[0], nx = b.st[1];
        if (nloc == 0u) { xcd_barrier_complete(bar, b.x, nloc, nx); b.st[0] = nloc; b.st[1] = nx; }
        const unsigned old = xb_add(&bar[XB_XSUB(b.x)], 1u);
        const unsigned gen = old / nloc;
        if (old + 1u == (gen + 1u) * nloc) {
            __builtin_amdgcn_fence(__ATOMIC_RELEASE, "agent");
            asm volatile("s_waitcnt vmcnt(0)" ::: "memory");
            const unsigned og = xb_add(&bar[XB_TOP], 1u);
            const unsigned tg = og / nx;
            if (og + 1u == (tg + 1u) * nx) xb_add(&bar[XB_TOPGEN], 1u);
            else XB_SPIN(xb_ld(&bar[XB_TOPGEN]) == tg, bar);
            __builtin_amdgcn_fence(__ATOMIC_ACQUIRE, "agent");
            xb_add(&bar[XB_XGEN(b.x)], 1u);
            asm volatile("s_waitcnt vmcnt(0)" ::: "memory");
        } else {
            XB_SPIN(xb_ld(&bar[XB_XGEN(b.x)]) == gen, bar);
            __builtin_amdgcn_fence(__ATOMIC_ACQUIRE, "agent");
            asm volatile("s_waitcnt vmcnt(0)" ::: "memory");
        }
    }
    __syncthreads();
}

struct Args { const float* in[10]; float* out; unsigned char* ws; int ph_lo, ph_hi; };
__global__ void __launch_bounds__(512, 2) fwd_megakernel(Args a) {
    extern __shared__ __attribute__((aligned(16))) unsigned char lds_raw[];
    LAS unsigned char* lds = (LAS unsigned char*)lds_raw;
    cg::grid_group grid = cg::this_grid();
    const int G = gridDim.x, bx = blockIdx.x, vcu = (G % 8 == 0) ? (bx % 8) * (G / 8) + bx / 8 : bx;
    const int tid = threadIdx.x, lane = tid & 63, wave = __builtin_amdgcn_readfirstlane(tid >> 6);
    Ptrs P; P.x = a.in[0]; P.pos = (const int*)a.in[1]; P.norm_w = a.in[2]; P.w_in = a.in[3]; P.lbl = a.in[4]; P.hnw = a.in[5]; P.wa = a.in[6]; P.wb = a.in[7]; P.wo = a.in[8]; P.fnw = a.in[9];
    P.out = a.out; P.ws = a.ws;
    unsigned char* ws = a.ws; unsigned char* dout = (unsigned char*)a.out;
    const int lo = a.ph_lo, hi = a.ph_hi;
#ifndef REP_MASK
#define REP_MASK 0
#endif
#define IN(k) (lo <= (k) && (k) < hi)
#define REPS(k) for (int rep_ = 0; rep_ < 1 + ((REP_MASK >> (k)) & 1); ++rep_)
#ifdef PROBE_K
#ifndef PROBE_A
#define PROBE_A PROBE_K
#define PROBE_B (PROBE_K + 1)
#endif
#define STAMP(k) do { if (bx == 0 && tid == 0) ((LAS unsigned long long*)(lds + 163344))[k] = __builtin_amdgcn_s_memrealtime(); } while (0)
#else
#define STAMP(k) do {} while (0)
#endif
#define SEAM(k) do { if (IN(k) && IN((k) + 1)) xcd_barrier(bar); STAMP((k) + 1); } while (0)
    if (tid < 4) ((LAS unsigned*)(lds + 163328))[tid] = 0u;
    __syncthreads();
    const XcdBarrier bar = xcd_barrier_post((unsigned*)(ws + WS_BAR), (volatile LAS unsigned*)(lds + 163328));
    if (a.ph_hi > 1000) grid.sync();
    STAMP(0);
    if (IN(0)) REPS(0) p0_prologue(P, lds, vcu, G);
    SEAM(0);
#ifdef EXTRA_SYNCS
    for (int i_ = 0; i_ < EXTRA_SYNCS; ++i_) xcd_barrier(bar);
#endif
    if (IN(1)) REPS(1) { pg8::Gemm g{(const u16*)(ws + WS_H), (const u16*)(ws + WS_WT) + (size_t)6144 * 1024, TT, 5120, 1024}; pg8::StaticOrder S; S.init(TT, 5120, G, bx);
        EpiZ E{0, ws, dout, P.lbl}; pg8::gemm_phase<EpiZ, pg8::StaticOrder, true, true>(lds, g, S, E); }
    SEAM(1);
    if (IN(2)) REPS(2) attn_phase(lds, (const u16*)(ws + WS_Z), (u16*)(dout + DO_OG), (float*)(ws + WS_COS), bx, G);
    SEAM(2);
    if (IN(3)) {
        pg8::Gemm g{(const u16*)(ws + WS_H), (const u16*)(ws + WS_WT), TT, 4096, 1024}; DefOrder S; S.base.init(48 * 256, 4096, G, bx);
        EpiZ E{1, ws, dout, P.lbl}; pg8::gemm_phase<EpiZ, DefOrder, true, true>(lds, g, S, E); }
    SEAM(3);
    if (IN(4)) {
        {
            if (bx < 64) { hgrn_unit(lds, bx & 7, bx >> 3, (const u16*)(ws + Z_QA), (const u16*)(ws + Z_G), (const u16*)(ws + Z_VA), (const u16*)(ws + Z_HG), P.hnw, (u16*)(ws + Z_QA), (unsigned*)(ws + WS_BAR + 36864)); STAMP(9);
            }
            else { const int x = bx & 7, r = (bx >> 3) - 8;
                const pg8::Gemm gG{(const u16*)(ws + WS_H), (const u16*)(ws + WS_WT) + (size_t)4096 * 1024, TT, 2048, 1024}; const pg8::Gemm gB{(const u16*)(dout + DO_OG), (const u16*)(ws + WS_WB), TT, 1024, 512};
                const EpiZ EG{2, ws, dout, P.lbl}; const EpiGateB EB{(const u16*)(ws + Z_GATES), (u16*)(dout + DO_TMPB)};
                unsigned lg, lb2;
                if (r < 8) { lg = lo_code(r, 4) | (lo_code(r + 24, 4) << 8) | 0xffff0000u; lb2 = lo_code(r, 0) | (lo_code(r + 24, 0) << 8) | 0xffff0000u; }
                else { lg = lo_code(r, 4) | (lo_code(2 * (r - 8), 0) << 8) | (lo_code(2 * (r - 8) + 1, 0) << 16) | 0xff000000u; lb2 = lo_code(r, 0) | 0xffffff00u; }
                unsigned* mcnt = (unsigned*)(ws + WS_BAR + 16384 + 64 * 64 * 4);
                unsigned* dcnt = (unsigned*)(ws + WS_BAR + 36864);
                { unsigned ld; if (r < 8) ld = (unsigned)(((2 * r) << 3) | 6) | ((unsigned)(((2 * r + 1) << 3) | 6) << 8) | 0xffff0000u; else ld = (unsigned)(((r - 8) << 3) | 7) | 0xffffff00u;
                  const pg8::Gemm gD{(const u16*)(ws + WS_H), (const u16*)(ws + WS_WT), TT, 4096, 1024}; const EpiZT<true> ED{1, ws, dout, P.lbl};
                  ListOrder S{8 * x, ld}; pg8::gemm_phase<EpiZT<true>, ListOrder, true, true>(lds, gD, S, ED);
                  asm volatile("s_waitcnt vmcnt(0)" ::: "memory"); __syncthreads();
                  if (tid == 0) __hip_atomic_fetch_add(dcnt + 64 * (8 * x + (r < 8 ? 6 : 7)), (r < 8 ? 2u : 1u), __ATOMIC_RELAXED, __HIP_MEMORY_SCOPE_AGENT); }
                merge_phase((u16*)(dout + DO_OG), (const float*)(ws + WS_COS), (const u16*)(dout + DO_AG), bx - 64, 192);
                asm volatile("s_waitcnt vmcnt(0)" ::: "memory"); __syncthreads();
                if (tid == 0) __hip_atomic_fetch_add(mcnt, 1u, __ATOMIC_RELAXED, __HIP_MEMORY_SCOPE_AGENT);
                { ListOrder S{8 * x, lg}; pg8::gemm_phase<EpiZ, ListOrder, true, true>(lds, gG, S, EG); }
                if (tid == 0) { unsigned sp = 0u; while (__hip_atomic_load(mcnt, __ATOMIC_RELAXED, __HIP_MEMORY_SCOPE_AGENT) < 192u) { __builtin_amdgcn_s_sleep(2); if (++sp > (1u << 22)) break; }
                    __builtin_amdgcn_fence(__ATOMIC_ACQUIRE, "agent"); asm volatile("s_waitcnt vmcnt(0)" ::: "memory"); }
                __syncthreads();
                { ListOrder S{8 * x, lb2}; pg8::gemm_phase<EpiGateB, ListOrder, true, true>(lds, gB, S, EB); } }
        }
    }
    SEAM(4);
    if (IN(5)) { pg8::Gemm g{(const u16*)(ws + Z_QA), (const u16*)(ws + WS_WA), TT, 1024, 1024}; pg8::StaticOrder S; S.init(TT, 1024, G, bx);
        EpiGateA E{(const u16*)(ws + Z_GATES), (const u16*)(dout + DO_TMPB), (u16*)(ws + Z_MERGED)}; pg8::gemm_phase<EpiGateA, pg8::StaticOrder, true, true>(lds, g, S, E); }
    SEAM(5);
    if (IN(6)) { pg8::Gemm g{(const u16*)(ws + Z_MERGED), (const u16*)(ws + WS_WO), TT, 1024, 1024}; pg8::StaticOrder S; S.init(TT, 1024, G, bx);
        EpiOutNorm E{P.x, P.out, P.fnw, (float*)(ws + WS_BAR + 65536), (unsigned*)(ws + WS_BAR + 16384)}; pg8::gemm_phase<EpiOutNorm, pg8::StaticOrder, false, true>(lds, g, S, E); }
#ifdef HG_PROBE_MODE
    if (bx < 64) hgrn_unit<HG_PROBE_MODE>(lds, bx >> 3, bx & 7, (const u16*)(ws + Z_QA), (const u16*)(ws + Z_G), (const u16*)(ws + Z_VA), (const u16*)(ws + Z_HG), P.hnw, (u16*)(ws + Z_HG), nullptr);
#endif
#ifdef PROBE_K
    STAMP(7);
    if (bx == 0 && tid == 0) { const LAS unsigned long long* ts = (const LAS unsigned long long*)(lds + 163344);
#ifdef PROBE_ACC
        const unsigned long long dt = ts[10], t0
#else
        const unsigned long long dt = ts[PROBE_B] - ts[PROBE_A], t0
#endif
 = __builtin_amdgcn_s_memrealtime();
        while (__builtin_amdgcn_s_memrealtime() - t0 < dt) __builtin_amdgcn_s_sleep(8); }
#endif
#undef IN
#undef SEAM
}

extern "C" void kernel_launch(void* const* d_in, const int* in_sizes, int n_in, void* d_out, int out_size, void* d_ws, size_t ws_size, hipStream_t stream) {
    static int grid = 0;
    if (grid == 0) {
        if (n_in != 10 || in_sizes[0] != TT * DM || out_size != TT * DM || ws_size < WS_END) { fprintf(stderr, "kernel_launch: unexpected shapes (n_in %d, in0 %d, out %d, ws %zu)\n", n_in, n_in > 0 ? in_sizes[0] : -1, out_size, ws_size); grid = -1; return; }
        int dev = 0, cus = 0, per_cu = 0;
        hipGetDevice(&dev); hipDeviceGetAttribute(&cus, hipDeviceAttributeMultiprocessorCount, dev);
        if (hipFuncSetAttribute((const void*)fwd_megakernel, hipFuncAttributeMaxDynamicSharedMemorySize, LDS_BYTES) != hipSuccess) { fprintf(stderr, "kernel_launch: hipFuncSetAttribute failed\n"); grid = -1; return; }
        if (hipOccupancyMaxActiveBlocksPerMultiprocessor(&per_cu, (const void*)fwd_megakernel, 512, LDS_BYTES) != hipSuccess || per_cu < 1) { fprintf(stderr, "kernel_launch: occupancy query says %d\n", per_cu); per_cu = 1; }
        (void)hipGetLastError();
        grid = cus * (per_cu > 1 ? 1 : per_cu);
        if (grid != 256) { fprintf(stderr, "kernel_launch: built for a 256-CU device (one workgroup per CU); got %d\n", grid); grid = -1; return; }
    }
    if (grid < 0) return;
    if (hipMemsetAsync((char*)d_ws + WS_BAR, 0, 36864 + 16384, stream) != hipSuccess) { fprintf(stderr, "kernel_launch: memset of the barrier words failed\n"); return; }
    Args a{};
    for (int i = 0; i < 10; ++i) a.in[i] = (const float*)d_in[i];
    a.out = (float*)d_out; a.ws = (unsigned char*)d_ws; a.ph_lo = 0; a.ph_hi = 7;
    void* args[] = {&a};
    hipError_t e = hipLaunchCooperativeKernel((const void*)fwd_megakernel, dim3(grid), dim3(512), args, LDS_BYTES, stream);
    if (e != hipSuccess) fprintf(stderr, "kernel_launch: cooperative launch failed: %s (grid %d)\n", hipGetErrorString(e), grid);
}
```

```cpp
#include <hip/hip_runtime.h>
#include <hip/hip_cooperative_groups.h>
#include <hip/hip_bf16.h>
#include <cstdio>
#include <cstdint>
#include <cmath>
namespace cg = cooperative_groups;
namespace pg8 {
#define PG8_LAS __attribute__((address_space(3)))
typedef unsigned short bf16_t;
typedef short bf16x8 __attribute__((ext_vector_type(8)));
typedef float f32x4 __attribute__((ext_vector_type(4)));
typedef unsigned u32x4 __attribute__((ext_vector_type(4)));
constexpr int BM = 256, BK = 64, HALF = 128, HTB = HALF * BK * 2  , STAGE_BYTES = 8 * HTB, NXCD = 8, WGM = 8;

__host__ __device__ __forceinline__ int lds_byte(int r, int c) { const int st = (r >> 4) * 2 + (c >> 5), rr = r & 15, cc = c & 31, ob = rr * 64 + cc * 2; return st * 1024 + (ob ^ (((ob >> 9) & 1) << 5)); }
__host__ __device__ __forceinline__ void stage_rc(int b, int& R, int& C) { const int st = b / 1024, sb = b % 1024, swz = sb ^ (((sb >> 9) & 1) << 5); R = (st >> 1) * 16 + swz / 64; C = (st & 1) * 32 + (swz % 64) / 2; }
__host__ __device__ __forceinline__ int perm32(int rho) { const int n = rho >> 4, i = rho & 15; return 8 * (i >> 2) + 4 * n + (i & 3); }

struct Unit { int pm, pn; };
struct Gemm { const bf16_t* A; const bf16_t* Bt; int M, N, K; };

struct StaticOrder {
    int nM, nN, nwg, G, c;
    __host__ __device__ void init(int M, int N, int G_, int c_) { nM = M / BM; nN = N / BM; nwg = nM * nN; G = G_; c = c_; }
    __host__ __device__ bool next(int i, Unit& u) const {
        const long L = (long)i * G + c; if (L >= nwg) return false;
        int wgid = (int)L; { const int q = nwg / NXCD, r = nwg % NXCD, xcd = wgid % NXCD, off = wgid / NXCD; wgid = (xcd < r ? xcd * (q + 1) : r * (q + 1) + (xcd - r) * q) + off; }
        const int nig = WGM * nN, gid = wgid / nig, fm = gid * WGM, gsz = (nM - fm) < WGM ? (nM - fm) : WGM;
        u.pm = fm + ((wgid % nig) % gsz); u.pn = (wgid % nig) / gsz; return true;
    }
    __device__ __forceinline__ void a_ready(const Unit&) const {}
    __device__ __forceinline__ void done(const Unit&) const {}
};

__device__ __forceinline__ unsigned cvt_pk_bf16(float lo, float hi) { unsigned r; asm volatile("v_cvt_pk_bf16_f32 %0, %1, %2" : "=v"(r) : "v"(lo), "v"(hi)); return r; }
typedef float f32x2 __attribute__((ext_vector_type(2)));
template <class Epi, class Sched, bool ALIGN_EPI = false, bool SP2 = false>
__device__ __forceinline__ void gemm_phase(PG8_LAS unsigned char* lds, const Gemm g, const Sched& S, const Epi& E) {
    const int tid = threadIdx.x, wid = __builtin_amdgcn_readfirstlane(tid >> 6), lane = tid & 63, wr = wid >> 2, wc = wid & 3, fr = lane & 15, fq = lane >> 4;
    const int K = g.K, nt = K / BK;
    unsigned voffA[2], voffB[2];
#pragma unroll
    for (int i = 0; i < 2; ++i) { int R, C; stage_rc(tid * 16 + i * 8192, R, C); const int Rb = Epi::PERM ? ((R & ~31) + perm32(R & 31)) : R;
        voffA[i] = (unsigned)(R * K + C) * 2u; voffB[i] = (unsigned)(Rb * K + C) * 2u; }
    const size_t kstep = (size_t)(BK * 2);
    const size_t hstep = (size_t)HALF * K * 2;
    const size_t tstep = 2 * hstep;
    const unsigned ldsw = (unsigned)wid * 1024u;
    const int aoff = lds_byte(wr * 64 + fr, fq * 8), boff = lds_byte(wc * 32 + fr, fq * 8);
#define PG8_SA(b, h) (((b) * 2 + (h)) * HTB)
#define PG8_SB(b, h) ((4 + (b) * 2 + (h)) * HTB)
#define PG8_STAGE(bufoff, gbase, voff) do { _Pragma("unroll") for (int _i = 0; _i < 2; ++_i) \
        __builtin_amdgcn_global_load_lds((const unsigned*)((const char*)(gbase) + (voff)[_i]), (PG8_LAS unsigned*)(lds + (bufoff) + ldsw + _i * 8192), 16, 0, 0); } while (0)
#define PG8_LDA(dst, b, h) do { _Pragma("unroll") for (int m = 0; m < 4; ++m) _Pragma("unroll") for (int k = 0; k < 2; ++k) dst[m][k] = *(const PG8_LAS bf16x8*)(lds + PG8_SA(b, h) + aoff + m * 2048 + k * 1024); } while (0)
#define PG8_LDB(dst, b, h) do { _Pragma("unroll") for (int n = 0; n < 2; ++n) _Pragma("unroll") for (int k = 0; k < 2; ++k) dst[n][k] = *(const PG8_LAS bf16x8*)(lds + PG8_SB(b, h) + boff + n * 2048 + k * 1024); } while (0)
#define PG8_MMA(ai, bj, At, Bt) do { __builtin_amdgcn_s_setprio(1); _Pragma("unroll") for (int m = 0; m < 4; ++m) _Pragma("unroll") for (int n = 0; n < 2; ++n) _Pragma("unroll") for (int k = 0; k < 2; ++k) \
        acc[ai][bj][m][n] = __builtin_amdgcn_mfma_f32_16x16x32_bf16(Bt[n][k], At[m][k], acc[ai][bj][m][n], 0, 0, 0); __builtin_amdgcn_s_setprio(0); } while (0)
#define PG8_WAIT_V(n) asm volatile("s_waitcnt vmcnt(" #n ")" ::: "memory")
#define PG8_WAIT_L(n) asm volatile("s_waitcnt lgkmcnt(" #n ")" ::: "memory")
#define PG8_BAR __builtin_amdgcn_s_barrier()
#define PG8_SCHED __builtin_amdgcn_sched_barrier(0)
    Unit cur, nxt; int ui = 0;
    if (!S.next(0, cur)) return;
    f32x4 acc[2][2][4][2];
#pragma unroll
    for (int a = 0; a < 2; ++a)
#pragma unroll
        for (int b = 0; b < 2; ++b)
#pragma unroll
            for (int m = 0; m < 4; ++m)
#pragma unroll
                for (int n = 0; n < 2; ++n) acc[a][b][m][n] = (f32x4){0.f, 0.f, 0.f, 0.f};
    bf16x8 At[4][2], B0[2][2], B1[2][2];
    const char* cA = (const char*)g.A + (size_t)cur.pm * tstep; const char* cB = (const char*)g.Bt + (size_t)cur.pn * tstep;
    S.a_ready(cur);
    if constexpr (SP2) {
        PG8_STAGE(PG8_SB(0, 0), cB, voffB); PG8_STAGE(PG8_SB(0, 1), cB + hstep, voffB); PG8_STAGE(PG8_SA(0, 0), cA, voffA); PG8_STAGE(PG8_SA(0, 1), cA + hstep, voffA);
        if (wr == 1) PG8_BAR;
        PG8_WAIT_V(2); PG8_BAR;
        PG8_STAGE(PG8_SB(1, 0), cB + kstep, voffB); PG8_STAGE(PG8_SA(1, 0), cA + kstep, voffA); PG8_STAGE(PG8_SB(1, 1), cB + hstep + kstep, voffB);
        PG8_WAIT_V(6); PG8_BAR;
    } else {
        PG8_STAGE(PG8_SB(0, 0), cB, voffB); PG8_STAGE(PG8_SA(0, 0), cA, voffA); PG8_STAGE(PG8_SB(0, 1), cB + hstep, voffB); PG8_STAGE(PG8_SA(0, 1), cA + hstep, voffA);
        if (wr == 1) PG8_BAR;
        PG8_WAIT_V(4); PG8_BAR;
        PG8_STAGE(PG8_SB(1, 0), cB + kstep, voffB); PG8_STAGE(PG8_SA(1, 0), cA + kstep, voffA); PG8_STAGE(PG8_SB(1, 1), cB + hstep + kstep, voffB);
        PG8_WAIT_V(6); PG8_BAR;
    }
    for (;;) {
        const bool has_next = S.next(ui + 1, nxt);
        const char* nA = has_next ? (const char*)g.A + (size_t)nxt.pm * tstep : cA; const char* nB = has_next ? (const char*)g.Bt + (size_t)nxt.pn * tstep : cB;
        for (int t = 0; t < nt; t += 2) {
            const bool last = (t == nt - 2);
            const char* a1 = cA + (size_t)(t + 1) * kstep;
            const char* a2 = last ? nA : cA + (size_t)(t + 2) * kstep; const char* b2 = last ? nB : cB + (size_t)(t + 2) * kstep;
            const char* a3 = a2 + kstep; const char* b3 = b2 + kstep;
            if (last && has_next) S.a_ready(nxt);
            if constexpr (SP2) {
            PG8_LDB(B0, 0, 0); PG8_LDB(B1, 0, 1); PG8_SCHED; PG8_LDA(At, 0, 0); PG8_STAGE(PG8_SA(1, 1), a1 + hstep, voffA);
            PG8_WAIT_V(8); PG8_WAIT_L(0); PG8_BAR; PG8_MMA(0, 0, At, B0); PG8_MMA(0, 1, At, B1); PG8_BAR; PG8_SCHED;
            PG8_LDA(At, 0, 1); PG8_STAGE(PG8_SB(0, 0), b2, voffB); PG8_STAGE(PG8_SB(0, 1), b2 + hstep, voffB); PG8_STAGE(PG8_SA(0, 0), a2, voffA);
            PG8_WAIT_V(8); PG8_WAIT_L(0); PG8_BAR; PG8_MMA(1, 0, At, B0); PG8_MMA(1, 1, At, B1); PG8_BAR; PG8_SCHED;
            PG8_LDB(B0, 1, 0); PG8_LDB(B1, 1, 1); PG8_SCHED; PG8_LDA(At, 1, 0); PG8_STAGE(PG8_SA(0, 1), a2 + hstep, voffA);
            PG8_WAIT_V(8); PG8_WAIT_L(0); PG8_BAR; PG8_MMA(0, 0, At, B0); PG8_MMA(0, 1, At, B1); PG8_BAR; PG8_SCHED;
            PG8_LDA(At, 1, 1); PG8_STAGE(PG8_SB(1, 0), b3, voffB); PG8_STAGE(PG8_SB(1, 1), b3 + hstep, voffB); PG8_STAGE(PG8_SA(1, 0), a3, voffA);
            PG8_WAIT_V(8); PG8_WAIT_L(0); PG8_BAR; PG8_MMA(1, 0, At, B0); PG8_MMA(1, 1, At, B1); PG8_BAR; PG8_SCHED;
            } else {
            PG8_LDB(B0, 0, 0); PG8_SCHED; PG8_LDA(At, 0, 0); PG8_STAGE(PG8_SA(1, 1), a1 + hstep, voffA);
            PG8_WAIT_L(8); PG8_BAR; PG8_WAIT_L(0); PG8_MMA(0, 0, At, B0); PG8_BAR; PG8_SCHED;
            PG8_LDB(B1, 0, 1); PG8_STAGE(PG8_SB(0, 0), b2, voffB);
            PG8_BAR; PG8_WAIT_L(0); PG8_MMA(0, 1, At, B1); PG8_BAR;
            PG8_LDA(At, 0, 1); PG8_STAGE(PG8_SA(0, 0), a2, voffA);
            PG8_BAR; PG8_WAIT_L(0); PG8_MMA(1, 0, At, B0); PG8_BAR; PG8_SCHED;
            PG8_STAGE(PG8_SB(0, 1), b2 + hstep, voffB);
            PG8_WAIT_V(6); PG8_BAR; PG8_MMA(1, 1, At, B1); PG8_BAR;
            PG8_LDB(B0, 1, 0); PG8_SCHED; PG8_LDA(At, 1, 0); PG8_STAGE(PG8_SA(0, 1), a2 + hstep, voffA);
            PG8_WAIT_L(8); PG8_BAR; PG8_WAIT_L(0); PG8_MMA(0, 0, At, B0); PG8_BAR; PG8_SCHED;
            PG8_LDB(B1, 1, 1); PG8_STAGE(PG8_SB(1, 0), b3, voffB);
            PG8_BAR; PG8_WAIT_L(0); PG8_MMA(0, 1, At, B1); PG8_BAR;
            PG8_LDA(At, 1, 1); PG8_STAGE(PG8_SA(1, 0), a3, voffA);
            PG8_BAR; PG8_WAIT_L(0); PG8_MMA(1, 0, At, B0); PG8_BAR; PG8_SCHED;
            PG8_STAGE(PG8_SB(1, 1), b3 + hstep, voffB);
            PG8_WAIT_V(6); PG8_BAR; PG8_MMA(1, 1, At, B1); PG8_BAR;
            }
        }
        if constexpr (ALIGN_EPI) { if (wr == 0) PG8_BAR; }
        if constexpr (!Epi::AFTER_DRAIN) { E(acc, cur, wr, wc, fr, fq); S.done(cur); }
        if (!has_next) break;
#pragma unroll
        for (int a = 0; a < 2; ++a)
#pragma unroll
            for (int b = 0; b < 2; ++b)
#pragma unroll
                for (int m = 0; m < 4; ++m)
#pragma unroll
                    for (int n = 0; n < 2; ++n) acc[a][b][m][n] = (f32x4){0.f, 0.f, 0.f, 0.f};
        cur = nxt; cA = nA; cB = nB; ++ui;
        if constexpr (ALIGN_EPI) { if (wr == 1) PG8_BAR; }
    }
    PG8_WAIT_V(0);
    if constexpr (!ALIGN_EPI) { if (wr == 0) PG8_BAR; }
    PG8_BAR;
    if constexpr (Epi::AFTER_DRAIN) { E.fused(acc, cur, wr, wc, fr, fq, lds, wid, lane); S.done(cur); }
#undef PG8_SA
#undef PG8_SB
#undef PG8_STAGE
#undef PG8_LDA
#undef PG8_LDB
#undef PG8_MMA
#undef PG8_WAIT_V
#undef PG8_WAIT_L
#undef PG8_BAR
#undef PG8_SCHED
}
}

#define LAS __attribute__((address_space(3)))
typedef unsigned short u16;
typedef short bf16x8 __attribute__((ext_vector_type(8)));
typedef short s16x4 __attribute__((ext_vector_type(4)));
typedef float f32x4 __attribute__((ext_vector_type(4)));
typedef float f32x2 __attribute__((ext_vector_type(2)));
typedef unsigned u32x4 __attribute__((ext_vector_type(4)));
typedef unsigned u32x2 __attribute__((ext_vector_type(2)));

constexpr int TT = 16384, DM = 1024, SEQ = 2048, NIN = 11264;
constexpr int ZBP = 4608;
constexpr size_t MiB = 1u << 20;
constexpr size_t WS_WT = 0;
constexpr size_t WS_WA = 22 * MiB, WS_WB = 24 * MiB, WS_WO = 25 * MiB;
constexpr size_t WS_COS = 27 * MiB, WS_SIN = 29 * MiB;
constexpr size_t WS_BAR = 31 * MiB;
constexpr size_t WS_H = 32 * MiB;
constexpr size_t WS_Z = 64 * MiB;
constexpr size_t Z_QA = WS_Z, Z_G = WS_Z + 32 * MiB, Z_VA = WS_Z + 64 * MiB, Z_HG = WS_Z + 96 * MiB, Z_GATES = WS_Z + 128 * MiB;
constexpr size_t Z_MERGED = WS_Z + 64 * MiB;
constexpr size_t WS_END = 256 * MiB;
constexpr size_t DO_OG = 0, DO_AG = 48 * MiB, DO_TMPB = 16 * MiB;
constexpr int LDS_BYTES = 163840;
constexpr float NORM_EPS = 1e-6f;

__device__ __forceinline__ unsigned pk_bf16(float lo, float hi) { typedef __bf16 b2 __attribute__((ext_vector_type(2))); f32x2 v = {lo, hi}; b2 b = __builtin_convertvector(v, b2); return __builtin_bit_cast(unsigned, b); }
__device__ __forceinline__ unsigned pk_f16(float lo, float hi) { typedef _Float16 h2 __attribute__((ext_vector_type(2))); h2 h = {(_Float16)lo, (_Float16)hi}; return __builtin_bit_cast(unsigned, h); }
__device__ __forceinline__ float bflo(unsigned u) { return __uint_as_float(u << 16); }
__device__ __forceinline__ float bfhi(unsigned u) { return __uint_as_float(u & 0xffff0000u); }
__device__ __forceinline__ float f16lo(unsigned u) { return (float)__builtin_bit_cast(_Float16, (unsigned short)(u & 0xffffu)); }
__device__ __forceinline__ float f16hi(unsigned u) { return (float)__builtin_bit_cast(_Float16, (unsigned short)(u >> 16)); }
__device__ __forceinline__ float sigm(float x) { return __builtin_amdgcn_rcpf(1.0f + __expf(-x)); }
__device__ __forceinline__ s16x4 ds_tr(const LAS u16* p) { typedef short v4 __attribute__((ext_vector_type(4))); return __builtin_bit_cast(s16x4, __builtin_amdgcn_ds_read_tr16_b64_v4i16((LAS v4*)p)); }
__device__ __forceinline__ bf16x8 cat8(s16x4 lo, s16x4 hi) { return (bf16x8){lo[0], lo[1], lo[2], lo[3], hi[0], hi[1], hi[2], hi[3]}; }
__device__ __forceinline__ f32x4 mfma16(bf16x8 a, bf16x8 b, f32x4 c) { return __builtin_amdgcn_mfma_f32_16x16x32_bf16(a, b, c, 0, 0, 0); }
__device__ __forceinline__ void store16_wt(void* p, u32x4 v) { asm volatile("global_store_dwordx4 %0, %1, off sc1\n\ts_nop 1" :: "v"(p), "v"(v) : "memory"); }
template <bool WT> __device__ __forceinline__ void store16(void* p, u32x4 v) { if (WT) store16_wt(p, v); else *(u32x4*)p = v; }
__device__ __forceinline__ float wave_sum(float v) {
#pragma unroll
    for (int o = 1; o < 64; o <<= 1) v += __shfl_xor(v, o);
    return v;
}

using pg8::Unit;
template <int ACT  > __device__ __forceinline__ float act1(float v) { if (ACT == 1) return v * sigm(v); if (ACT == 2) return sigm(v); return v; }
template <int ACT, bool WT = false> __device__ __forceinline__ void epi_store16(const f32x4 (&acc)[2][2][4][2], u16* base, int pitch, int row0, int col0) {
#pragma unroll
    for (int ai = 0; ai < 2; ++ai)
#pragma unroll
        for (int m = 0; m < 4; ++m) { u16* rowp = base + (size_t)(row0 + ai * 128 + m * 16) * pitch + col0;
#pragma unroll
            for (int bj = 0; bj < 2; ++bj) { const f32x4 v0 = acc[ai][bj][m][0], v1 = acc[ai][bj][m][1]; u32x4 w;
                w.x = pk_bf16(act1<ACT>(v0[0]), act1<ACT>(v0[1])); w.y = pk_bf16(act1<ACT>(v0[2]), act1<ACT>(v0[3]));
                w.z = pk_bf16(act1<ACT>(v1[0]), act1<ACT>(v1[1])); w.w = pk_bf16(act1<ACT>(v1[2]), act1<ACT>(v1[3]));
                store16<WT>(rowp + bj * 128, w); } }
}
__device__ __forceinline__ size_t frag_off(size_t tile, int ai, int m, int bj, int tidx) { return (((tile * 16 + (size_t)((ai * 4 + m) * 2 + bj)) * 512) + (size_t)tidx) * 8; }
template <int ACT, bool WT> __device__ __forceinline__ void epi_store_frag(const f32x4 (&acc)[2][2][4][2], u16* base, size_t tile, int tidx) {
#pragma unroll
    for (int ai = 0; ai < 2; ++ai)
#pragma unroll
        for (int m = 0; m < 4; ++m)
#pragma unroll
            for (int bj = 0; bj < 2; ++bj) { const f32x4 v0 = acc[ai][bj][m][0], v1 = acc[ai][bj][m][1]; u32x4 w;
                w.x = pk_bf16(act1<ACT>(v0[0]), act1<ACT>(v0[1])); w.y = pk_bf16(act1<ACT>(v0[2]), act1<ACT>(v0[3]));
                w.z = pk_bf16(act1<ACT>(v1[0]), act1<ACT>(v1[1])); w.w = pk_bf16(act1<ACT>(v1[2]), act1<ACT>(v1[3]));
                store16<WT>(base + frag_off(tile, ai, m, bj, tidx), w); }
}
template <int ACT, bool WT> __device__ __forceinline__ void epi_store16_hm(const f32x4 (&acc)[2][2][4][2], u16* base, int pnl, int row0, int lc) {
#pragma unroll
    for (int ai = 0; ai < 2; ++ai)
#pragma unroll
        for (int m = 0; m < 4; ++m) { const int row = row0 + ai * 128 + m * 16, b = row >> 11, t = row & 2047;
#pragma unroll
            for (int bj = 0; bj < 2; ++bj) { const f32x4 v0 = acc[ai][bj][m][0], v1 = acc[ai][bj][m][1]; u32x4 w;
                w.x = pk_bf16(act1<ACT>(v0[0]), act1<ACT>(v0[1])); w.y = pk_bf16(act1<ACT>(v0[2]), act1<ACT>(v0[3]));
                w.z = pk_bf16(act1<ACT>(v1[0]), act1<ACT>(v1[1])); w.w = pk_bf16(act1<ACT>(v1[2]), act1<ACT>(v1[3]));
                store16<WT>(base + ((size_t)(b * 8 + 2 * pnl + bj) * 2048 + t) * 128 + lc, w); } }
}
template <bool WT> struct EpiZT {
    static constexpr bool PERM = true, AFTER_DRAIN = false;
    int mode;
    unsigned char* ws; unsigned char* dout; const float* lbl;
    __device__ __forceinline__ void operator()(const f32x4 (&acc)[2][2][4][2], const Unit& u, int wr, int wc, int fr, int fq) const {
        const int pn = u.pn, row0 = u.pm * 256 + wr * 64 + fr, lc = wc * 32 + 8 * fq;
        if (mode == 2) { epi_store_frag<2, WT>(acc, (u16*)(ws + Z_GATES), (size_t)u.pm * 8 + pn, (wr * 4 + wc) * 64 + fq * 16 + fr); return; }
        if (mode == 0) {
            u16* ZB = (u16*)(ws + WS_Z);
            if (pn < 12) {
                const float sc = (pn < 6) ? 0.125f * 1.4426950408889634f : 1.0f;
                const float* cosT = (const float*)(ws + WS_COS); const float* sinT = (const float*)(ws + WS_SIN);
                const int jb = 16 * (wc & 1) + 4 * fq;
#pragma unroll
                for (int ai = 0; ai < 2; ++ai) { f32x4 cc[4], ss[4];
#pragma unroll
                    for (int m = 0; m < 4; ++m) { const int row = row0 + ai * 128 + m * 16; cc[m] = *(const f32x4*)(cosT + (size_t)row * 32 + jb); ss[m] = *(const f32x4*)(sinT + (size_t)row * 32 + jb); }
#pragma unroll
                    for (int m = 0; m < 4; ++m) { const int row = row0 + ai * 128 + m * 16; const f32x4 c = cc[m], s = ss[m];
                        u16* rowp = ZB + ((size_t)(pn * 4 + (wc >> 1)) * TT + row) * 64 + (lc & 63);
#pragma unroll
                        for (int bj = 0; bj < 2; ++bj) { const f32x4 v0 = acc[ai][bj][m][0], v1 = acc[ai][bj][m][1]; u32x4 w;
                            w.x = pk_bf16((v0[0] * c[0] - v0[1] * s[0]) * sc, (v0[1] * c[0] + v0[0] * s[0]) * sc);
                            w.y = pk_bf16((v0[2] * c[1] - v0[3] * s[1]) * sc, (v0[3] * c[1] + v0[2] * s[1]) * sc);
                            w.z = pk_bf16((v1[0] * c[2] - v1[1] * s[2]) * sc, (v1[1] * c[2] + v1[0] * s[2]) * sc);
                            w.w = pk_bf16((v1[2] * c[3] - v1[3] * s[3]) * sc, (v1[3] * c[3] + v1[2] * s[3]) * sc);
                            *(u32x4*)(rowp + (size_t)bj * 2 * TT * 64) = w; } } }
            } else if (pn < 18) {
#pragma unroll
                for (int ai = 0; ai < 2; ++ai)
#pragma unroll
                    for (int m = 0; m < 4; ++m) { u16* rowp = ZB + ((size_t)(pn * 4 + (wc >> 1)) * TT + (row0 + ai * 128 + m * 16)) * 64 + (lc & 63);
#pragma unroll
                        for (int bj = 0; bj < 2; ++bj) { const f32x4 v0 = acc[ai][bj][m][0], v1 = acc[ai][bj][m][1]; u32x4 w;
                            w.x = pk_bf16(v0[0], v0[1]); w.y = pk_bf16(v0[2], v0[3]); w.z = pk_bf16(v1[0], v1[1]); w.w = pk_bf16(v1[2], v1[3]);
                            *(u32x4*)(rowp + (size_t)bj * 2 * TT * 64) = w; } }
            }
            else epi_store16<1>(acc, (u16*)(dout + DO_AG), 512, row0, (pn - 18) * 256 + lc);
        } else {
            if (pn < 4) epi_store16<1, WT>(acc, (u16*)(ws + Z_QA), 1024, row0, pn * 256 + lc);
            else if (pn < 8) {
                const int cb = (pn - 4) * 256 + lc; float lb[2][8];
#pragma unroll
                for (int bj = 0; bj < 2; ++bj)
#pragma unroll
                    for (int e = 0; e < 8; ++e) { const int idx = cb + bj * 128 + e; lb[bj][e] = 1.0f / (1.0f + __expf(lbl[1024 + idx] - lbl[idx])); }
                u16* G = (u16*)(ws + Z_G);
#pragma unroll
                for (int ai = 0; ai < 2; ++ai)
#pragma unroll
                    for (int m = 0; m < 4; ++m) { const int row = row0 + ai * 128 + m * 16; u16* rowp = G + ((size_t)((row >> 11) * 8 + 2 * (pn - 4)) * 2048 + (row & 2047)) * 128 + lc;
#pragma unroll
                        for (int bj = 0; bj < 2; ++bj) { const f32x4 v0 = acc[ai][bj][m][0], v1 = acc[ai][bj][m][1]; float g[8];
#pragma unroll
                            for (int e = 0; e < 8; ++e) { const float v = e < 4 ? v0[e & 3] : v1[e & 3]; g[e] = lb[bj][e] + (1.0f - lb[bj][e]) * sigm(v); }
                            u32x4 w; w.x = pk_f16(g[0], g[1]); w.y = pk_f16(g[2], g[3]); w.z = pk_f16(g[4], g[5]); w.w = pk_f16(g[6], g[7]);
                            store16<WT>(rowp + (size_t)bj * 2048 * 128, w); } }
            } else if (pn < 12) epi_store16_hm<0, WT>(acc, (u16*)(ws + Z_VA), pn - 8, row0, lc);
            else if (pn < 16) epi_store16_hm<1, WT>(acc, (u16*)(ws + Z_HG), pn - 12, row0, lc);
            else epi_store16<2>(acc, (u16*)(ws + Z_GATES), 2048, row0, (pn - 16) * 256 + lc);
        }
    }
};
typedef EpiZT<false> EpiZ;
struct EpiGateB {
    static constexpr bool PERM = true, AFTER_DRAIN = false;
    const u16* gates; u16* tmpb;
    __device__ __forceinline__ void operator()(const f32x4 (&acc)[2][2][4][2], const Unit& u, int wr, int wc, int fr, int fq) const {
        const int row0 = u.pm * 256 + wr * 64 + fr, col0 = u.pn * 256 + wc * 32 + 8 * fq, tidx = (wr * 4 + wc) * 64 + fq * 16 + fr;
#pragma unroll
        for (int ai = 0; ai < 2; ++ai) { u32x4 gg[4][2];
#pragma unroll
            for (int m = 0; m < 4; ++m)
#pragma unroll
                for (int bj = 0; bj < 2; ++bj) gg[m][bj] = *(const u32x4*)(gates + frag_off((size_t)u.pm * 8 + 4 + u.pn, ai, m, bj, tidx));
#pragma unroll
            for (int m = 0; m < 4; ++m) { const size_t row = row0 + ai * 128 + m * 16;
#pragma unroll
                for (int bj = 0; bj < 2; ++bj) { const int col = col0 + bj * 128; const u32x4 g = gg[m][bj];
                    const f32x4 v0 = acc[ai][bj][m][0], v1 = acc[ai][bj][m][1]; u32x4 w;
                    w.x = pk_bf16(v0[0] * bflo(g.x), v0[1] * bfhi(g.x)); w.y = pk_bf16(v0[2] * bflo(g.y), v0[3] * bfhi(g.y));
                    w.z = pk_bf16(v1[0] * bflo(g.z), v1[1] * bfhi(g.z)); w.w = pk_bf16(v1[2] * bflo(g.w), v1[3] * bfhi(g.w));
                    *(u32x4*)(tmpb + frag_off((size_t)u.pm * 4 + u.pn, ai, m, bj, tidx)) = w; } } }
    }
};
struct EpiGateA {
    static constexpr bool PERM = true, AFTER_DRAIN = false;
    const u16* gates; const u16* tmpb; u16* merged;
    __device__ __forceinline__ void operator()(const f32x4 (&acc)[2][2][4][2], const Unit& u, int wr, int wc, int fr, int fq) const {
        const int row0 = u.pm * 256 + wr * 64 + fr, col0 = u.pn * 256 + wc * 32 + 8 * fq, tidx = (wr * 4 + wc) * 64 + fq * 16 + fr;
#pragma unroll
        for (int ai = 0; ai < 2; ++ai) { u32x4 gg[4][2], tb[4][2];
#pragma unroll
            for (int m = 0; m < 4; ++m)
#pragma unroll
                for (int bj = 0; bj < 2; ++bj) { const size_t row = row0 + ai * 128 + m * 16; gg[m][bj] = *(const u32x4*)(gates + frag_off((size_t)u.pm * 8 + u.pn, ai, m, bj, tidx)); tb[m][bj] = *(const u32x4*)(tmpb + frag_off((size_t)u.pm * 4 + u.pn, ai, m, bj, tidx)); }
#pragma unroll
            for (int m = 0; m < 4; ++m) { const size_t row = row0 + ai * 128 + m * 16;
#pragma unroll
                for (int bj = 0; bj < 2; ++bj) { const int col = col0 + bj * 128; const u32x4 g = gg[m][bj], t = tb[m][bj];
                    const f32x4 v0 = acc[ai][bj][m][0], v1 = acc[ai][bj][m][1]; u32x4 w;
                    w.x = pk_bf16(bflo(t.x) + v0[0] * bflo(g.x), bfhi(t.x) + v0[1] * bfhi(g.x)); w.y = pk_bf16(bflo(t.y) + v0[2] * bflo(g.y), bfhi(t.y) + v0[3] * bfhi(g.y));
                    w.z = pk_bf16(bflo(t.z) + v1[0] * bflo(g.z), bfhi(t.z) + v1[1] * bfhi(g.z)); w.w = pk_bf16(bflo(t.w) + v1[2] * bflo(g.w), bfhi(t.w) + v1[3] * bfhi(g.w));
                    *(u32x4*)(merged + row * 1024 + col) = w; } } }
    }
};
struct ListOrder { int pm0; unsigned list;
    __device__ __forceinline__ bool next(int i, Unit& u) const { const unsigned c = (i < 4) ? ((list >> (8 * i)) & 0xffu) : 0xffu; if (c == 0xffu) return false; u.pm = pm0 + (int)(c & 7u); u.pn = (int)(c >> 3); return true; }
    __device__ __forceinline__ void a_ready(const Unit&) const {} __device__ __forceinline__ void done(const Unit&) const {} };
struct DefOrder { pg8::StaticOrder base;
    __device__ __forceinline__ bool next(int i, Unit& u) const { if (!base.next(i, u)) return false; u.pm = (u.pm / 6) * 8 + (u.pm % 6); return true; }
    __device__ __forceinline__ void a_ready(const Unit&) const {} __device__ __forceinline__ void done(const Unit&) const {} };
__device__ __forceinline__ unsigned lo_code(int idx, int base) { return (unsigned)(((base + (idx >> 3)) << 3) | (idx & 7)); }
struct EpiOutNorm {
    static constexpr bool PERM = true, AFTER_DRAIN = true;
    const float* x; float* out; const float* fnw; float* xbuf; unsigned* cnt;
    __device__ __forceinline__ void operator()(const f32x4 (&)[2][2][4][2], const Unit&, int, int, int, int) const {}
    __device__ __forceinline__ void fused(f32x4 (&acc)[2][2][4][2], const Unit& u, int wr, int wc, int fr, int fq, PG8_LAS unsigned char* lds, int wid, int lane) const {
        const int row0 = u.pm * 256 + wr * 64 + fr, col0 = u.pn * 256 + wc * 32 + 8 * fq;
        LAS float* PS = (LAS float*)lds;
        LAS float* RS = (LAS float*)(lds + 4096);
#pragma unroll
        for (int ai = 0; ai < 2; ++ai)
#pragma unroll
            for (int mh = 0; mh < 2; ++mh) { f32x4 xv[2][2][2];
#pragma unroll
                for (int mm = 0; mm < 2; ++mm)
#pragma unroll
                    for (int bj = 0; bj < 2; ++bj) { const size_t o = (size_t)(row0 + ai * 128 + (2 * mh + mm) * 16) * 1024 + col0 + bj * 128; xv[mm][bj][0] = *(const f32x4*)(x + o); xv[mm][bj][1] = *(const f32x4*)(x + o + 4); }
#pragma unroll
                for (int mm = 0; mm < 2; ++mm) { const int m = 2 * mh + mm; float sq = 0.f;
#pragma unroll
                    for (int bj = 0; bj < 2; ++bj)
#pragma unroll
                        for (int n = 0; n < 2; ++n) { const f32x4 v = acc[ai][bj][m][n] + xv[mm][bj][n]; acc[ai][bj][m][n] = v; sq += (v[0] * v[0] + v[1] * v[1]) + (v[2] * v[2] + v[3] * v[3]); }
                    sq += __shfl_xor(sq, 16); sq += __shfl_xor(sq, 32);
                    if (fq == 0) PS[(ai * 128 + wr * 64 + m * 16 + fr) * 4 + wc] = sq; } }
        asm volatile("s_waitcnt lgkmcnt(0)" ::: "memory"); __builtin_amdgcn_s_barrier(); asm volatile("" ::: "memory");
        const int tid = wid * 64 + lane;
        if (tid < 256) { const f32x4 p = *(const LAS f32x4*)(PS + tid * 4);
            __hip_atomic_store(xbuf + (size_t)(u.pm * 256 + tid) * 4 + u.pn, (p[0] + p[1]) + (p[2] + p[3]), __ATOMIC_RELAXED, __HIP_MEMORY_SCOPE_AGENT); }
        asm volatile("s_waitcnt vmcnt(0)" ::: "memory"); __builtin_amdgcn_s_barrier(); asm volatile("" ::: "memory");
        if (tid == 0) {
            __hip_atomic_fetch_add(cnt + 64 * u.pm, 1u, __ATOMIC_RELAXED, __HIP_MEMORY_SCOPE_AGENT);
            unsigned sp = 0u; while (__hip_atomic_load(cnt + 64 * u.pm, __ATOMIC_RELAXED, __HIP_MEMORY_SCOPE_AGENT) < 4u) { __builtin_amdgcn_s_sleep(2); if (++sp > (1u << 22)) break; }
            __builtin_amdgcn_fence(__ATOMIC_ACQUIRE, "agent"); asm volatile("s_waitcnt vmcnt(0)" ::: "memory"); }
        __builtin_amdgcn_s_barrier(); asm volatile("" ::: "memory");
        if (tid < 256) { const float* sl = xbuf + (size_t)(u.pm * 256 + tid) * 4; float t = 0.f;
#pragma unroll
            for (int k = 0; k < 4; ++k) t += __hip_atomic_load(sl + k, __ATOMIC_RELAXED, __HIP_MEMORY_SCOPE_AGENT);
            RS[tid] = rsqrtf(t * (1.0f / 1024.0f) + NORM_EPS); }
        asm volatile("s_waitcnt vmcnt(0) lgkmcnt(0)" ::: "memory"); __builtin_amdgcn_s_barrier(); asm volatile("" ::: "memory");
        f32x4 wv[2][2];
#pragma unroll
        for (int bj = 0; bj < 2; ++bj) { wv[bj][0] = *(const f32x4*)(fnw + col0 + bj * 128); wv[bj][1] = *(const f32x4*)(fnw + col0 + bj * 128 + 4); }
#pragma unroll
        for (int ai = 0; ai < 2; ++ai)
#pragma unroll
            for (int m = 0; m < 4; ++m) { const int rl = ai * 128 + wr * 64 + m * 16 + fr; const float rs = RS[rl]; const size_t o = (size_t)(u.pm * 256 + rl) * 1024 + col0;
#pragma unroll
                for (int bj = 0; bj < 2; ++bj) { *(f32x4*)(out + o + bj * 128) = acc[ai][bj][m][0] * rs * wv[bj][0]; *(f32x4*)(out + o + bj * 128 + 4) = acc[ai][bj][m][1] * rs * wv[bj][1]; } }
    }
};

__device__ __forceinline__ int wt_row_of_col(int n) {
    if (n < 4096) return n;
    if (n >= 9216) return 4096 + (n - 9216);
    int a = n - 4096;
    if (a < 3072) { const int e = a & 63; a = (a - e) + (e < 32 ? 2 * e : 2 * (e - 32) + 1); }
    return 6144 + a;
}
template <bool MAP> __device__ __forceinline__ void p0_transpose_item(const float* W, int K, int N, u16* WT, LAS float* scr, int item, int lane) {
    const int nblk = N / 32, kb = item / nblk, nb = item % nblk, k0 = 64 * kb, n0 = 32 * nb;
    float tv[32];
#pragma unroll
    for (int i = 0; i < 32; ++i) tv[i] = W[(size_t)(k0 + 2 * i + (lane >> 5)) * N + n0 + (lane & 31)];
#pragma unroll
    for (int i = 0; i < 32; ++i) scr[(2 * i + (lane >> 5)) * 33 + (lane & 31)] = tv[i];
    asm volatile("s_waitcnt lgkmcnt(0)" ::: "memory");
    const int c = lane & 7;
#pragma unroll
    for (int j = 0; j < 4; ++j) { const int n = (lane >> 3) + 8 * j; const LAS float* s = scr + (8 * c) * 33 + n;
        u32x4 o; o.x = pk_bf16(s[0 * 33], s[1 * 33]); o.y = pk_bf16(s[2 * 33], s[3 * 33]); o.z = pk_bf16(s[4 * 33], s[5 * 33]); o.w = pk_bf16(s[6 * 33], s[7 * 33]);
        const int r = MAP ? wt_row_of_col(n0 + n) : (n0 + n);
        *(u32x4*)(WT + (size_t)r * K + k0 + 8 * c) = o; }
    asm volatile("s_waitcnt lgkmcnt(0)" ::: "memory");
}
struct Ptrs { const float* x; const int* pos; const float* norm_w; const float* w_in; const float* lbl; const float* hnw; const float* wa; const float* wb; const float* wo; const float* fnw; float* out; unsigned char* ws; };

__device__ __forceinline__ void p0_prologue(const Ptrs& P, LAS unsigned char* lds, int vcu, int G) {
    const int tid = threadIdx.x, lane = tid & 63, wave = __builtin_amdgcn_readfirstlane(tid >> 6);
    LAS float* scr = (LAS float*)(lds + wave * 16384);
    const int gw = vcu * 8 + wave, NGW = G * 8;
    constexpr int I_IN = 16 * (NIN / 32), I_A = 16 * 32, I_B = 8 * 32, I_O = 16 * 32, NITEMS = I_IN + I_A + I_B + I_O;
    for (int it = gw; it < NITEMS; it += NGW) {
        int r = it;
        if (r < I_IN) { p0_transpose_item<true>(P.w_in, 1024, NIN, (u16*)(P.ws + WS_WT), scr, r, lane); continue; } r -= I_IN;
        if (r < I_A) { p0_transpose_item<false>(P.wa, 1024, 1024, (u16*)(P.ws + WS_WA), scr, r, lane); continue; } r -= I_A;
        if (r < I_B) { p0_transpose_item<false>(P.wb, 512, 1024, (u16*)(P.ws + WS_WB), scr, r, lane); continue; } r -= I_B;
        p0_transpose_item<false>(P.wo, 1024, 1024, (u16*)(P.ws + WS_WO), scr, r, lane);
    }
    u16* H = (u16*)(P.ws + WS_H);
    for (int m = gw; m < TT; m += 2 * NGW) {
        const int m2 = (m + NGW < TT) ? m + NGW : m;
        const f32x4* xr = (const f32x4*)(P.x + (size_t)m * DM) + lane; const f32x4* xr2 = (const f32x4*)(P.x + (size_t)m2 * DM) + lane; f32x4 v[4], v2[4]; float s = 0.f, s2 = 0.f;
#pragma unroll
        for (int j = 0; j < 4; ++j) { v[j] = xr[64 * j]; v2[j] = xr2[64 * j]; }
#pragma unroll
        for (int j = 0; j < 4; ++j) { s += (v[j].x * v[j].x + v[j].y * v[j].y) + (v[j].z * v[j].z + v[j].w * v[j].w); s2 += (v2[j].x * v2[j].x + v2[j].y * v2[j].y) + (v2[j].z * v2[j].z + v2[j].w * v2[j].w); }
        const float rstd = rsqrtf(wave_sum(s) * (1.0f / DM) + NORM_EPS), rstd2 = rsqrtf(wave_sum(s2) * (1.0f / DM) + NORM_EPS);
        u32x2* o8 = (u32x2*)(H + (size_t)m * DM) + lane; u32x2* o82 = (u32x2*)(H + (size_t)m2 * DM) + lane;
#pragma unroll
        for (int j = 0; j < 4; ++j) { const f32x4 w4 = ((const f32x4*)P.norm_w)[lane + 64 * j];
            o8[64 * j] = (u32x2){pk_bf16(v[j].x * rstd * w4.x, v[j].y * rstd * w4.y), pk_bf16(v[j].z * rstd * w4.z, v[j].w * rstd * w4.w)};
            o82[64 * j] = (u32x2){pk_bf16(v2[j].x * rstd2 * w4.x, v2[j].y * rstd2 * w4.y), pk_bf16(v2[j].z * rstd2 * w4.z, v2[j].w * rstd2 * w4.w)}; }
    }
    float* cosT = (float*)(P.ws + WS_COS); float* sinT = (float*)(P.ws + WS_SIN);
    for (int e = (vcu * 512 + tid); e < TT * 32; e += G * 512) {
        const int row = e >> 5, j = e & 31;
        const float inv = exp2f(-(float)j * (13.287712379549449f / 32.0f));
        const float ang = (float)P.pos[row] * inv;
        const double rev = (double)ang * 0.15915494309189535; const float fr = (float)(rev - __builtin_rint(rev));
        cosT[e] = __builtin_amdgcn_cosf(fr); sinT[e] = __builtin_amdgcn_sinf(fr);
    }
}

#define LBAR() asm volatile("s_waitcnt lgkmcnt(0)\n\ts_barrier" ::: "memory")
__device__ __forceinline__ void attn_phase(LAS unsigned char* lds, const u16* ZB, u16* OG, float* LSE, int bid, int G) {
    const int tid = threadIdx.x, lane = tid & 63, w = __builtin_amdgcn_readfirstlane(tid >> 6), l15 = lane & 15, q4 = lane >> 4, sb = w >> 2, wq = w & 3;
    constexpr int KP = 72;
    LAS u16* KI = (LAS u16*)lds; LAS u16* VI = (LAS u16*)(lds + 384 * KP * 2);
    u32x4 kr[6], vr[6]; bf16x8 qn[2][2];
#define AT_DEC(un_) const int b_ = (un_) / 192, rem_ = (un_) % 192, g_ = rem_ >> 6, h_ = (rem_ >> 3) & 7, su_ = rem_ & 7; \
        const int d_ = (g_ == 0) ? 1 : (g_ == 1 ? 4 : 16); const size_t tb_ = (size_t)b_ * SEQ; \
        const int r0_ = (g_ == 0) ? 0 : (g_ == 1 ? (su_ >> 1) : 2 * su_), c0_ = (g_ == 0) ? 2 * su_ : (g_ == 1 ? 2 * (su_ & 1) : 0); \
        const int rq_ = (g_ == 2) ? r0_ + sb : r0_, cq_ = (g_ == 2) ? 0 : c0_ + sb;
#define AT_LOAD(un_) do { AT_DEC(un_) \
        _Pragma("unroll") for (int i = 0; i < 6; ++i) { const int id = tid + 512 * i, j = id >> 3, ch = id & 7; \
            const int mp = (g_ == 2) ? (j & 127) : 128 * (c0_ - 1) + j, rr = (g_ == 2) ? r0_ + (j >> 7) : r0_; \
            kr[i] = (u32x4){0u, 0u, 0u, 0u}; vr[i] = (u32x4){0u, 0u, 0u, 0u}; \
            if (mp >= 0 && (g_ != 2 || j < 256)) { const size_t tk_ = tb_ + (size_t)mp * d_ + rr; kr[i] = *(const u32x4*)(ZB + ((size_t)(24 + g_ * 8 + h_) * TT + tk_) * 64 + 8 * ch); vr[i] = *(const u32x4*)(ZB + ((size_t)(48 + g_ * 8 + h_) * TT + tk_) * 64 + 8 * ch); } } \
        _Pragma("unroll") for (int qt = 0; qt < 2; ++qt) { const size_t tq_ = tb_ + (size_t)(128 * cq_ + 32 * wq + 16 * qt + l15) * d_ + rq_; \
            _Pragma("unroll") for (int ds = 0; ds < 2; ++ds) qn[qt][ds] = *(const bf16x8*)(ZB + ((size_t)(g_ * 8 + h_) * TT + tq_) * 64 + 32 * ds + 8 * q4); } } while (0)
    const bool xl = (G == 256); const int ustep = xl ? 32 : G, ubase = xl ? (bid & 7) * 192 : 0, ulim = xl ? ubase + 192 : 1536;
    { const int u0 = ubase + (xl ? (bid >> 3) : bid); AT_LOAD((u0 < ulim ? u0 : ulim - 1)); }
    for (int un = ubase + (xl ? (bid >> 3) : bid); un < ulim; un += ustep) {
        AT_DEC(un)
        const int g = g_, h = h_; const bool prev_ok = (g_ != 2) && (cq_ > 0); const int wbase = (g_ == 2) ? 128 * sb - 128 : 128 * sb;
        size_t tq[2];
#pragma unroll
        for (int qt = 0; qt < 2; ++qt) tq[qt] = tb_ + (size_t)(128 * cq_ + 32 * wq + 16 * qt + l15) * d_ + rq_;
#pragma unroll
        for (int i = 0; i < 6; ++i) { const int id = tid + 512 * i, j = id >> 3, ch = id & 7; *(LAS u32x4*)(KI + j * KP + 8 * ch) = kr[i]; *(LAS u32x4*)(VI + j * KP + 8 * ch) = vr[i]; }
        bf16x8 qf[2][2];
#pragma unroll
        for (int qt = 0; qt < 2; ++qt) { qf[qt][0] = qn[qt][0]; qf[qt][1] = qn[qt][1]; }
        LBAR();
        { const int nx = (un + ustep < ulim) ? un + ustep : un; AT_LOAD(nx); }
        f32x4 st[5][2][2]; float mx[2] = {-INFINITY, -INFINITY};
#pragma unroll
        for (int p = 0; p < 5; ++p) { const int a = wq + p; const bool on = prev_ok || a >= 4;
#pragma unroll
            for (int t = 0; t < 2; ++t) {
                if (on) { const int j0 = 32 * a + 16 * t, k = 2 * p + t; f32x4 s0 = (f32x4){0.f, 0.f, 0.f, 0.f}, s1 = (f32x4){0.f, 0.f, 0.f, 0.f};
#pragma unroll
                    for (int ds = 0; ds < 2; ++ds) { const bf16x8 kf = *(const LAS bf16x8*)(KI + (wbase + j0 + l15) * KP + 32 * ds + 8 * q4); if (k <= 8) s0 = mfma16(kf, qf[0][ds], s0); if (k >= 1) s1 = mfma16(kf, qf[1][ds], s1); }
#pragma unroll
                    for (int i = 0; i < 4; ++i) { const int kk = 4 * q4 + i;
                        if (k == 0) s0[i] = (kk >= l15) ? s0[i] : -INFINITY; if (k == 8) s0[i] = (kk <= l15) ? s0[i] : -INFINITY; if (k == 9) s0[i] = -INFINITY;
                        if (k == 1) s1[i] = (kk >= l15) ? s1[i] : -INFINITY; if (k == 9) s1[i] = (kk <= l15) ? s1[i] : -INFINITY; if (k == 0) s1[i] = -INFINITY;
                        mx[0] = fmaxf(mx[0], s0[i]); mx[1] = fmaxf(mx[1], s1[i]); }
                    st[p][t][0] = s0; st[p][t][1] = s1;
                } else { st[p][t][0] = (f32x4){-INFINITY, -INFINITY, -INFINITY, -INFINITY}; st[p][t][1] = st[p][t][0]; } } }
        float l[2] = {0.f, 0.f}; bf16x8 pf[5][2];
#pragma unroll
        for (int qt = 0; qt < 2; ++qt) { mx[qt] = fmaxf(mx[qt], __shfl_xor(mx[qt], 16)); mx[qt] = fmaxf(mx[qt], __shfl_xor(mx[qt], 32)); }
#pragma unroll
        for (int p = 0; p < 5; ++p)
#pragma unroll
            for (int qt = 0; qt < 2; ++qt) { float e[8];
#pragma unroll
                for (int t = 0; t < 2; ++t)
#pragma unroll
                    for (int i = 0; i < 4; ++i) { e[4 * t + i] = __builtin_amdgcn_exp2f(st[p][t][qt][i] - mx[qt]); l[qt] += e[4 * t + i]; }
                u32x4 pw; pw.x = pk_bf16(e[0], e[1]); pw.y = pk_bf16(e[2], e[3]); pw.z = pk_bf16(e[4], e[5]); pw.w = pk_bf16(e[6], e[7]); pf[p][qt] = __builtin_bit_cast(bf16x8, pw); }
#pragma unroll
        for (int qt = 0; qt < 2; ++qt) { l[qt] += __shfl_xor(l[qt], 16); l[qt] += __shfl_xor(l[qt], 32); }
        f32x4 o[4][2];
#pragma unroll
        for (int dt = 0; dt < 4; ++dt) { o[dt][0] = (f32x4){0.f, 0.f, 0.f, 0.f}; o[dt][1] = (f32x4){0.f, 0.f, 0.f, 0.f}; }
#pragma unroll
        for (int p = 0; p < 5; ++p) { const int a = wq + p; const bool on = prev_ok || a >= 4;
            if (on) {
#pragma unroll
                for (int dt = 0; dt < 4; ++dt) { const LAS u16* vp = VI + (wbase + 32 * a + 4 * q4 + (l15 >> 2)) * KP + 16 * dt + 4 * (l15 & 3);
                    const s16x4 lo = ds_tr(vp), hi = ds_tr(vp + 16 * KP); const bf16x8 vf = cat8(lo, hi); o[dt][0] = mfma16(vf, pf[p][0], o[dt][0]); o[dt][1] = mfma16(vf, pf[p][1], o[dt][1]); } } }
        LAS u16* stg = (LAS u16*)(lds + 2 * 384 * KP * 2 + w * 4608);
#pragma unroll
        for (int qt = 0; qt < 2; ++qt) { const float il = 1.0f / l[qt];
#pragma unroll
            for (int dt = 0; dt < 4; ++dt) *(LAS u32x2*)(stg + (16 * qt + l15) * 72 + 16 * dt + 4 * q4) = (u32x2){pk_bf16(o[dt][qt][0] * il, o[dt][qt][1] * il), pk_bf16(o[dt][qt][2] * il, o[dt][qt][3] * il)};
            if (q4 == 0) LSE[(size_t)g * TT * 8 + tq[qt] * 8 + h] = mx[qt] + __log2f(l[qt]); }
        asm volatile("s_waitcnt lgkmcnt(0)" ::: "memory");
#pragma unroll
        for (int i = 0; i < 4; ++i) { const int row = i * 8 + (lane >> 3), ch = lane & 7; const u32x4 v = *(const LAS u32x4*)(stg + row * 72 + 8 * ch);
            const size_t tr = tb_ + (size_t)(128 * cq_ + 32 * wq + row) * d_ + rq_;
            *(u32x4*)(OG + (size_t)g * TT * 512 + tr * 512 + h * 64 + 8 * ch) = v; }
        LBAR();
    }
#undef AT_DEC
#undef AT_LOAD
}
__device__ __forceinline__ void merge_phase(u16* OG, const float* LSE, const u16* AG, int bid, int nb) {
    for (int idx = bid * 512 + threadIdx.x; idx < TT * 64; idx += nb * 512) {
        const int tok = idx >> 6, h = (idx >> 3) & 7, ch = idx & 7; const size_t off = (size_t)tok * 512 + h * 64 + 8 * ch;
        const float l0 = LSE[(size_t)tok * 8 + h], l1 = LSE[(size_t)TT * 8 + (size_t)tok * 8 + h], l2 = LSE[(size_t)2 * TT * 8 + (size_t)tok * 8 + h];
        const float m = fmaxf(l0, fmaxf(l1, l2)); float w0 = __builtin_amdgcn_exp2f(l0 - m), w1 = __builtin_amdgcn_exp2f(l1 - m), w2 = __builtin_amdgcn_exp2f(l2 - m);
        const float inv = 1.0f / (w0 + w1 + w2); w0 *= inv; w1 *= inv; w2 *= inv;
        const u32x4 a = *(const u32x4*)(OG + off), bq = *(const u32x4*)(OG + (size_t)TT * 512 + off), cq = *(const u32x4*)(OG + (size_t)2 * TT * 512 + off), gq = *(const u32x4*)(AG + off);
        u32x4 o;
#define MRG(F) o.F = pk_bf16((w0 * bflo(a.F) + w1 * bflo(bq.F) + w2 * bflo(cq.F)) * bflo(gq.F), (w0 * bfhi(a.F) + w1 * bfhi(bq.F) + w2 * bfhi(cq.F)) * bfhi(gq.F))
        MRG(x); MRG(y); MRG(z); MRG(w);
#undef MRG
        store16_wt(OG + off, o);
    }
}

template <int MODE = 0> __device__ __forceinline__ void hgrn_unit(LAS unsigned char* lds, int b, int h, const u16* QA, const u16* GG, const u16* VA, const u16* HG, const float* nw, u16* OA, unsigned* dcnt) {
    const int tid = threadIdx.x, lane = tid & 63, w = __builtin_amdgcn_readfirstlane(tid >> 6), l15 = lane & 15, q4 = lane >> 4;
    constexpr int P = 136, IMGB = 52224;
    LAS u16* SB = (LAS u16*)(lds + 104448); LAS float* TOT = (LAS float*)(lds + 139264); LAS float* DFB = (LAS float*)(lds + 143360); LAS float* SSQ = (LAS float*)(lds + 146432);
    f32x4 S[8];
#pragma unroll
    for (int i = 0; i < 8; ++i) S[i] = (f32x4){0.f, 0.f, 0.f, 0.f};
    const int kp = lane, seg = w, tt = (w < 4) ? (w >> 1) : 3 - ((w - 4) >> 1), vh = w & 1;
    const size_t tok0 = (size_t)b * SEQ, hbase = (size_t)(b * 8 + h) * SEQ;
    unsigned gq0[8], qq0[8], gq1[8], qq1[8]; u32x4 vv0[2], vv1[2]; u32x2 hg0[4], hg1[4];
    f32x4 O[4]; float sqp = 0.f;
#pragma unroll
    for (int j = 0; j < 4; ++j) O[j] = (f32x4){0.f, 0.f, 0.f, 0.f};
#define HG_LOAD(c, gq, qq, vv) do { const size_t t0_ = tok0 + 64 * (c); \
        const size_t hb_ = hbase + 64 * (c); \
        _Pragma("unroll") for (int i = 0; i < 8; ++i) { const size_t o_ = (t0_ + 8 * seg + i) * 1024 + h * 128 + 2 * kp; gq[i] = *(const unsigned*)(GG + (hb_ + 8 * seg + i) * 128 + 2 * kp); qq[i] = *(const unsigned*)(QA + o_); } \
        _Pragma("unroll") for (int u_ = 0; u_ < 2; ++u_) { const int id_ = tid + 512 * u_; vv[u_] = *(const u32x4*)(VA + (hb_ + (id_ >> 4)) * 128 + 8 * (id_ & 15)); } } while (0)
#define HG_LOADG(c, hgv) do { const size_t tq_ = hbase + 64 * (c) + 16 * tt + l15; \
        _Pragma("unroll") for (int j = 0; j < 4; ++j) hgv[j] = *(const u32x2*)(HG + tq_ * 128 + 16 * (4 * vh + j) + 4 * q4); } while (0)
#define HG_PREP1(gq) do { float r0_ = 1.f, r1_ = 1.f; \
        _Pragma("unroll") for (int i = 0; i < 8; ++i) { r0_ *= f16lo(gq[i]); r1_ *= f16hi(gq[i]); } \
        *(LAS f32x2*)(TOT + seg * 128 + 2 * kp) = (f32x2){__log2f(r0_), __log2f(r1_)}; } while (0)
#define HG_PREP2(buf, gq, qq, vv) do { LAS u16* QM_ = (LAS u16*)(lds + (buf) * IMGB); LAS u16* KM_ = (LAS u16*)(lds + (buf) * IMGB + 17408); LAS u16* VI_ = (LAS u16*)(lds + (buf) * IMGB + 34816); LAS float* DF_ = DFB + (buf) * 384; \
        float off0 = 0.f, off1 = 0.f, br0 = 0.f, br1 = 0.f, bl0 = 0.f, bl1 = 0.f; \
        _Pragma("unroll") for (int s2 = 0; s2 < 8; ++s2) { const f32x2 t_ = *(const LAS f32x2*)(TOT + s2 * 128 + 2 * kp); \
            if (s2 < seg) { off0 += t_.x; off1 += t_.y; } if (s2 < 4) { br0 += t_.x; br1 += t_.y; } bl0 += t_.x; bl1 += t_.y; } \
        off0 -= br0; off1 -= br1; \
        float E0 = __builtin_amdgcn_exp2f(fminf(off0, 115.f)), E1 = __builtin_amdgcn_exp2f(fminf(off1, 115.f)), I0 = __builtin_amdgcn_exp2f(fminf(-off0, 115.f)), I1 = __builtin_amdgcn_exp2f(fminf(-off1, 115.f)); \
        _Pragma("unroll") for (int i = 0; i < 8; ++i) { const int s_ = 8 * seg + i; const float f0_ = f16lo(gq[i]), f1_ = f16hi(gq[i]); \
            E0 *= f0_; E1 *= f1_; I0 *= __builtin_amdgcn_rcpf(f0_); I1 *= __builtin_amdgcn_rcpf(f1_); \
            *(LAS unsigned*)(QM_ + s_ * P + 2 * kp) = pk_bf16(bflo(qq[i]) * E0, bfhi(qq[i]) * E1); \
            *(LAS unsigned*)(KM_ + s_ * P + 2 * kp) = pk_bf16((1.0f - f0_) * I0, (1.0f - f1_) * I1); } \
        if (seg == 0) { *(LAS f32x2*)(DF_ + 2 * kp) = (f32x2){__builtin_amdgcn_exp2f(bl0), __builtin_amdgcn_exp2f(bl1)}; *(LAS f32x2*)(DF_ + 128 + 2 * kp) = (f32x2){__builtin_amdgcn_exp2f(bl0 - br0), __builtin_amdgcn_exp2f(bl1 - br1)}; *(LAS f32x2*)(DF_ + 256 + 2 * kp) = (f32x2){__builtin_amdgcn_exp2f(br0), __builtin_amdgcn_exp2f(br1)}; } \
        _Pragma("unroll") for (int u_ = 0; u_ < 2; ++u_) { const int id_ = tid + 512 * u_; *(LAS u32x4*)(VI_ + (id_ >> 4) * P + 8 * (id_ & 15)) = vv[u_]; } } while (0)
#define HG_STAGE(hgv) do { \
        _Pragma("unroll") for (int j = 0; j < 4; ++j) { const f32x4 n4 = nwv[j]; const int row_ = 16 * tt + l15, c16_ = 2 * (4 * vh + j) + (q4 >> 1); \
            *(LAS u32x2*)(STG + row_ * 256 + ((c16_ ^ l15) << 4) + 8 * (q4 & 1)) = (u32x2){pk_bf16(O[j][0] * n4[0] * bflo(hgv[j].x), O[j][1] * n4[1] * bfhi(hgv[j].x)), \
                                                                                         pk_bf16(O[j][2] * n4[2] * bflo(hgv[j].y), O[j][3] * n4[3] * bfhi(hgv[j].y))}; } } while (0)
#define HG_COPY(c) do { \
        _Pragma("unroll") for (int u_ = 0; u_ < 2; ++u_) { const int id_ = tid + 512 * u_, row_ = id_ >> 4, ch_ = id_ & 15; \
            const float sc_ = rsqrtf((SSQ[((row_ >> 4) * 2) * 16 + (row_ & 15)] + SSQ[((row_ >> 4) * 2 + 1) * 16 + (row_ & 15)]) * (1.0f / 128.0f) + NORM_EPS); \
            const u32x4 v_ = *(const LAS u32x4*)(STG + row_ * 256 + ((ch_ ^ (row_ & 15)) << 4)); u32x4 o_; \
            o_.x = pk_bf16(bflo(v_.x) * sc_, bfhi(v_.x) * sc_); o_.y = pk_bf16(bflo(v_.y) * sc_, bfhi(v_.y) * sc_); o_.z = pk_bf16(bflo(v_.z) * sc_, bfhi(v_.z) * sc_); o_.w = pk_bf16(bflo(v_.w) * sc_, bfhi(v_.w) * sc_); \
            if (MODE & 8) { dacc_ ^= o_.x ^ o_.w; } else *(u32x4*)(OA + (tok0 + 64 * (c) + row_) * 1024 + h * 128 + 8 * ch_) = o_; } } while (0)
    unsigned dacc_ = 0u;
    LAS unsigned char* STG = lds + 146944;
    f32x4 nwv[4];
#pragma unroll
    for (int j = 0; j < 4; ++j) nwv[j] = *(const f32x4*)(nw + 16 * (4 * vh + j) + 4 * q4);
    HG_LOAD(0, gq0, qq0, vv0); HG_LOADG(0, hg0); HG_LOADG(0, hg1); if (tid < 128) SSQ[tid] = 1.0f; HG_PREP1(gq0); LBAR(); HG_PREP2(0, gq0, qq0, vv0);
    for (int i = tid; i < 128 * P / 2; i += 512) ((LAS unsigned*)SB)[i] = 0u;
    HG_LOAD(1, gq1, qq1, vv1); HG_LOAD(2, gq0, qq0, vv0); LBAR(); HG_PREP1(gq1); LBAR();
#ifdef PROBE_ACC
    unsigned tacc_ = 0u, tlast_ = (unsigned)__builtin_amdgcn_s_memrealtime();
#define HG_T(k) do { if (blockIdx.x == 0 && tid == 448) { const unsigned n_ = (unsigned)__builtin_amdgcn_s_memrealtime(); if ((k) == PROBE_ACC) tacc_ += n_ - tlast_; tlast_ = n_; } } while (0)
#else
#define HG_T(k) do {} while (0)
#endif
#define HG_STEP(c, G2, Q2, V2, G1, HGU, HGL, LASTF) do { HG_T(2); \
        const int cur = (c) & 1, nxt = cur ^ 1; \
        const LAS u16* QM = (const LAS u16*)(lds + cur * IMGB); const LAS u16* KM = (const LAS u16*)(lds + cur * IMGB + 17408); const LAS u16* VI = (const LAS u16*)(lds + cur * IMGB + 34816); const LAS float* DF = DFB + cur * 384; \
        if (!(MODE & 4)) HG_COPY(((c) > 0 ? (c) - 1 : 0)); \
        if (!(LASTF)) { if (!(MODE & 2)) HG_PREP2(nxt, G2, Q2, V2); HG_LOADG(((c) + 1 < 32 ? (c) + 1 : 31), HGL); \
        HG_LOAD(((c) + 3 < 32 ? (c) + 3 : 31), G2, Q2, V2); } HG_T(0); \
        if (!(MODE & 1)) { \
        bf16x8 qm[4]; \
        _Pragma("unroll") for (int ks = 0; ks < 4; ++ks) qm[ks] = *(const LAS bf16x8*)(QM + (16 * tt + l15) * P + 32 * ks + 8 * q4); \
        f32x4 Dm[4]; \
        _Pragma("unroll") for (int st = 0; st < 4; ++st) { Dm[st] = (f32x4){0.f, 0.f, 0.f, 0.f}; \
            _Pragma("unroll") for (int ks = 0; ks < 4; ++ks) { const bf16x8 kf = *(const LAS bf16x8*)(KM + (16 * st + l15) * P + 32 * ks + 8 * q4); Dm[st] = mfma16(kf, qm[ks], Dm[st]); } \
            _Pragma("unroll") for (int i = 0; i < 4; ++i) { const bool keep_ = (st < tt) || (st == tt && 4 * q4 + i <= l15); Dm[st][i] = keep_ ? Dm[st][i] : 0.f; } } \
        bf16x8 pf[2]; \
        _Pragma("unroll") for (int a = 0; a < 2; ++a) { u32x4 pw; pw.x = pk_bf16(Dm[2 * a][0], Dm[2 * a][1]); pw.y = pk_bf16(Dm[2 * a][2], Dm[2 * a][3]); pw.z = pk_bf16(Dm[2 * a + 1][0], Dm[2 * a + 1][1]); pw.w = pk_bf16(Dm[2 * a + 1][2], Dm[2 * a + 1][3]); pf[a] = __builtin_bit_cast(bf16x8, pw); } \
        _Pragma("unroll") for (int j = 0; j < 4; ++j) { const int vt = 4 * vh + j; f32x4 o = (f32x4){0.f, 0.f, 0.f, 0.f}; \
            _Pragma("unroll") for (int a = 0; a < 2; ++a) { const LAS u16* vp = VI + (32 * a + 4 * q4 + (l15 >> 2)) * P + 16 * vt + 4 * (l15 & 3); \
                const s16x4 lo = ds_tr(vp), hi = ds_tr(vp + 16 * P); o = mfma16(cat8(lo, hi), pf[a], o); } \
            _Pragma("unroll") for (int ks = 0; ks < 4; ++ks) { const bf16x8 sf = *(const LAS bf16x8*)(SB + (16 * vt + l15) * P + 32 * ks + 8 * q4); o = mfma16(sf, qm[ks], o); } \
            O[j] = o; } \
        { bf16x8 ka[2]; \
            _Pragma("unroll") for (int a = 0; a < 2; ++a) { const LAS u16* kpp = KM + (32 * a + 8 * q4 + (l15 >> 2)) * P + 16 * w + 4 * (l15 & 3); const s16x4 lo = ds_tr(kpp), hi = ds_tr(kpp + 4 * P); ka[a] = cat8(lo, hi); } \
            const f32x4 d1 = *(const LAS f32x4*)(DF + 16 * w + 4 * q4), d2 = *(const LAS f32x4*)(DF + 128 + 16 * w + 4 * q4); \
            _Pragma("unroll") for (int vt = 0; vt < 8; ++vt) { f32x4 U = (f32x4){0.f, 0.f, 0.f, 0.f}; \
                _Pragma("unroll") for (int a = 0; a < 2; ++a) { const LAS u16* vp = VI + (32 * a + 8 * q4 + (l15 >> 2)) * P + 16 * vt + 4 * (l15 & 3); const s16x4 lo = ds_tr(vp), hi = ds_tr(vp + 4 * P); U = mfma16(ka[a], cat8(lo, hi), U); } \
                S[vt] = d1 * S[vt] + d2 * U; } } \
        { float sq = 0.f; \
            _Pragma("unroll") for (int j = 0; j < 4; ++j) sq += (O[j][0] * O[j][0] + O[j][1] * O[j][1]) + (O[j][2] * O[j][2] + O[j][3] * O[j][3]); \
            sq += __shfl_xor(sq, 16); sq += __shfl_xor(sq, 32); sqp = sq; } } \
        HG_T(1); \
        LBAR(); HG_T(2); \
        { const f32x4 eb = *(const LAS f32x4*)(DFB + nxt * 384 + 256 + 16 * w + 4 * q4); \
            _Pragma("unroll") for (int vt = 0; vt < 8; ++vt) *(LAS u32x2*)(SB + (16 * vt + l15) * P + 16 * w + 4 * q4) = (u32x2){pk_bf16(S[vt][0] * eb[0], S[vt][1] * eb[1]), pk_bf16(S[vt][2] * eb[2], S[vt][3] * eb[3])}; } \
        if (q4 == 0) SSQ[(tt * 2 + vh) * 16 + l15] = sqp; \
        if (!(MODE & 4)) HG_STAGE(HGU); \
        if (!(LASTF) && !(MODE & 2)) HG_PREP1(G1); HG_T(3); \
        LBAR(); } while (0)
    for (int c = 0; c < 30; c += 2) {
        if (c == 20 && dcnt) {
            if (tid == 0) { unsigned sp = 0u;
                while (__hip_atomic_load(dcnt + 64 * (8 * b + 6), __ATOMIC_RELAXED, __HIP_MEMORY_SCOPE_AGENT) < 16u || __hip_atomic_load(dcnt + 64 * (8 * b + 7), __ATOMIC_RELAXED, __HIP_MEMORY_SCOPE_AGENT) < 16u) { __builtin_amdgcn_s_sleep(2); if (++sp > (1u << 22)) break; }
                __builtin_amdgcn_fence(__ATOMIC_ACQUIRE, "agent"); asm volatile("s_waitcnt vmcnt(0)" ::: "memory"); }
            LBAR(); }
        HG_STEP(c, gq1, qq1, vv1, gq0, hg0, hg1, false);
        HG_STEP(c + 1, gq0, qq0, vv0, gq1, hg1, hg0, false);
    }
    HG_STEP(30, gq1, qq1, vv1, gq0, hg0, hg1, false);
    HG_STEP(31, gq0, qq0, vv0, gq1, hg1, hg0, true);
    HG_COPY(31);
    if (MODE & 8) { if (dacc_ == 0x12345678u) OA[tid] = (u16)dacc_; }
#ifdef PROBE_ACC
    if (blockIdx.x == 0 && tid == 448) ((LAS unsigned long long*)(lds + 163344))[10] = (unsigned long long)tacc_;
#endif
#undef HG_STEP
#undef HG_LOAD
#undef HG_LOADG
#undef HG_PREP1
#undef HG_PREP2
#undef HG_STAGE
#undef HG_COPY
    LBAR();
}

#define XB_TMO      128
#define XB_XCNT(j)  (256  + 64 * (j))
#define XB_XSUB(j)  (1280 + 64 * (j))
#define XB_XGEN(j)  (2304 + 64 * (j))
#define XB_TOP      3328
#define XB_TOPGEN   3392
#define XCD_BAR_WORDS 3456
#define XB_SPIN_CAP (1u << 18)

__device__ __forceinline__ unsigned xb_ld(unsigned* p)              { return __hip_atomic_load(p, __ATOMIC_RELAXED, __HIP_MEMORY_SCOPE_AGENT); }
__device__ __forceinline__ unsigned xb_add(unsigned* p, unsigned v) { return __hip_atomic_fetch_add(p, v, __ATOMIC_RELAXED, __HIP_MEMORY_SCOPE_AGENT); }
__device__ __forceinline__ unsigned xb_xcc_id() { return (unsigned)__builtin_amdgcn_s_getreg((3 << 11) | 20) & 0xFu; }
#define XB_SPIN(cond, bar) do { unsigned _sp = 0; while (cond) { __builtin_amdgcn_s_sleep(1); \
    if ((++_sp & 255u) == 0u) { if (xb_ld(&(bar)[XB_TMO])) break; if (_sp > XB_SPIN_CAP) { atomicAdd(&(bar)[XB_TMO], 1u); break; } } } } while (0)

struct XcdBarrier {
    unsigned* bar; unsigned x;
    volatile LAS unsigned* st;
};

__device__ __forceinline__ XcdBarrier xcd_barrier_post(unsigned* bar, volatile LAS unsigned* st) {
    XcdBarrier b; b.bar = bar; b.x = xb_xcc_id(); b.st = st;
    if (threadIdx.x == 0) (void)xb_add(&bar[XB_XCNT(b.x)], 1u);
    return b;
}
__device__ __forceinline__ void xcd_barrier_complete(unsigned* bar, unsigned x, unsigned& nloc, unsigned& nx) {
    const unsigned G = gridDim.x * gridDim.y * gridDim.z;
    unsigned sum, cnt, mine, sp = 0u;
    for (;;) {
        sum = 0u; cnt = 0u; mine = 0u;
#pragma unroll
        for (unsigned j = 0; j < 16; ++j) { const unsigned c = xb_ld(&bar[XB_XCNT(j)]); sum += c; cnt += (c > 0u) ? 1u : 0u; mine = (j == x) ? c : mine; }
        if (sum == G) break;
        __builtin_amdgcn_s_sleep(1);
        if ((++sp & 255u) == 0u) { if (xb_ld(&bar[XB_TMO])) break; if (sp > XB_SPIN_CAP) { atomicAdd(&bar[XB_TMO], 1u); break; } }
    }
    nloc = mine > 0u ? mine : 1u; nx = cnt > 0u ? cnt : 1u;
}

__device__ __forceinline__ void xcd_barrier(const XcdBarrier& b) {
    asm volatile("s_waitcnt vmcnt(0)" ::: "memory");
    __syncthreads();
    if (threadIdx.x == 0) {
        unsigned* bar = b.bar;
        __builtin_amdgcn_s_waitcnt(0);
        unsigned nloc = b.st[0], nx = b.st[1];
        if (nloc == 0u) { xcd_barrier_complete(bar, b.x, nloc, nx); b.st[0] = nloc; b.st[1] = nx; }
        const unsigned old = xb_add(&bar[XB_XSUB(b.x)], 1u);
        const unsigned gen = old / nloc;
        if (old + 1u == (gen + 1u) * nloc) {
            __builtin_amdgcn_fence(__ATOMIC_RELEASE, "agent");
            asm volatile("s_waitcnt vmcnt(0)" ::: "memory");
            const unsigned og = xb_add(&bar[XB_TOP], 1u);
            const unsigned tg = og / nx;
            if (og + 1u == (tg + 1u) * nx) xb_add(&bar[XB_TOPGEN], 1u);
            else XB_SPIN(xb_ld(&bar[XB_TOPGEN]) == tg, bar);
            __builtin_amdgcn_fence(__ATOMIC_ACQUIRE, "agent");
            xb_add(&bar[XB_XGEN(b.x)], 1u);
            asm volatile("s_waitcnt vmcnt(0)" ::: "memory");
        } else {
            XB_SPIN(xb_ld(&bar[XB_XGEN(b.x)]) == gen, bar);
            __builtin_amdgcn_fence(__ATOMIC_ACQUIRE, "agent");
            asm volatile("s_waitcnt vmcnt(0)" ::: "memory");
        }
    }
    __syncthreads();
}

struct Args { const float* in[10]; float* out; unsigned char* ws; int ph_lo, ph_hi; };
__global__ void __launch_bounds__(512, 2) fwd_megakernel(Args a) {
    extern __shared__ __attribute__((aligned(16))) unsigned char lds_raw[];
    LAS unsigned char* lds = (LAS unsigned char*)lds_raw;
    cg::grid_group grid = cg::this_grid();
    const int G = gridDim.x, bx = blockIdx.x, vcu = (G % 8 == 0) ? (bx % 8) * (G / 8) + bx / 8 : bx;
    const int tid = threadIdx.x, lane = tid & 63, wave = __builtin_amdgcn_readfirstlane(tid >> 6);
    Ptrs P; P.x = a.in[0]; P.pos = (const int*)a.in[1]; P.norm_w = a.in[2]; P.w_in = a.in[3]; P.lbl = a.in[4]; P.hnw = a.in[5]; P.wa = a.in[6]; P.wb = a.in[7]; P.wo = a.in[8]; P.fnw = a.in[9];
    P.out = a.out; P.ws = a.ws;
    unsigned char* ws = a.ws; unsigned char* dout = (unsigned char*)a.out;
    const int lo = a.ph_lo, hi = a.ph_hi;
#ifndef REP_MASK
#define REP_MASK 0
#endif
#define IN(k) (lo <= (k) && (k) < hi)
#define REPS(k) for (int rep_ = 0; rep_ < 1 + ((REP_MASK >> (k)) & 1); ++rep_)
#ifdef PROBE_K
#ifndef PROBE_A
#define PROBE_A PROBE_K
#define PROBE_B (PROBE_K + 1)
#endif
#define STAMP(k) do { if (bx == 0 && tid == 0) ((LAS unsigned long long*)(lds + 163344))[k] = __builtin_amdgcn_s_memrealtime(); } while (0)
#else
#define STAMP(k) do {} while (0)
#endif
#define SEAM(k) do { if (IN(k) && IN((k) + 1)) xcd_barrier(bar); STAMP((k) + 1); } while (0)
    if (tid < 4) ((LAS unsigned*)(lds + 163328))[tid] = 0u;
    __syncthreads();
    const XcdBarrier bar = xcd_barrier_post((unsigned*)(ws + WS_BAR), (volatile LAS unsigned*)(lds + 163328));
    if (a.ph_hi > 1000) grid.sync();
    STAMP(0);
    if (IN(0)) REPS(0) p0_prologue(P, lds, vcu, G);
    SEAM(0);
#ifdef EXTRA_SYNCS
    for (int i_ = 0; i_ < EXTRA_SYNCS; ++i_) xcd_barrier(bar);
#endif
    if (IN(1)) REPS(1) { pg8::Gemm g{(const u16*)(ws + WS_H), (const u16*)(ws + WS_WT) + (size_t)6144 * 1024, TT, 5120, 1024}; pg8::StaticOrder S; S.init(TT, 5120, G, bx);
        EpiZ E{0, ws, dout, P.lbl}; pg8::gemm_phase<EpiZ, pg8::StaticOrder, true, true>(lds, g, S, E); }
    SEAM(1);
    if (IN(2)) REPS(2) attn_phase(lds, (const u16*)(ws + WS_Z), (u16*)(dout + DO_OG), (float*)(ws + WS_COS), bx, G);
    SEAM(2);
    if (IN(3)) {
        pg8::Gemm g{(const u16*)(ws + WS_H), (const u16*)(ws + WS_WT), TT, 4096, 1024}; DefOrder S; S.base.init(48 * 256, 4096, G, bx);
        EpiZ E{1, ws, dout, P.lbl}; pg8::gemm_phase<EpiZ, DefOrder, true, true>(lds, g, S, E); }
    SEAM(3);
    if (IN(4)) {
        {
            if (bx < 64) { hgrn_unit(lds, bx & 7, bx >> 3, (const u16*)(ws + Z_QA), (const u16*)(ws + Z_G), (const u16*)(ws + Z_VA), (const u16*)(ws + Z_HG), P.hnw, (u16*)(ws + Z_QA), (unsigned*)(ws + WS_BAR + 36864)); STAMP(9);
            }
            else { const int x = bx & 7, r = (bx >> 3) - 8;
                const pg8::Gemm gG{(const u16*)(ws + WS_H), (const u16*)(ws + WS_WT) + (size_t)4096 * 1024, TT, 2048, 1024}; const pg8::Gemm gB{(const u16*)(dout + DO_OG), (const u16*)(ws + WS_WB), TT, 1024, 512};
                const EpiZ EG{2, ws, dout, P.lbl}; const EpiGateB EB{(const u16*)(ws + Z_GATES), (u16*)(dout + DO_TMPB)};
                unsigned lg, lb2;
                if (r < 8) { lg = lo_code(r, 4) | (lo_code(r + 24, 4) << 8) | 0xffff0000u; lb2 = lo_code(r, 0) | (lo_code(r + 24, 0) << 8) | 0xffff0000u; }
                else { lg = lo_code(r, 4) | (lo_code(2 * (r - 8), 0) << 8) | (lo_code(2 * (r - 8) + 1, 0) << 16) | 0xff000000u; lb2 = lo_code(r, 0) | 0xffffff00u; }
                unsigned* mcnt = (unsigned*)(ws + WS_BAR + 16384 + 64 * 64 * 4);
                unsigned* dcnt = (unsigned*)(ws + WS_BAR + 36864);
                { unsigned ld; if (r < 8) ld = (unsigned)(((2 * r) << 3) | 6) | ((unsigned)(((2 * r + 1) << 3) | 6) << 8) | 0xffff0000u; else ld = (unsigned)(((r - 8) << 3) | 7) | 0xffffff00u;
                  const pg8::Gemm gD{(const u16*)(ws + WS_H), (const u16*)(ws + WS_WT), TT, 4096, 1024}; const EpiZT<true> ED{1, ws, dout, P.lbl};
                  ListOrder S{8 * x, ld}; pg8::gemm_phase<EpiZT<true>, ListOrder, true, true>(lds, gD, S, ED);
                  asm volatile("s_waitcnt vmcnt(0)" ::: "memory"); __syncthreads();
                  if (tid == 0) __hip_atomic_fetch_add(dcnt + 64 * (8 * x + (r < 8 ? 6 : 7)), (r < 8 ? 2u : 1u), __ATOMIC_RELAXED, __HIP_MEMORY_SCOPE_AGENT); }
                merge_phase((u16*)(dout + DO_OG), (const float*)(ws + WS_COS), (const u16*)(dout + DO_AG), bx - 64, 192);
                asm volatile("s_waitcnt vmcnt(0)" ::: "memory"); __syncthreads();
                if (tid == 0) __hip_atomic_fetch_add(mcnt, 1u, __ATOMIC_RELAXED, __HIP_MEMORY_SCOPE_AGENT);
                { ListOrder S{8 * x, lg}; pg8::gemm_phase<EpiZ, ListOrder, true, true>(lds, gG, S, EG); }
                if (tid == 0) { unsigned sp = 0u; while (__hip_atomic_load(mcnt, __ATOMIC_RELAXED, __HIP_MEMORY_SCOPE_AGENT) < 192u) { __builtin_amdgcn_s_sleep(2); if (++sp > (1u << 22)) break; }
                    __builtin_amdgcn_fence(__ATOMIC_ACQUIRE, "agent"); asm volatile("s_waitcnt vmcnt(0)" ::: "memory"); }
                __syncthreads();
                { ListOrder S{8 * x, lb2}; pg8::gemm_phase<EpiGateB, ListOrder, true, true>(lds, gB, S, EB); } }
        }
    }
    SEAM(4);
    if (IN(5)) { pg8::Gemm g{(const u16*)(ws + Z_QA), (const u16*)(ws + WS_WA), TT, 1024, 1024}; pg8::StaticOrder S; S.init(TT, 1024, G, bx);
        EpiGateA E{(const u16*)(ws + Z_GATES), (const u16*)(dout + DO_TMPB), (u16*)(ws + Z_MERGED)}; pg8::gemm_phase<EpiGateA, pg8::StaticOrder, true, true>(lds, g, S, E); }
    SEAM(5);
    if (IN(6)) { pg8::Gemm g{(const u16*)(ws + Z_MERGED), (const u16*)(ws + WS_WO), TT, 1024, 1024}; pg8::StaticOrder S; S.init(TT, 1024, G, bx);
        EpiOutNorm E{P.x, P.out, P.fnw, (float*)(ws + WS_BAR + 65536), (unsigned*)(ws + WS_BAR + 16384)}; pg8::gemm_phase<EpiOutNorm, pg8::StaticOrder, false, true>(lds, g, S, E); }
#ifdef HG_PROBE_MODE
    if (bx < 64) hgrn_unit<HG_PROBE_MODE>(lds, bx >> 3, bx & 7, (const u16*)(ws + Z_QA), (const u16*)(ws + Z_G), (const u16*)(ws + Z_VA), (const u16*)(ws + Z_HG), P.hnw, (u16*)(ws + Z_HG), nullptr);
#endif
#ifdef PROBE_K
    STAMP(7);
    if (bx == 0 && tid == 0) { const LAS unsigned long long* ts = (const LAS unsigned long long*)(lds + 163344);
#ifdef PROBE_ACC
        const unsigned long long dt = ts[10], t0
#else
        const unsigned long long dt = ts[PROBE_B] - ts[PROBE_A], t0
#endif
 = __builtin_amdgcn_s_memrealtime();
        while (__builtin_amdgcn_s_memrealtime() - t0 < dt) __builtin_amdgcn_s_sleep(8); }
#endif
#undef IN
#undef SEAM
}

extern "C" void kernel_launch(void* const* d_in, const int* in_sizes, int n_in, void* d_out, int out_size, void* d_ws, size_t ws_size, hipStream_t stream) {
    static int grid = 0;
    if (grid == 0) {
        if (n_in != 10 || in_sizes[0] != TT * DM || out_size != TT * DM || ws_size < WS_END) { fprintf(stderr, "kernel_launch: unexpected shapes (n_in %d, in0 %d, out %d, ws %zu)\n", n_in, n_in > 0 ? in_sizes[0] : -1, out_size, ws_size); grid = -1; return; }
        int dev = 0, cus = 0, per_cu = 0;
        hipGetDevice(&dev); hipDeviceGetAttribute(&cus, hipDeviceAttributeMultiprocessorCount, dev);
        if (hipFuncSetAttribute((const void*)fwd_megakernel, hipFuncAttributeMaxDynamicSharedMemorySize, LDS_BYTES) != hipSuccess) { fprintf(stderr, "kernel_launch: hipFuncSetAttribute failed\n"); grid = -1; return; }
        if (hipOccupancyMaxActiveBlocksPerMultiprocessor(&per_cu, (const void*)fwd_megakernel, 512, LDS_BYTES) != hipSuccess || per_cu < 1) { fprintf(stderr, "kernel_launch: occupancy query says %d\n", per_cu); per_cu = 1; }
        (void)hipGetLastError();
        grid = cus * (per_cu > 1 ? 1 : per_cu);
        if (grid != 256) { fprintf(stderr, "kernel_launch: built for a 256-CU device (one workgroup per CU); got %d\n", grid); grid = -1; return; }
    }
    if (grid < 0) return;
    if (hipMemsetAsync((char*)d_ws + WS_BAR, 0, 36864 + 16384, stream) != hipSuccess) { fprintf(stderr, "kernel_launch: memset of the barrier words failed\n"); return; }
    Args a{};
    for (int i = 0; i < 10; ++i) a.in[i] = (const float*)d_in[i];
    a.out = (float*)d_out; a.ws = (unsigned char*)d_ws; a.ph_lo = 0; a.ph_hi = 7;
    void* args[] = {&a};
    hipError_t e = hipLaunchCooperativeKernel((const void*)fwd_megakernel, dim3(grid), dim3(512), args, LDS_BYTES, stream);
    if (e != hipSuccess) fprintf(stderr, "kernel_launch: cooperative launch failed: %s (grid %d)\n", hipGetErrorString(e), grid);
}
```
